# Optimizing an MI355X kernel written in HIP

```python
import math
import jax, jax.numpy as jnp
from jax import lax
import numpy as np

D_MODEL = 1024
BATCH = 16
SEQ = 4096
DEPTH = 1

CHUNK = 64

CONV_HEAD_DIM = 64
CONV_HEADS = 12
D_CONV = CONV_HEADS * CONV_HEAD_DIM
CONV_WIDTH = 3
SSM_GROUP_CH = 16
SSM_GROUPS = 16
D_SSM = SSM_GROUPS * SSM_GROUP_CH
SSM_STATE = 64
D_IN = 3 * D_CONV + D_SSM
DT_MIN = 0.001
DT_MAX = 0.1

N_EXPERTS = 64
TOP_K = 6
N_EXPERT_GROUPS = 8
TOPK_GROUPS = 4
EXPERTS_PER_GROUP = N_EXPERTS // N_EXPERT_GROUPS
D_EXPERT = 256
D_SHARED = 256
ROUTED_SCALE = 2.5
EXPERT_BLOCK = 256

RMS_EPS = 1e-6

kernel_name = 'hybrid_conv_s5_moe_adaln_block'


def rms_norm(x, g):
    xf = x.astype(jnp.float32)
    y = xf * lax.rsqrt(jnp.mean(xf * xf, axis=-1, keepdims=True) + RMS_EPS)
    return (y * g.astype(jnp.float32)).astype(x.dtype)


def modulate(h, shift, scale):
    return h * (1.0 + scale[:, None, :]) + shift[:, None, :]


def short_conv_mixer(b_gate, c_gate, v, conv_w, conv_b):
    z = c_gate * v
    z = lax.conv_general_dilated(
        z, conv_w[:, None, :].astype(z.dtype), window_strides=(1,),
        padding=[(CONV_WIDTH - 1, 0)], dimension_numbers=('NWC', 'WIO', 'NWC'),
        feature_group_count=z.shape[-1])
    z = z + conv_b.astype(z.dtype)
    return b_gate * z


def _complex_scan_combine(e1, e2):
    a1r, a1i, b1r, b1i = e1
    a2r, a2i, b2r, b2i = e2
    ar = a1r * a2r - a1i * a2i
    ai = a1r * a2i + a1i * a2r
    br = a2r * b1r - a2i * b1i + b2r
    bi = a2r * b1i + a2i * b1r + b2i
    return (ar, ai, br, bi)


def s5_mixer(u, lam_re, lam_im, log_dt, b_re, b_im, c_re, c_im, d_skip, w_glu, b_glu):
    bsz, seq, _ = u.shape
    uf = u.astype(jnp.float32).reshape(bsz, seq, SSM_GROUPS, SSM_GROUP_CH)
    lr = lam_re.astype(jnp.float32)
    li = lam_im.astype(jnp.float32)
    dt = jnp.exp(log_dt.astype(jnp.float32))[:, None]
    mag = jnp.exp(lr * dt)
    ang = li * dt
    ab_re = mag * jnp.cos(ang)
    ab_im = mag * jnp.sin(ang)
    den = lr * lr + li * li
    nr = ab_re - 1.0
    ni = ab_im
    q_re = (nr * lr + ni * li) / den
    q_im = (ni * lr - nr * li) / den
    br = b_re.astype(jnp.float32)
    bi = b_im.astype(jnp.float32)
    bb_re = q_re[..., None] * br - q_im[..., None] * bi
    bb_im = q_re[..., None] * bi + q_im[..., None] * br
    bu_re = jnp.einsum('bsgh,gph->bsgp', uf, bb_re)
    bu_im = jnp.einsum('bsgh,gph->bsgp', uf, bb_im)
    a_re = jnp.broadcast_to(ab_re, bu_re.shape)
    a_im = jnp.broadcast_to(ab_im, bu_im.shape)
    _, _, xs_re, xs_im = lax.associative_scan(
        _complex_scan_combine, (a_re, a_im, bu_re, bu_im), axis=1)
    y = (jnp.einsum('bsgp,ghp->bsgh', xs_re, c_re.astype(jnp.float32))
         - jnp.einsum('bsgp,ghp->bsgh', xs_im, c_im.astype(jnp.float32)))
    y = y + d_skip.astype(jnp.float32).reshape(SSM_GROUPS, SSM_GROUP_CH) * uf
    y = y.reshape(bsz, seq, D_SSM)
    y = jax.nn.gelu(y)
    y = y * jax.nn.sigmoid(y @ w_glu.astype(jnp.float32) + b_glu.astype(jnp.float32))
    return y.astype(u.dtype)


def swiglu(h, w1, w3, w2):
    return (jax.nn.silu(h @ w1) * (h @ w3)) @ w2


def routed_experts(h, w_router, router_bias, w1, w3, w2):
    n_tok, d = h.shape
    scores = jax.nn.sigmoid(h.astype(jnp.float32) @ w_router.astype(jnp.float32))
    biased = scores + router_bias.astype(jnp.float32)
    grp = biased.reshape(n_tok, N_EXPERT_GROUPS, EXPERTS_PER_GROUP)
    grp_score = lax.top_k(grp, 2)[0].sum(-1)
    _, grp_idx = lax.top_k(grp_score, TOPK_GROUPS)
    grp_sel = jnp.any(grp_idx[..., None] == jnp.arange(N_EXPERT_GROUPS), axis=1)
    expert_mask = jnp.repeat(grp_sel, EXPERTS_PER_GROUP, axis=-1)
    masked = jnp.where(expert_mask, biased, -jnp.inf)
    _, e_idx = lax.top_k(masked, TOP_K)
    w_sel = jnp.take_along_axis(scores, e_idx, axis=-1)
    w_sel = w_sel / jnp.sum(w_sel, axis=-1, keepdims=True) * ROUTED_SCALE

    n_assign = n_tok * TOP_K
    m = EXPERT_BLOCK
    n_blocks = -(-(n_assign + N_EXPERTS * (m - 1)) // m)
    n_rows = n_blocks * m
    e_flat = e_idx.reshape(n_assign)
    tok_flat = jnp.arange(n_assign, dtype=jnp.int32) // TOP_K
    w_flat = w_sel.reshape(n_assign)
    order = jnp.argsort(e_flat)
    e_sorted = e_flat[order]
    counts = jnp.bincount(e_flat, length=N_EXPERTS)
    padded = (counts + m - 1) // m * m
    start = jnp.cumsum(counts) - counts
    pend = jnp.cumsum(padded)
    pstart = pend - padded
    rank = jnp.arange(n_assign, dtype=jnp.int32) - start[e_sorted]
    dest = pstart[e_sorted] + rank
    tok_buf = jnp.zeros((n_rows,), jnp.int32).at[dest].set(tok_flat[order])
    w_buf = jnp.zeros((n_rows,), jnp.float32).at[dest].set(w_flat[order])
    block_e = jnp.minimum(
        jnp.searchsorted(pend, jnp.arange(n_blocks) * m, side='right'), N_EXPERTS - 1)

    def expert_block(args):
        tok, wt, e = args
        xb = h[tok]
        yb = swiglu(xb, w1[e], w3[e], w2[e])
        return yb * wt[:, None].astype(yb.dtype)

    ys = lax.map(expert_block, (tok_buf.reshape(n_blocks, m),
                                w_buf.reshape(n_blocks, m), block_e))
    return jnp.zeros_like(h).at[tok_buf].add(ys.reshape(n_rows, d).astype(h.dtype))


def setup_inputs(seed: int = 0) -> dict:
    key = jax.random.key(seed)
    ks = jax.random.split(key, 32)
    f32 = jnp.float32
    nrm = lambda k, shape, s: jax.random.normal(k, shape, f32) * s
    d = D_MODEL
    n_idx = jnp.arange(SSM_STATE, dtype=f32)
    return {
        'x': nrm(ks[0], (BATCH, SEQ, d), 1.0),
        'c': nrm(ks[1], (BATCH, d), 1.0),
        'w_ada': nrm(ks[2], (d, 6 * d), 0.02),
        'b_ada': nrm(ks[3], (6 * d,), 0.01),
        'g_mix': 1.0 + nrm(ks[4], (d,), 0.01),
        'w_in': nrm(ks[5], (d, D_IN), d ** -0.5),
        'conv_w': nrm(ks[6], (CONV_WIDTH, D_CONV), CONV_WIDTH ** -0.5),
        'conv_b': nrm(ks[7], (D_CONV,), 0.01),
        'g_conv': 1.0 + nrm(ks[8], (D_CONV,), 0.01),
        'lam_re': -0.5 + nrm(ks[9], (SSM_GROUPS, SSM_STATE), 0.01),
        'lam_im': math.pi * n_idx[None, :] + nrm(ks[10], (SSM_GROUPS, SSM_STATE), 0.01),
        'log_dt': jax.random.uniform(ks[11], (SSM_GROUPS,), f32,
                                     math.log(DT_MIN), math.log(DT_MAX)),
        'b_re': nrm(ks[12], (SSM_GROUPS, SSM_STATE, SSM_GROUP_CH), (2 * SSM_GROUP_CH) ** -0.5),
        'b_im': nrm(ks[13], (SSM_GROUPS, SSM_STATE, SSM_GROUP_CH), (2 * SSM_GROUP_CH) ** -0.5),
        'c_re': nrm(ks[14], (SSM_GROUPS, SSM_GROUP_CH, SSM_STATE), SSM_STATE ** -0.5),
        'c_im': nrm(ks[15], (SSM_GROUPS, SSM_GROUP_CH, SSM_STATE), SSM_STATE ** -0.5),
        'd_skip': nrm(ks[16], (D_SSM,), 1.0),
        'w_glu': nrm(ks[17], (D_SSM, D_SSM), D_SSM ** -0.5),
        'b_glu': nrm(ks[18], (D_SSM,), 0.01),
        'g_ssm': 1.0 + nrm(ks[19], (D_SSM,), 0.01),
        'w_out': nrm(ks[20], (d, d), d ** -0.5),
        'g_ffn': 1.0 + nrm(ks[21], (d,), 0.01),
        'w_router': nrm(ks[22], (d, N_EXPERTS), d ** -0.5),
        'router_bias': nrm(ks[23], (N_EXPERTS,), 0.01),
        'w1': nrm(ks[24], (N_EXPERTS, d, D_EXPERT), d ** -0.5),
        'w3': nrm(ks[25], (N_EXPERTS, d, D_EXPERT), d ** -0.5),
        'w2': nrm(ks[26], (N_EXPERTS, D_EXPERT, d), D_EXPERT ** -0.5),
        'ws1': nrm(ks[27], (d, D_SHARED), d ** -0.5),
        'ws3': nrm(ks[28], (d, D_SHARED), d ** -0.5),
        'ws2': nrm(ks[29], (D_SHARED, d), D_SHARED ** -0.5),
        'g_final': 1.0 + nrm(ks[30], (d,), 0.01),
    }


def reference(x, c, w_ada, b_ada, g_mix, w_in, conv_w, conv_b, g_conv,
              lam_re, lam_im, log_dt, b_re, b_im, c_re, c_im, d_skip, w_glu, b_glu,
              g_ssm, w_out, g_ffn, w_router, router_bias, w1, w3, w2,
              ws1, ws3, ws2, g_final):
    bsz, seq, d = x.shape
    mod = jax.nn.silu(c) @ w_ada + b_ada
    shift1, scale1, gate1, shift2, scale2, gate2 = jnp.split(mod, 6, axis=-1)
    for _ in range(DEPTH):
        h = modulate(rms_norm(x, g_mix), shift1, scale1)
        proj = h @ w_in
        b_gate, c_gate, v, u = jnp.split(
            proj, [D_CONV, 2 * D_CONV, 3 * D_CONV], axis=-1)
        y_conv = rms_norm(short_conv_mixer(b_gate, c_gate, v, conv_w, conv_b), g_conv)
        y_ssm = rms_norm(s5_mixer(u, lam_re, lam_im, log_dt, b_re, b_im, c_re, c_im,
                                  d_skip, w_glu, b_glu), g_ssm)
        y = jnp.concatenate([y_conv, y_ssm], axis=-1) @ w_out
        x = x + gate1[:, None, :] * y
        h2 = modulate(rms_norm(x, g_ffn), shift2, scale2).reshape(bsz * seq, d)
        ffn = swiglu(h2, ws1, ws3, ws2) + routed_experts(h2, w_router, router_bias, w1, w3, w2)
        x = x + gate2[:, None, :] * ffn.reshape(bsz, seq, d)
    return rms_norm(x, g_final)
```

```cpp
#include <hip/hip_runtime.h>
#include <hip/hip_cooperative_groups.h>
#include <cstdio>
#include <cstdint>
namespace cg = cooperative_groups;

#ifndef MK_N_LAUNCHES
#define MK_N_LAUNCHES 1
#endif

#define LAS __attribute__((address_space(3)))
typedef unsigned short bf16_t;
typedef short bf16x8 __attribute__((ext_vector_type(8)));
typedef float f32x4 __attribute__((ext_vector_type(4)));
typedef float f32x2 __attribute__((ext_vector_type(2)));
typedef unsigned u32x4 __attribute__((ext_vector_type(4)));
typedef unsigned u32x2 __attribute__((ext_vector_type(2)));

constexpr int NB = 16, SEQ = 4096, D = 1024, T = NB * SEQ;
constexpr int DCONV = 768, DSSM = 256, DIN = 2560, NG = 16, GC = 16, NP = 64;
constexpr int NE = 64, TOPK = 6, DE = 256;
constexpr int LCH = 32;
constexpr int NCHUNK = T / LCH;
constexpr int KU = LCH * GC;
constexpr int KA2 = KU + 2 * NP;
constexpr int MAXBLK = 1600;
constexpr float RMS_EPS = 1e-6f;

constexpr size_t MiB = 1u << 20, KiB = 1u << 10;
constexpr size_t WS_CTL = 0;
constexpr size_t WS_MOD = 64 * KiB;
constexpr size_t WS_AB32 = 448 * KiB;
constexpr size_t WS_BLKE = 512 * KiB;
constexpr size_t WS_WIN_T = 1 * MiB;
constexpr size_t WS_WOUT_T = 6 * MiB;
constexpr size_t WS_WGLU_T = 8 * MiB;
constexpr size_t WS_WS2_T = 8 * MiB + 512 * KiB;
constexpr size_t WS_WSR_T = 9 * MiB;
constexpr size_t WS_T1 = 11 * MiB;
constexpr size_t WS_T2 = 15 * MiB;
constexpr size_t WS_W13T = 25 * MiB;
constexpr size_t WS_W2T = 89 * MiB;
constexpr size_t WS_H = 128 * MiB;
constexpr size_t WS_X1 = 128 * MiB;
constexpr size_t WS_PROJC = 256 * MiB;
constexpr size_t WS_ACT = 256 * MiB;
constexpr size_t WS_ACTS = 456 * MiB;
constexpr size_t WS_ROUTE = 488 * MiB;
constexpr size_t WS_H2 = 512 * MiB;
constexpr size_t WS_Y4 = 512 * MiB;
constexpr size_t WS_YCAT = 640 * MiB;
constexpr size_t WS_LOGITS = 640 * MiB;
constexpr size_t WS_A2 = 768 * MiB;
constexpr size_t WS_S = 808 * MiB;
constexpr size_t WS_YS = 824 * MiB;
constexpr size_t WS_END = 1024 * MiB;
constexpr size_t RT_SELE = 0;
constexpr size_t RT_SELW = 2 * MiB;
constexpr size_t RT_CNTW = 4 * MiB;
constexpr size_t RT_CNTB = 5 * MiB;
constexpr size_t RT_TOK = 6 * MiB;
constexpr size_t RT_WBUF = 8 * MiB;
constexpr size_t RT_DST = 10 * MiB;
constexpr int CW_NBLK = 16;

constexpr int RING_BYTES = 131072;
constexpr int EPI_OFF = RING_BYTES;
constexpr int LDS_BYTES = 147456;

__device__ __forceinline__ unsigned f2bf(float f) { unsigned u = __builtin_bit_cast(unsigned, f); return (u + 0x7fffu + ((u >> 16) & 1u)) >> 16; }
__device__ __forceinline__ unsigned pk2(float lo, float hi) { return f2bf(lo) | (f2bf(hi) << 16); }
__device__ __forceinline__ float bflo(unsigned w) { return __builtin_bit_cast(float, w << 16); }
__device__ __forceinline__ float bfhi(unsigned w) { return __builtin_bit_cast(float, w & 0xffff0000u); }
__device__ __forceinline__ float bf2f(bf16_t b) { return __builtin_bit_cast(float, (unsigned)b << 16); }
__device__ __forceinline__ float sigmoidf_(float v) { return 1.0f / (1.0f + __expf(-v)); }
__device__ __forceinline__ float siluf_(float v) { return v / (1.0f + __expf(-v)); }
__device__ __forceinline__ float gelu_tanh(float v) {
    const float z = 0.7978845608028654f * (v + 0.044715f * v * v * v);
    const float e = __expf(2.0f * z);
    const float th = 1.0f - 2.0f / (e + 1.0f);
    return 0.5f * v * (1.0f + th);
}
__device__ __forceinline__ float wave_sum(float v) {
#pragma unroll
    for (int o = 1; o < 64; o <<= 1) v += __shfl_xor(v, o);
    return v;
}
__device__ __forceinline__ int ld_i32_agent(const int* p) { return __hip_atomic_load(p, __ATOMIC_RELAXED, __HIP_MEMORY_SCOPE_AGENT); }

namespace pg8 {
constexpr int BM = 256, BK = 64, HALF = 128, HTB = HALF * BK * 2, STAGE_BYTES = 8 * HTB;
__device__ __forceinline__ int lds_byte(int r, int c) { const int st = (r >> 4) * 2 + (c >> 5), rr = r & 15, cc = c & 31, ob = rr * 64 + cc * 2; return st * 1024 + (ob ^ (((ob >> 9) & 1) << 5)); }
__device__ __forceinline__ void stage_rc(int b, int& R, int& C) { const int st = b / 1024, sb = b % 1024, swz = sb ^ (((sb >> 9) & 1) << 5); R = (st >> 1) * 16 + swz / 64; C = (st & 1) * 32 + (swz % 64) / 2; }
__device__ __forceinline__ int perm32(int rho) { const int n = rho >> 4, i = rho & 15; return 8 * (i >> 2) + 4 * n + (i & 3); }

struct Unit { const char* A; const char* B; const int* rows; int pm, pn, aux; };
struct Desc { int lda, ldb, K; };

template <class Epi, class Sched, bool GATHER, bool ALIGN_EPI>
__device__ __forceinline__ void gemm_phase(LAS unsigned char* lds, const Desc g, const Sched& S, const Epi& E) {
    const int tid = threadIdx.x, wid = __builtin_amdgcn_readfirstlane(tid >> 6), lane = tid & 63, wr = wid >> 2, wc = wid & 3, fr = lane & 15, fq = lane >> 4;
    const int K = g.K, nt = K / BK;
    int Rr[2], Cc[2]; unsigned voffB[2];
#pragma unroll
    for (int i = 0; i < 2; ++i) { int R, C; stage_rc(tid * 16 + i * 8192, R, C); const int Rb = Epi::PERM ? ((R & ~31) + perm32(R & 31)) : R;
        Rr[i] = R; Cc[i] = C; voffB[i] = (unsigned)(Rb * g.ldb + C) * 2u; }
    const size_t kstep = (size_t)(BK * 2);
    const size_t hstepB = (size_t)HALF * g.ldb * 2;
    const unsigned ldsw = (unsigned)wid * 1024u;
    const int aoff = lds_byte(wr * 64 + fr, fq * 8), boff = lds_byte(wc * 32 + fr, fq * 8);
#define PG8_SA(b, h) (((b) * 2 + (h)) * HTB)
#define PG8_SB(b, h) ((4 + (b) * 2 + (h)) * HTB)
#define PG8_STAGE(bufoff, gbase, v0, v1) do { \
        __builtin_amdgcn_global_load_lds((const unsigned*)((const char*)(gbase) + (v0)), (LAS unsigned*)(lds + (bufoff) + ldsw), 16, 0, 0); \
        __builtin_amdgcn_global_load_lds((const unsigned*)((const char*)(gbase) + (v1)), (LAS unsigned*)(lds + (bufoff) + ldsw + 8192), 16, 0, 0); } while (0)
#define PG8_STAGEB(bufoff, gbase) PG8_STAGE(bufoff, gbase, voffB[0], voffB[1])
#define PG8_LDA(dst, b, h) do { _Pragma("unroll") for (int m = 0; m < 4; ++m) _Pragma("unroll") for (int k = 0; k < 2; ++k) dst[m][k] = *(const LAS bf16x8*)(lds + PG8_SA(b, h) + aoff + m * 2048 + k * 1024); } while (0)
#define PG8_LDB(dst, b, h) do { _Pragma("unroll") for (int n = 0; n < 2; ++n) _Pragma("unroll") for (int k = 0; k < 2; ++k) dst[n][k] = *(const LAS bf16x8*)(lds + PG8_SB(b, h) + boff + n * 2048 + k * 1024); } while (0)
#define PG8_MMA(ai, bj, At, Bt) do { __builtin_amdgcn_s_setprio(1); _Pragma("unroll") for (int m = 0; m < 4; ++m) _Pragma("unroll") for (int n = 0; n < 2; ++n) _Pragma("unroll") for (int k = 0; k < 2; ++k) \
        acc[ai][bj][m][n] = __builtin_amdgcn_mfma_f32_16x16x32_bf16(Bt[n][k], At[m][k], acc[ai][bj][m][n], 0, 0, 0); __builtin_amdgcn_s_setprio(0); } while (0)
#define PG8_WAIT_V(n) asm volatile("s_waitcnt vmcnt(" #n ")" ::: "memory")
#define PG8_WAIT_L(n) asm volatile("s_waitcnt lgkmcnt(" #n ")" ::: "memory")
#define PG8_BAR __builtin_amdgcn_s_barrier()
#define PG8_SCHED __builtin_amdgcn_sched_barrier(0)
    const unsigned hoffA = GATHER ? 0u : (unsigned)(HALF * g.lda) * 2u;
#define PG8_AOFFS(dst, u) do { if constexpr (GATHER) { _Pragma("unroll") for (int h = 0; h < 2; ++h) _Pragma("unroll") for (int i = 0; i < 2; ++i) { \
        const int row_ = (u).rows[h * HALF + Rr[i]]; dst[h][i] = (unsigned)(row_ * g.lda + Cc[i]) * 2u; } \
        asm volatile("" : "+v"(dst[0][0]), "+v"(dst[0][1]), "+v"(dst[1][0]), "+v"(dst[1][1])); } } while (0)
    Unit cur, nxt; int ui = 0;
    if (!S.next(0, cur)) return;
    unsigned cvo[2][2], nvo[2][2];
    if constexpr (GATHER) { PG8_AOFFS(cvo, cur); }
    else {
#pragma unroll
        for (int i = 0; i < 2; ++i) { cvo[0][i] = (unsigned)(Rr[i] * g.lda + Cc[i]) * 2u; cvo[1][i] = cvo[0][i] + hoffA; nvo[0][i] = cvo[0][i]; nvo[1][i] = cvo[1][i]; } }
    f32x4 acc[2][2][4][2];
#pragma unroll
    for (int a = 0; a < 2; ++a)
#pragma unroll
        for (int b = 0; b < 2; ++b)
#pragma unroll
            for (int m = 0; m < 4; ++m)
#pragma unroll
                for (int n = 0; n < 2; ++n) acc[a][b][m][n] = (f32x4){0.f, 0.f, 0.f, 0.f};
    bf16x8 At[4][2], B0[2][2], B1[2][2];
    const char* cA = cur.A; const char* cB = cur.B;
    PG8_STAGEB(PG8_SB(0, 0), cB); PG8_STAGEB(PG8_SB(0, 1), cB + hstepB); PG8_STAGE(PG8_SA(0, 0), cA, cvo[0][0], cvo[0][1]); PG8_STAGE(PG8_SA(0, 1), cA, cvo[1][0], cvo[1][1]);
    if (wr == 1) PG8_BAR;
    PG8_WAIT_V(2); PG8_BAR;
    PG8_STAGEB(PG8_SB(1, 0), cB + kstep); PG8_STAGE(PG8_SA(1, 0), cA + kstep, cvo[0][0], cvo[0][1]); PG8_STAGEB(PG8_SB(1, 1), cB + hstepB + kstep);
    PG8_WAIT_V(6); PG8_BAR;
    for (;;) {
        const bool has_next = S.next(ui + 1, nxt);
        const char* nA = has_next ? nxt.A : cA; const char* nB = has_next ? nxt.B : cB;
        if constexpr (GATHER) { if (has_next) { PG8_AOFFS(nvo, nxt); } else {
#pragma unroll
            for (int h = 0; h < 2; ++h)
#pragma unroll
                for (int i = 0; i < 2; ++i) nvo[h][i] = cvo[h][i]; } }
#pragma nounroll
        for (int t = 0; t < nt; t += 2) {
            const bool last = (t == nt - 2);
            const char* a1 = cA + (size_t)(t + 1) * kstep;
            const char* a2 = last ? nA : cA + (size_t)(t + 2) * kstep; const char* b2 = last ? nB : cB + (size_t)(t + 2) * kstep;
            const char* a3 = a2 + kstep; const char* b3 = b2 + kstep;
            const unsigned o00 = (GATHER && last) ? nvo[0][0] : cvo[0][0], o01 = (GATHER && last) ? nvo[0][1] : cvo[0][1], o10 = (GATHER && last) ? nvo[1][0] : cvo[1][0], o11 = (GATHER && last) ? nvo[1][1] : cvo[1][1];
            PG8_LDB(B0, 0, 0); PG8_LDB(B1, 0, 1); PG8_SCHED; PG8_LDA(At, 0, 0); PG8_STAGE(PG8_SA(1, 1), a1, cvo[1][0], cvo[1][1]);
            PG8_WAIT_V(8); PG8_WAIT_L(0); PG8_BAR; PG8_MMA(0, 0, At, B0); PG8_MMA(0, 1, At, B1); PG8_BAR; PG8_SCHED;
            PG8_LDA(At, 0, 1); PG8_STAGEB(PG8_SB(0, 0), b2); PG8_STAGEB(PG8_SB(0, 1), b2 + hstepB); PG8_STAGE(PG8_SA(0, 0), a2, o00, o01);
            PG8_WAIT_V(8); PG8_WAIT_L(0); PG8_BAR; PG8_MMA(1, 0, At, B0); PG8_MMA(1, 1, At, B1); PG8_BAR; PG8_SCHED;
            PG8_LDB(B0, 1, 0); PG8_LDB(B1, 1, 1); PG8_SCHED; PG8_LDA(At, 1, 0); PG8_STAGE(PG8_SA(0, 1), a2, o10, o11);
            PG8_WAIT_V(8); PG8_WAIT_L(0); PG8_BAR; PG8_MMA(0, 0, At, B0); PG8_MMA(0, 1, At, B1); PG8_BAR; PG8_SCHED;
            PG8_LDA(At, 1, 1); PG8_STAGEB(PG8_SB(1, 0), b3); PG8_STAGEB(PG8_SB(1, 1), b3 + hstepB); PG8_STAGE(PG8_SA(1, 0), a3, o00, o01);
            PG8_WAIT_V(8); PG8_WAIT_L(0); PG8_BAR; PG8_MMA(1, 0, At, B0); PG8_MMA(1, 1, At, B1); PG8_BAR; PG8_SCHED;
        }
        if constexpr (ALIGN_EPI) { if (wr == 0) PG8_BAR; }
        E(acc, cur, wr, wc, fr, fq);
        if (!has_next) break;
#pragma unroll
        for (int a = 0; a < 2; ++a)
#pragma unroll
            for (int b = 0; b < 2; ++b)
#pragma unroll
                for (int m = 0; m < 4; ++m)
#pragma unroll
                    for (int n = 0; n < 2; ++n) acc[a][b][m][n] = (f32x4){0.f, 0.f, 0.f, 0.f};
        cur = nxt; cA = nA; cB = nB; ++ui;
        if constexpr (GATHER) {
#pragma unroll
        for (int h = 0; h < 2; ++h)
#pragma unroll
            for (int i = 0; i < 2; ++i) cvo[h][i] = nvo[h][i]; }
        if constexpr (ALIGN_EPI) { if (wr == 1) PG8_BAR; }
    }
    PG8_WAIT_V(0);
    if constexpr (!ALIGN_EPI) { if (wr == 0) PG8_BAR; }
    PG8_BAR;
#undef PG8_SA
#undef PG8_SB
#undef PG8_STAGE
#undef PG8_STAGEB
#undef PG8_LDA
#undef PG8_LDB
#undef PG8_MMA
#undef PG8_WAIT_V
#undef PG8_WAIT_L
#undef PG8_BAR
#undef PG8_SCHED
#undef PG8_AOFFS
}
}
using pg8::Unit;

struct Args { const float* in[31]; float* out; unsigned char* ws; int ph_lo, ph_hi; };
struct Frame {
    LAS unsigned char* lds; int tid, lane, wave, blk, G, vcu;
    const float *x, *c, *w_ada, *b_ada, *g_mix, *w_in, *conv_w, *conv_b, *g_conv, *lam_re, *lam_im, *log_dt, *b_re, *b_im, *c_re, *c_im,
        *d_skip, *w_glu, *b_glu, *g_ssm, *w_out, *g_ffn, *w_router, *router_bias, *w1, *w3, *w2, *ws1, *ws3, *ws2, *g_final;
    float* out; unsigned char* ws;
};
#define WSP(T_, off) ((T_*)(F.ws + (off)))
#define LDS_WAIT() asm volatile("s_waitcnt lgkmcnt(0)" ::: "memory")
#define VM_WAIT() asm volatile("s_waitcnt vmcnt(0)" ::: "memory")

struct TileOrder {
    int nM, nN, nwg, G, c;
    __device__ __forceinline__ void init(int nM_, int nN_, int G_, int c_) { nM = nM_; nN = nN_; nwg = nM * nN; G = G_; c = c_; }
    __device__ __forceinline__ bool tile(int i, int& pm, int& pn) const {
        const long L = (long)i * G + c; if (L >= nwg) return false;
        int wgid = (int)L; { const int q = nwg / 8, r = nwg % 8, xcd = wgid % 8, off = wgid / 8; wgid = (xcd < r ? xcd * (q + 1) : r * (q + 1) + (xcd - r) * q) + off; }
        const int nig = 8 * nN, gid = wgid / nig, fm = gid * 8, gsz = (nM - fm) < 8 ? (nM - fm) : 8;
        pm = fm + ((wgid % nig) % gsz); pn = (wgid % nig) / gsz; return true;
    }
};

__device__ __forceinline__ void transpose_item(const float* W, int ldw, int k0, int n0, bf16_t* WT, int ldt, int drow0, LAS float* scr, int lane) {
#pragma unroll 8
    for (int i = 0; i < 32; ++i) { const int kk = 2 * i + (lane >> 5); scr[kk * 33 + (lane & 31)] = W[(size_t)(k0 + kk) * ldw + n0 + (lane & 31)]; }
    LDS_WAIT(); asm volatile("" ::: "memory");
    const int c = lane & 7;
#pragma unroll
    for (int j = 0; j < 4; ++j) { const int n = (lane >> 3) + 8 * j; const LAS float* s = scr + (8 * c) * 33 + n;
        u32x4 o; o.x = pk2(s[0 * 33], s[1 * 33]); o.y = pk2(s[2 * 33], s[3 * 33]); o.z = pk2(s[4 * 33], s[5 * 33]); o.w = pk2(s[6 * 33], s[7 * 33]);
        *(u32x4*)(WT + (size_t)(drow0 + n) * ldt + k0 + 8 * c) = o; }
    LDS_WAIT(); asm volatile("" ::: "memory");
}

__device__ __forceinline__ void p0_mod(Frame& F) {
    LAS float* sil = (LAS float*)F.lds;
    LAS float* red = (LAS float*)(F.lds + 65536);
    for (int i = F.tid; i < NB * D; i += 512) { const float v = F.c[i]; sil[i] = v / (1.0f + __expf(-v)); }
    __syncthreads();
    const int col = F.tid & 31, ks = F.tid >> 5, n0 = F.blk * 32;
    float acc[16];
#pragma unroll
    for (int b = 0; b < 16; ++b) acc[b] = 0.f;
    for (int kk = 0; kk < 64; ++kk) { const int k = ks * 64 + kk; const float w = F.w_ada[(size_t)k * 6144 + n0 + col];
#pragma unroll
        for (int b = 0; b < 16; ++b) acc[b] += sil[b * 1024 + k] * w; }
#pragma unroll
    for (int b = 0; b < 16; ++b) red[(ks * 16 + b) * 32 + col] = acc[b];
    __syncthreads();
    { const int b = F.tid >> 5; float s = 0.f;
#pragma unroll
      for (int k2 = 0; k2 < 16; ++k2) s += red[(k2 * 16 + b) * 32 + col];
      WSP(float, WS_MOD)[b * 6144 + n0 + col] = s + F.b_ada[n0 + col]; }
    __syncthreads();
}

__device__ __forceinline__ void p0_s5_tables(Frame& F, int g, int part) {
    LAS f32x2* pw = (LAS f32x2*)F.lds;
    LAS f32x2* Bb = (LAS f32x2*)(F.lds + 20480);
    LAS f32x2* Cc = (LAS f32x2*)(F.lds + 28672);
    LAS float* Kn = (LAS float*)(F.lds + 36864);
    const float dt = expf(F.log_dt[g]);
    for (int i = F.tid; i < 33 * 64; i += 512) { const int tau = i >> 6, p = i & 63; const float lr = F.lam_re[g * 64 + p], li = F.lam_im[g * 64 + p];
        const float mag = expf(lr * dt * (float)tau), ang = li * dt * (float)tau; float sn, cs; sincosf(ang, &sn, &cs); pw[i] = (f32x2){mag * cs, mag * sn}; }
    for (int i = F.tid; i < 1024; i += 512) { const int p = i >> 4, hi = i & 15; const float lr = F.lam_re[g * 64 + p], li = F.lam_im[g * 64 + p];
        const float mag = expf(lr * dt), ang = li * dt; float sn, cs; sincosf(ang, &sn, &cs);
        const float nr = mag * cs - 1.0f, ni = mag * sn, den = lr * lr + li * li, qr = (nr * lr + ni * li) / den, qi = (ni * lr - nr * li) / den;
        const float br = F.b_re[(g * 64 + p) * 16 + hi], bi = F.b_im[(g * 64 + p) * 16 + hi];
        Bb[i] = (f32x2){qr * br - qi * bi, qr * bi + qi * br};
        Cc[i] = (f32x2){F.c_re[g * 1024 + i], F.c_im[g * 1024 + i]}; }
    __syncthreads();
    for (int i = F.tid; i < 8192; i += 512) { const int tau = i >> 8, ho = (i >> 4) & 15, hi = i & 15; float s = 0.f;
        for (int p = 0; p < 64; ++p) { const f32x2 c = Cc[ho * 64 + p], a = pw[tau * 64 + p], b = Bb[p * 16 + hi];
            const float wr_ = c.x * a.x - c.y * a.y, wi_ = c.x * a.y + c.y * a.x; s += wr_ * b.x - wi_ * b.y; }
        Kn[i] = s; }
    __syncthreads();
    bf16_t* T2 = WSP(bf16_t, WS_T2); bf16_t* T1 = WSP(bf16_t, WS_T1);
    for (int i = F.tid; i < 64 * 320; i += 512) { const int n = 64 * part + i / 320, k = 2 * (i % 320), tl = n >> 4, ho = n & 15; float v0, v1;
        if (k < KU) { const int sl = k >> 4, hi = k & 15;
            if (sl <= tl) { v0 = Kn[((tl - sl) * 16 + ho) * 16 + hi]; v1 = Kn[((tl - sl) * 16 + ho) * 16 + hi + 1];
                if (sl == tl) { const float dsk = F.d_skip[g * 16 + ho]; if (hi == ho) v0 += dsk; if (hi + 1 == ho) v1 += dsk; } }
            else { v0 = 0.f; v1 = 0.f; } }
        else { const int p = (k - KU) >> 1; const f32x2 c = Cc[ho * 64 + p], a = pw[(tl + 1) * 64 + p]; v0 = c.x * a.x - c.y * a.y; v1 = -(c.x * a.y + c.y * a.x); }
        *(unsigned*)(T2 + ((size_t)(g * 512 + n) * KA2 + k)) = pk2(v0, v1); }
    for (int i = F.tid; i < 16 * 256; i += 512) { const int n1 = 16 * part + (i >> 8), k = 2 * (i & 255), p = n1 >> 1, ri = n1 & 1, sl = k >> 4, hi = k & 15;
        const f32x2 a = pw[(31 - sl) * 64 + p], b0 = Bb[p * 16 + hi], b1 = Bb[p * 16 + hi + 1];
        const float v0 = ri ? (a.x * b0.y + a.y * b0.x) : (a.x * b0.x - a.y * b0.y), v1 = ri ? (a.x * b1.y + a.y * b1.x) : (a.x * b1.x - a.y * b1.y);
        *(unsigned*)(T1 + ((size_t)(g * 256 + n1) * KU + k)) = pk2(v0, v1);
        *(unsigned*)(T1 + ((size_t)(g * 256 + 128 + n1) * KU + k)) = 0u; }
    if (part == 0 && F.tid < 64) { const f32x2 a = pw[32 * 64 + F.tid]; WSP(f32x2, WS_AB32)[g * 64 + F.tid] = a; }
    __syncthreads();
}

__device__ __forceinline__ void p0_prologue(Frame& F) {
    if (F.blk < 192) p0_mod(F);
    else { for (int it = F.blk - 192; it < 128; it += 64) p0_s5_tables(F, it >> 3, it & 7); }
    __syncthreads();
    { u32x4* z = (u32x4*)(WSP(bf16_t, WS_WSR_T) + (size_t)576 * 1024); const int nz = 192 * 1024 * 2 / 16;
      for (int i = F.blk * 512 + F.tid; i < nz; i += F.G * 512) z[i] = (u32x4){0u, 0u, 0u, 0u}; }
    LAS float* scr = (LAS float*)(F.lds + F.wave * 16384);
    const int gw = F.vcu * 8 + F.wave, NGW = F.G * 8;
    constexpr int I0 = 1280, I1 = 512, I2 = 32, I3 = 128, I4 = 128, I5 = 32, I6 = 128, I7 = 8192, I8 = 8192, I9 = 8192;
    constexpr int NITEMS = I0 + I1 + I2 + I3 + I4 + I5 + I6 + I7 + I8 + I9;
    for (int it = gw; it < NITEMS; it += NGW) {
        int r = it;
        if (r < I0) { const int kb = r / 80, nb = r % 80; transpose_item(F.w_in, DIN, 64 * kb, 32 * nb, WSP(bf16_t, WS_WIN_T), 1024, 32 * nb, scr, F.lane); continue; } r -= I0;
        if (r < I1) { const int kb = r / 32, nb = r % 32; transpose_item(F.w_out, 1024, 64 * kb, 32 * nb, WSP(bf16_t, WS_WOUT_T), 1024, 32 * nb, scr, F.lane); continue; } r -= I1;
        if (r < I2) { const int kb = r / 8, nb = r % 8; transpose_item(F.w_glu, 256, 64 * kb, 32 * nb, WSP(bf16_t, WS_WGLU_T), 256, 32 * nb, scr, F.lane); continue; } r -= I2;
        if (r < I3) { const int kb = r / 8, nb = r % 8, n0 = 32 * nb; transpose_item(F.ws1, 256, 64 * kb, n0, WSP(bf16_t, WS_WSR_T), 1024, (n0 >> 7) * 256 + (n0 & 127), scr, F.lane); continue; } r -= I3;
        if (r < I4) { const int kb = r / 8, nb = r % 8, n0 = 32 * nb; transpose_item(F.ws3, 256, 64 * kb, n0, WSP(bf16_t, WS_WSR_T), 1024, (n0 >> 7) * 256 + 128 + (n0 & 127), scr, F.lane); continue; } r -= I4;
        if (r < I5) { const int kb = r / 2, nb = r % 2; transpose_item(F.w_router, 64, 64 * kb, 32 * nb, WSP(bf16_t, WS_WSR_T), 1024, 512 + 32 * nb, scr, F.lane); continue; } r -= I5;
        if (r < I6) { const int kb = r / 32, nb = r % 32; transpose_item(F.ws2, 1024, 64 * kb, 32 * nb, WSP(bf16_t, WS_WS2_T), 256, 32 * nb, scr, F.lane); continue; } r -= I6;
        if (r < I7) { const int e = r >> 7, q = r & 127, kb = q / 8, nb = q % 8, n0 = 32 * nb;
            transpose_item(F.w1 + (size_t)e * 1024 * 256, 256, 64 * kb, n0, WSP(bf16_t, WS_W13T) + (size_t)e * 512 * 1024, 1024, (n0 >> 7) * 256 + (n0 & 127), scr, F.lane); continue; } r -= I7;
        if (r < I8) { const int e = r >> 7, q = r & 127, kb = q / 8, nb = q % 8, n0 = 32 * nb;
            transpose_item(F.w3 + (size_t)e * 1024 * 256, 256, 64 * kb, n0, WSP(bf16_t, WS_W13T) + (size_t)e * 512 * 1024, 1024, (n0 >> 7) * 256 + 128 + (n0 & 127), scr, F.lane); continue; } r -= I8;
        { const int e = r >> 7, q = r & 127, kb = q / 32, nb = q % 32;
            transpose_item(F.w2 + (size_t)e * 256 * 1024, 1024, 64 * kb, 32 * nb, WSP(bf16_t, WS_W2T) + (size_t)e * 1024 * 256, 256, 32 * nb, scr, F.lane); }
    }
}

__device__ __forceinline__ void p1_h(Frame& F) {
    const float* mod = WSP(float, WS_MOD); bf16_t* H = WSP(bf16_t, WS_H);
    for (int t = F.blk * 8 + F.wave; t < T; t += F.G * 8) {
        const int b = t >> 12; const f32x4* xr = (const f32x4*)(F.x + (size_t)t * D) + F.lane;
        f32x4 v[4]; float ss = 0.f;
#pragma unroll
        for (int j = 0; j < 4; ++j) { v[j] = xr[64 * j]; ss += (v[j].x * v[j].x + v[j].y * v[j].y) + (v[j].z * v[j].z + v[j].w * v[j].w); }
        const float rstd = rsqrtf(wave_sum(ss) * (1.0f / D) + RMS_EPS);
#pragma unroll
        for (int j = 0; j < 4; ++j) { const int c0 = 4 * F.lane + 256 * j;
            const f32x4 gm = *(const f32x4*)(F.g_mix + c0), sh = *(const f32x4*)(mod + b * 6144 + c0), sc = *(const f32x4*)(mod + b * 6144 + 1024 + c0);
            const f32x4 h = v[j] * rstd * gm * (sc + 1.0f) + sh;
            *(u32x2*)(H + (size_t)t * D + c0) = (u32x2){pk2(h.x, h.y), pk2(h.z, h.w)}; }
    }
}

__device__ __forceinline__ u32x4 pack8(const f32x4 a, const f32x4 b) { return (u32x4){pk2(a.x, a.y), pk2(a.z, a.w), pk2(b.x, b.y), pk2(b.z, b.w)}; }
#define EPI_FOR_ROWS _Pragma("unroll") for (int ai = 0; ai < 2; ++ai) _Pragma("unroll") for (int m = 0; m < 4; ++m)
#define EPI_ROWL (ai * 128 + wr * 64 + m * 16 + fr)

struct SchedG1 { TileOrder o; const char* A; const char* B;
    __device__ __forceinline__ bool next(int i, Unit& u) const { int pm, pn; if (!o.tile(i, pm, pn)) return false; u.pm = pm; u.pn = pn; u.aux = 0; u.rows = nullptr;
        u.A = A + (size_t)pm * 256 * 1024 * 2; u.B = B + (size_t)pn * 256 * 1024 * 2; return true; } };
struct EpiG1 { static constexpr bool PERM = true; bf16_t* projc; bf16_t* A2;
    __device__ __forceinline__ void operator()(const f32x4 (&acc)[2][2][4][2], const Unit& u_in, int wr, int wc, int fr_in, int fq_in) const {
        Unit u = u_in; asm volatile("" : "+s"(u.pm), "+s"(u.pn), "+s"(u.aux)); int fr = fr_in, fq = fq_in; asm volatile("" : "+v"(fr), "+v"(fq));
        EPI_FOR_ROWS { const int row = u.pm * 256 + EPI_ROWL;
#pragma unroll
            for (int bj = 0; bj < 2; ++bj) { const int col = bj * 128 + wc * 32 + 8 * fq; const u32x4 w = pack8(acc[ai][bj][m][0], acc[ai][bj][m][1]);
                if (u.pn < 9) *(u32x4*)(projc + (size_t)row * 2304 + u.pn * 256 + col) = w;
                else { const int g = col >> 4, hi0 = col & 15, chunk = row >> 5, sl = row & 31; *(u32x4*)(A2 + ((size_t)(g * NCHUNK + chunk) * KA2 + sl * 16 + hi0)) = w; } } }
    } };

struct SchedS5a { int G, c; const char* A2; const char* T1;
    __device__ __forceinline__ bool next(int i, Unit& u) const { const int L = i * G + c; if (L >= 128) return false; const int g = L >> 3, pm = L & 7; u.pm = pm; u.pn = 0; u.aux = g; u.rows = nullptr;
        u.A = A2 + (size_t)(g * NCHUNK + pm * 256) * KA2 * 2; u.B = T1 + (size_t)g * 256 * KU * 2; return true; } };
struct EpiS5a { static constexpr bool PERM = false; float* S;
    __device__ __forceinline__ void operator()(const f32x4 (&acc)[2][2][4][2], const Unit& u_in, int wr, int wc, int fr_in, int fq_in) const {
        Unit u = u_in; asm volatile("" : "+s"(u.pm), "+s"(u.pn), "+s"(u.aux)); int fr = fr_in, fq = fq_in; asm volatile("" : "+v"(fr), "+v"(fq));
        EPI_FOR_ROWS { const int row = u.pm * 256 + EPI_ROWL;
#pragma unroll
            for (int n = 0; n < 2; ++n) { const int col = wc * 32 + 16 * n + 4 * fq; *(f32x4*)(S + ((size_t)(u.aux * NCHUNK + row) * 128 + col)) = acc[ai][0][m][n]; } }
    } };

struct SchedS5b { int G, c; const char* A2; const char* T2;
    __device__ __forceinline__ bool next(int i, Unit& u) const { const int L = i * G + c; if (L >= 256) return false; const int g = L >> 4, pm = (L >> 1) & 7, pn = L & 1; u.pm = pm; u.pn = pn; u.aux = g; u.rows = nullptr;
        u.A = A2 + (size_t)(g * NCHUNK + pm * 256) * KA2 * 2; u.B = T2 + (size_t)(g * 512 + pn * 256) * KA2 * 2; return true; } };
struct EpiS5b { static constexpr bool PERM = true; bf16_t* ys;
    __device__ __forceinline__ void operator()(const f32x4 (&acc)[2][2][4][2], const Unit& u_in, int wr, int wc, int fr_in, int fq_in) const {
        Unit u = u_in; asm volatile("" : "+s"(u.pm), "+s"(u.pn), "+s"(u.aux)); int fr = fr_in, fq = fq_in; asm volatile("" : "+v"(fr), "+v"(fq));
        EPI_FOR_ROWS { const int chunk = u.pm * 256 + EPI_ROWL;
#pragma unroll
            for (int bj = 0; bj < 2; ++bj) { const int n = u.pn * 256 + bj * 128 + wc * 32 + 8 * fq, tl = n >> 4, ho0 = n & 15; const size_t t = (size_t)chunk * LCH + tl;
                f32x4 a = acc[ai][bj][m][0], b = acc[ai][bj][m][1];
#pragma unroll
                for (int j = 0; j < 4; ++j) { a[j] = gelu_tanh(a[j]); b[j] = gelu_tanh(b[j]); }
                *(u32x4*)(ys + t * 256 + u.aux * 16 + ho0) = pack8(a, b); } }
    } };

struct SchedGlu { int G, c; const char* ys; const char* W;
    __device__ __forceinline__ bool next(int i, Unit& u) const { const int L = i * G + c; if (L >= 256) return false; u.pm = L; u.pn = 0; u.aux = 0; u.rows = nullptr;
        u.A = ys + (size_t)L * 256 * 256 * 2; u.B = W; return true; } };
struct EpiGlu { static constexpr bool PERM = true; const bf16_t* ys; const float* b_glu; const float* g_ssm; bf16_t* ycat; LAS float* scr;
    __device__ __forceinline__ void operator()(f32x4 (&acc)[2][2][4][2], const Unit& u_in, int wr, int wc, int fr_in, int fq_in) const {
        Unit u = u_in; asm volatile("" : "+s"(u.pm), "+s"(u.pn), "+s"(u.aux)); int fr = fr_in, fq = fq_in; asm volatile("" : "+v"(fr), "+v"(fq));
        EPI_FOR_ROWS { const int rl = EPI_ROWL; const size_t row = (size_t)u.pm * 256 + rl; float ss = 0.f;
#pragma unroll
            for (int bj = 0; bj < 2; ++bj) { const int col = bj * 128 + wc * 32 + 8 * fq; const u32x4 yw = *(const u32x4*)(ys + row * 256 + col);
                const f32x4 bg0 = *(const f32x4*)(b_glu + col), bg1 = *(const f32x4*)(b_glu + col + 4);
                const f32x4 y0 = (f32x4){bflo(yw.x), bfhi(yw.x), bflo(yw.y), bfhi(yw.y)}, y1 = (f32x4){bflo(yw.z), bfhi(yw.z), bflo(yw.w), bfhi(yw.w)};
#pragma unroll
                for (int j = 0; j < 4; ++j) { const float o0 = y0[j] * sigmoidf_(acc[ai][bj][m][0][j] + bg0[j]), o1 = y1[j] * sigmoidf_(acc[ai][bj][m][1][j] + bg1[j]);
                    acc[ai][bj][m][0][j] = o0; acc[ai][bj][m][1][j] = o1; ss += o0 * o0 + o1 * o1; } }
            ss += __shfl_xor(ss, 16); ss += __shfl_xor(ss, 32);
            if (fq == 0) scr[rl * 4 + wc] = ss; asm volatile("" ::: "memory"); }
        LDS_WAIT(); __builtin_amdgcn_s_barrier(); asm volatile("" ::: "memory");
        EPI_FOR_ROWS { const int rl = EPI_ROWL; const size_t row = (size_t)u.pm * 256 + rl; const f32x4 p = *(const LAS f32x4*)(scr + rl * 4);
            const float rstd = rsqrtf(((p.x + p.y) + (p.z + p.w)) * (1.0f / 256.0f) + RMS_EPS);
#pragma unroll
            for (int bj = 0; bj < 2; ++bj) { const int col = bj * 128 + wc * 32 + 8 * fq; const f32x4 g0 = *(const f32x4*)(g_ssm + col), g1 = *(const f32x4*)(g_ssm + col + 4);
                *(u32x4*)(ycat + row * 1024 + 768 + col) = pack8(acc[ai][bj][m][0] * rstd * g0, acc[ai][bj][m][1] * rstd * g1); } asm volatile("" ::: "memory"); }
        LDS_WAIT(); __builtin_amdgcn_s_barrier(); asm volatile("" ::: "memory");
    } };

struct SchedG2 { int c; const char* A; const char* B;
    __device__ __forceinline__ bool next(int i, Unit& u) const { if (i >= 4 || c >= 256) return false; u.pm = c; u.pn = i; u.aux = 0; u.rows = nullptr;
        u.A = A + (size_t)c * 256 * 1024 * 2; u.B = B + (size_t)i * 256 * 1024 * 2; return true; } };
struct EpiG2 { static constexpr bool PERM = true; const float* x; const float* mod; bf16_t* x1; LAS float* scr;
    __device__ __forceinline__ void operator()(const f32x4 (&acc)[2][2][4][2], const Unit& u_in, int wr, int wc, int fr_in, int fq_in) const {
        Unit u = u_in; asm volatile("" : "+s"(u.pm), "+s"(u.pn), "+s"(u.aux)); int fr = fr_in, fq = fq_in; asm volatile("" : "+v"(fr), "+v"(fq));
        EPI_FOR_ROWS { const int rl = EPI_ROWL; const size_t row = (size_t)u.pm * 256 + rl; const int b = (int)(row >> 12); float ss = 0.f;
#pragma unroll
            for (int bj = 0; bj < 2; ++bj) { const int col = u.pn * 256 + bj * 128 + wc * 32 + 8 * fq;
                const f32x4 x0 = *(const f32x4*)(x + row * 1024 + col), x1v = *(const f32x4*)(x + row * 1024 + col + 4);
                const f32x4 g0 = *(const f32x4*)(mod + b * 6144 + 2048 + col), g1 = *(const f32x4*)(mod + b * 6144 + 2048 + col + 4);
                const f32x4 o0 = x0 + g0 * acc[ai][bj][m][0], o1 = x1v + g1 * acc[ai][bj][m][1];
                ss += (o0.x * o0.x + o0.y * o0.y) + (o0.z * o0.z + o0.w * o0.w) + (o1.x * o1.x + o1.y * o1.y) + (o1.z * o1.z + o1.w * o1.w);
                *(u32x4*)(x1 + row * 1024 + col) = pack8(o0, o1); }
            ss += __shfl_xor(ss, 16); ss += __shfl_xor(ss, 32);
            if (fq == 0) scr[rl * 16 + u.pn * 4 + wc] = ss; asm volatile("" ::: "memory"); }
    } };

struct SchedRS { TileOrder o; const char* A; const char* B;
    __device__ __forceinline__ bool next(int i, Unit& u) const { int pm, pn; if (!o.tile(i, pm, pn)) return false; u.pm = pm; u.pn = pn; u.aux = 0; u.rows = nullptr;
        u.A = A + (size_t)pm * 256 * 1024 * 2; u.B = B + (size_t)pn * 256 * 1024 * 2; return true; } };
struct EpiRS { static constexpr bool PERM = true; bf16_t* acts; float* logits;
    __device__ __forceinline__ void operator()(const f32x4 (&acc)[2][2][4][2], const Unit& u_in, int wr, int wc, int fr_in, int fq_in) const {
        Unit u = u_in; asm volatile("" : "+s"(u.pm), "+s"(u.pn), "+s"(u.aux)); int fr = fr_in, fq = fq_in; asm volatile("" : "+v"(fr), "+v"(fq));
        EPI_FOR_ROWS { const size_t row = (size_t)u.pm * 256 + EPI_ROWL;
            if (u.pn < 2) { f32x4 o0, o1;
#pragma unroll
                for (int j = 0; j < 4; ++j) { o0[j] = siluf_(acc[ai][0][m][0][j]) * acc[ai][1][m][0][j]; o1[j] = siluf_(acc[ai][0][m][1][j]) * acc[ai][1][m][1][j]; }
                *(u32x4*)(acts + row * 256 + u.pn * 128 + wc * 32 + 8 * fq) = pack8(o0, o1); }
            else if (wc < 2) { const int col = wc * 32 + 8 * fq; *(f32x4*)(logits + row * 64 + col) = acc[ai][0][m][0]; *(f32x4*)(logits + row * 64 + col + 4) = acc[ai][0][m][1]; } }
    } };

struct SchedUp { int G, c, nblk; const int* blk_e; const int* tok; const char* H2; const char* W13;
    __device__ __forceinline__ bool next(int i, Unit& u) const { const int L = i * G + c; if (L >= 2 * nblk) return false; const int j = L >> 1, h = L & 1;
        const int e = __builtin_amdgcn_readfirstlane(ld_i32_agent(blk_e + j)); u.pm = j; u.pn = h; u.aux = e; u.rows = tok + j * 256; u.A = H2; u.B = W13 + (size_t)(e * 2 + h) * 256 * 1024 * 2; return true; } };
struct EpiUp { static constexpr bool PERM = true; bf16_t* act;
    __device__ __forceinline__ void operator()(const f32x4 (&acc)[2][2][4][2], const Unit& u_in, int wr, int wc, int fr_in, int fq_in) const {
        Unit u = u_in; asm volatile("" : "+s"(u.pm), "+s"(u.pn), "+s"(u.aux)); int fr = fr_in, fq = fq_in; asm volatile("" : "+v"(fr), "+v"(fq));
        EPI_FOR_ROWS { const size_t row = (size_t)u.pm * 256 + EPI_ROWL; f32x4 o0, o1;
#pragma unroll
            for (int j = 0; j < 4; ++j) { o0[j] = siluf_(acc[ai][0][m][0][j]) * acc[ai][1][m][0][j]; o1[j] = siluf_(acc[ai][0][m][1][j]) * acc[ai][1][m][1][j]; }
            *(u32x4*)(act + row * 256 + u.pn * 128 + wc * 32 + 8 * fq) = pack8(o0, o1); }
    } };

struct SchedDown { int G, c, nblk; const int* blk_e; const char* act; const char* acts; const char* W2; const char* WS2;
    __device__ __forceinline__ bool next(int i, Unit& u) const { const int L = i * G + c; u.rows = nullptr;
        if (L < 4 * nblk) { const int j = L >> 2, pn = L & 3; const int e = __builtin_amdgcn_readfirstlane(ld_i32_agent(blk_e + j)); u.pm = j; u.pn = pn; u.aux = 0;
            u.A = act + (size_t)j * 256 * 256 * 2; u.B = W2 + (size_t)(e * 1024 + pn * 256) * 256 * 2; return true; }
        const int L2 = L - 4 * nblk; if (L2 >= 1024) return false; u.pm = L2 >> 2; u.pn = L2 & 3; u.aux = 1;
        u.A = acts + (size_t)u.pm * 256 * 256 * 2; u.B = WS2 + (size_t)u.pn * 256 * 256 * 2; return true; } };
struct EpiDown { static constexpr bool PERM = true; const int* dst; const float* wbuf; bf16_t* Y4; bf16_t* outbf; bf16_t* x1; const float* mod;
    __device__ __forceinline__ void operator()(const f32x4 (&acc)[2][2][4][2], const Unit& u_in, int wr, int wc, int fr_in, int fq_in) const {
        Unit u = u_in; asm volatile("" : "+s"(u.pm), "+s"(u.pn), "+s"(u.aux)); int fr = fr_in, fq = fq_in; asm volatile("" : "+v"(fr), "+v"(fq));
        if (u.aux == 0) {
            EPI_FOR_ROWS { const int r = u.pm * 256 + EPI_ROWL; const int d = dst[r]; const float wt = wbuf[r];
                if (d >= 0) { const int tok = d / 6, k = d - tok * 6; bf16_t* p = (k < 4) ? (Y4 + ((size_t)tok * 4 + k) * 1024) : (outbf + ((size_t)tok * 2 + (k - 4)) * 1024);
#pragma unroll
                    for (int bj = 0; bj < 2; ++bj) { const int col = u.pn * 256 + bj * 128 + wc * 32 + 8 * fq; *(u32x4*)(p + col) = pack8(acc[ai][bj][m][0] * wt, acc[ai][bj][m][1] * wt); } } asm volatile("" ::: "memory"); }
        } else {
            EPI_FOR_ROWS { const size_t row = (size_t)u.pm * 256 + EPI_ROWL; const int b = (int)(row >> 12);
#pragma unroll
                for (int bj = 0; bj < 2; ++bj) { const int col = u.pn * 256 + bj * 128 + wc * 32 + 8 * fq; const u32x4 xw = *(const u32x4*)(x1 + row * 1024 + col);
                    const f32x4 g0 = *(const f32x4*)(mod + b * 6144 + 5120 + col), g1 = *(const f32x4*)(mod + b * 6144 + 5120 + col + 4);
                    const f32x4 x0 = (f32x4){bflo(xw.x), bfhi(xw.x), bflo(xw.y), bfhi(xw.y)}, x1v = (f32x4){bflo(xw.z), bfhi(xw.z), bflo(xw.w), bfhi(xw.w)};
                    *(u32x4*)(x1 + row * 1024 + col) = pack8(x0 + g0 * acc[ai][bj][m][0], x1v + g1 * acc[ai][bj][m][1]); } asm volatile("" ::: "memory"); }
        }
    } };

__device__ __forceinline__ void p3_conv(Frame& F) {
    const bf16_t* P = WSP(bf16_t, WS_PROJC); bf16_t* Y = WSP(bf16_t, WS_YCAT);
    for (int chunk = F.blk * 8 + F.wave; chunk < NCHUNK; chunk += F.G * 8) {
        const int t0 = chunk * LCH;
        f32x4 w0[3], w1[3], w2[3], cb[3], gc[3], z1[3], z2[3];
#pragma unroll
        for (int j = 0; j < 3; ++j) { const int c0 = 4 * F.lane + 256 * j;
            w0[j] = *(const f32x4*)(F.conv_w + c0); w1[j] = *(const f32x4*)(F.conv_w + DCONV + c0); w2[j] = *(const f32x4*)(F.conv_w + 2 * DCONV + c0);
            cb[j] = *(const f32x4*)(F.conv_b + c0); gc[j] = *(const f32x4*)(F.g_conv + c0); z1[j] = (f32x4){0.f, 0.f, 0.f, 0.f}; z2[j] = z1[j]; }
        if ((t0 & (SEQ - 1)) != 0) {
#pragma unroll
            for (int j = 0; j < 3; ++j) { const int c0 = 4 * F.lane + 256 * j;
                const u32x2 ca = *(const u32x2*)(P + (size_t)(t0 - 2) * 2304 + 768 + c0), va = *(const u32x2*)(P + (size_t)(t0 - 2) * 2304 + 1536 + c0);
                const u32x2 cb_ = *(const u32x2*)(P + (size_t)(t0 - 1) * 2304 + 768 + c0), vb = *(const u32x2*)(P + (size_t)(t0 - 1) * 2304 + 1536 + c0);
                z2[j] = (f32x4){bflo(ca.x) * bflo(va.x), bfhi(ca.x) * bfhi(va.x), bflo(ca.y) * bflo(va.y), bfhi(ca.y) * bfhi(va.y)};
                z1[j] = (f32x4){bflo(cb_.x) * bflo(vb.x), bfhi(cb_.x) * bfhi(vb.x), bflo(cb_.y) * bflo(vb.y), bfhi(cb_.y) * bfhi(vb.y)}; }
        }
#pragma unroll 2
        for (int tt = 0; tt < LCH; ++tt) { const size_t t = (size_t)t0 + tt; f32x4 val[3]; float ss = 0.f;
#pragma unroll
            for (int j = 0; j < 3; ++j) { const int c0 = 4 * F.lane + 256 * j;
                const u32x2 bw = *(const u32x2*)(P + t * 2304 + c0), cw = *(const u32x2*)(P + t * 2304 + 768 + c0), vw = *(const u32x2*)(P + t * 2304 + 1536 + c0);
                const f32x4 bg = (f32x4){bflo(bw.x), bfhi(bw.x), bflo(bw.y), bfhi(bw.y)};
                const f32x4 z = (f32x4){bflo(cw.x) * bflo(vw.x), bfhi(cw.x) * bfhi(vw.x), bflo(cw.y) * bflo(vw.y), bfhi(cw.y) * bfhi(vw.y)};
                val[j] = bg * (w0[j] * z2[j] + w1[j] * z1[j] + w2[j] * z + cb[j]); z2[j] = z1[j]; z1[j] = z;
                ss += (val[j].x * val[j].x + val[j].y * val[j].y) + (val[j].z * val[j].z + val[j].w * val[j].w); }
            const float rstd = rsqrtf(wave_sum(ss) * (1.0f / DCONV) + RMS_EPS);
#pragma unroll
            for (int j = 0; j < 3; ++j) { const int c0 = 4 * F.lane + 256 * j; const f32x4 o = val[j] * rstd * gc[j];
                *(u32x2*)(Y + t * 1024 + c0) = (u32x2){pk2(o.x, o.y), pk2(o.z, o.w)}; } }
    }
}

__device__ __forceinline__ void p4_scan(Frame& F) {
    if (F.wave != 0) return;
    const float* S = WSP(float, WS_S); bf16_t* A2 = WSP(bf16_t, WS_A2);
    for (int bg = F.blk; bg < NB * NG; bg += F.G) { const int b = bg >> 4, g = bg & 15, p = F.lane;
        const f32x2 a = WSP(f32x2, WS_AB32)[g * 64 + p]; float xr = 0.f, xi = 0.f;
#pragma unroll 8
        for (int c = 0; c < 128; ++c) { const size_t chunk = (size_t)g * NCHUNK + b * 128 + c;
            *(unsigned*)(A2 + chunk * KA2 + KU + 2 * p) = pk2(xr, xi);
            const f32x2 s = *(const f32x2*)(S + chunk * 128 + 2 * p);
            const float nr = a.x * xr - a.y * xi + s.x, ni = a.x * xi + a.y * xr + s.y; xr = nr; xi = ni; }
    }
}

__device__ __forceinline__ void p7_post(Frame& F) {
    const float* mod = WSP(float, WS_MOD); const bf16_t* X1 = WSP(bf16_t, WS_X1); bf16_t* H2 = WSP(bf16_t, WS_H2);
    LAS float* scr = (LAS float*)(F.lds + EPI_OFF);
    VM_WAIT(); LDS_WAIT(); __syncthreads();
    if (F.blk >= 256) return;
    for (int i = 0; i < 32; ++i) { const int rl = F.wave * 32 + i; const size_t row = (size_t)F.blk * 256 + rl; const int b = (int)(row >> 12);
        float tot = 0.f;
#pragma unroll
        for (int q = 0; q < 4; ++q) { const f32x4 pq = *(const LAS f32x4*)(scr + rl * 16 + 4 * q); tot += (pq.x + pq.y) + (pq.z + pq.w); }
        const float rstd = rsqrtf(tot * (1.0f / D) + RMS_EPS);
#pragma unroll
        for (int j = 0; j < 4; ++j) { const int c0 = 4 * F.lane + 256 * j; const u32x2 xw = *(const u32x2*)(X1 + row * 1024 + c0);
            const f32x4 xv = (f32x4){bflo(xw.x), bfhi(xw.x), bflo(xw.y), bfhi(xw.y)};
            const f32x4 gf = *(const f32x4*)(F.g_ffn + c0), sh = *(const f32x4*)(mod + b * 6144 + 3072 + c0), sc = *(const f32x4*)(mod + b * 6144 + 4096 + c0);
            const f32x4 h = xv * rstd * gf * (sc + 1.0f) + sh;
            *(u32x2*)(H2 + row * 1024 + c0) = (u32x2){pk2(h.x, h.y), pk2(h.z, h.w)}; } }
}

__device__ __forceinline__ void p9_topk(Frame& F) {
    const float* LG = WSP(float, WS_LOGITS); unsigned char* R = F.ws + WS_ROUTE;
    int* sele = (int*)(R + RT_SELE); float* selw = (float*)(R + RT_SELW); int* cntw = (int*)(R + RT_CNTW); int* cntb = (int*)(R + RT_CNTB);
    int* tokb = (int*)(R + RT_TOK); int* dstb = (int*)(R + RT_DST);
    LAS int* lcnt = (LAS int*)F.lds;
    const float NEG = -INFINITY;
    for (int blk = F.blk; blk < 256; blk += F.G) {
        for (int i = F.tid; i < MAXBLK; i += 512) { tokb[blk * MAXBLK + i] = 0; dstb[blk * MAXBLK + i] = -1; }
        const int lane = F.lane; const float rb = F.router_bias[lane]; int cnt = 0;
        for (int i = 0; i < 32; ++i) { const int tok = blk * 256 + F.wave * 32 + i;
            const float s = sigmoidf_(LG[(size_t)tok * 64 + lane]), bsd = s + rb;
            float m1 = bsd; int i1 = lane;
#pragma unroll
            for (int o = 1; o < 8; o <<= 1) { const float ov = __shfl_xor(m1, o); const int oi = __shfl_xor(i1, o); if (ov > m1 || (ov == m1 && oi < i1)) { m1 = ov; i1 = oi; } }
            float m2 = (lane == i1) ? NEG : bsd;
#pragma unroll
            for (int o = 1; o < 8; o <<= 1) m2 = fmaxf(m2, __shfl_xor(m2, o));
            const float gs = m1 + m2; const int myg = lane >> 3; int grank = 0;
#pragma unroll
            for (int g2 = 0; g2 < 8; ++g2) { const float s2 = __builtin_bit_cast(float, __builtin_amdgcn_readlane(__builtin_bit_cast(int, gs), 8 * g2)); grank += (s2 > gs || (s2 == gs && g2 < myg)) ? 1 : 0; }
            const float mv = (grank < 4) ? bsd : NEG; int rank = 0;
#pragma unroll
            for (int e2 = 0; e2 < 64; ++e2) { const float v2 = __builtin_bit_cast(float, __builtin_amdgcn_readlane(__builtin_bit_cast(int, mv), e2)); rank += (v2 > mv || (v2 == mv && e2 < lane)) ? 1 : 0; }
            const bool sel = rank < TOPK;
            const float wsum = wave_sum(sel ? s : 0.f);
            if (sel) { sele[(size_t)tok * 6 + rank] = lane | (cnt << 8); selw[(size_t)tok * 6 + rank] = s / wsum * 2.5f; ++cnt; } }
        cntw[(blk * 8 + F.wave) * 64 + lane] = cnt; lcnt[F.wave * 64 + lane] = cnt;
        __syncthreads();
        if (F.tid < 64) { int s = 0;
#pragma unroll
            for (int w = 0; w < 8; ++w) s += lcnt[w * 64 + F.tid];
            cntb[blk * 64 + F.tid] = s; }
        __syncthreads();
    }
}

__device__ __forceinline__ void p10_scatter(Frame& F) {
    unsigned char* R = F.ws + WS_ROUTE;
    const int* sele = (const int*)(R + RT_SELE); const float* selw = (const float*)(R + RT_SELW); const int* cntw = (const int*)(R + RT_CNTW); const int* cntb = (const int*)(R + RT_CNTB);
    int* tokb = (int*)(R + RT_TOK); float* wbuf = (float*)(R + RT_WBUF); int* dstb = (int*)(R + RT_DST);
    LAS int* ptot = (LAS int*)F.lds; LAS int* ppre = ptot + 512; LAS int* pst = ppre + 512; LAS int* pad = pst + 64; LAS int* base = pad + 64;
    for (int blk = F.blk; blk < 256; blk += F.G) {
        { const int p8 = F.tid >> 6, e = F.tid & 63; int tot = 0, pre = 0;
          for (int b2 = 32 * p8; b2 < 32 * p8 + 32; ++b2) { const int c = cntb[b2 * 64 + e]; tot += c; pre += (b2 < blk) ? c : 0; }
          ptot[p8 * 64 + e] = tot; ppre[p8 * 64 + e] = pre; }
        __syncthreads();
        if (F.tid < 64) { const int e = F.tid; int total = 0, bb = 0;
#pragma unroll
            for (int q = 0; q < 8; ++q) { total += ptot[q * 64 + e]; bb += ppre[q * 64 + e]; }
            const int padded = (total + 255) & ~255; int v = padded;
#pragma unroll
            for (int o = 1; o < 64; o <<= 1) { const int tv = __shfl_up(v, o); if (e >= o) v += tv; }
            const int pstart = v - padded; pst[e] = pstart; pad[e] = padded;
            int run = pstart + bb;
#pragma unroll
            for (int w = 0; w < 8; ++w) { base[w * 64 + e] = run; run += cntw[(blk * 8 + w) * 64 + e]; }
            if (blk == 0 && e == 63) { const int nblk = (pstart + padded) >> 8; __hip_atomic_store(WSP(int, WS_CTL) + CW_NBLK, nblk, __ATOMIC_RELAXED, __HIP_MEMORY_SCOPE_AGENT); } }
        __syncthreads();
        for (int a = F.tid; a < 256 * TOPK; a += 512) { const int tl = a / 6, k = a - tl * 6, tok = blk * 256 + tl, w = tl >> 5;
            const int se = sele[(size_t)tok * 6 + k]; const int e = se & 255, r = se >> 8; const int dest = base[w * 64 + e] + r;
            tokb[dest] = tok; wbuf[dest] = selw[(size_t)tok * 6 + k]; dstb[dest] = tok * 6 + k; }
        if (blk == 0) { const int nblk = (pst[63] + pad[63]) >> 8; int* blke = WSP(int, WS_BLKE);
            for (int j = F.tid; j < nblk; j += 512) { const int r0 = j * 256; int e = 0;
                for (int q = 0; q < 64; ++q) if (pad[q] > 0 && pst[q] <= r0 && r0 < pst[q] + pad[q]) e = q;
                blke[j] = e; } }
        __syncthreads();
    }
}

__device__ __forceinline__ void p13_final(Frame& F) {
    const float* mod = WSP(float, WS_MOD); const bf16_t* X1 = WSP(bf16_t, WS_X1); const bf16_t* Y4 = WSP(bf16_t, WS_Y4); const bf16_t* OB = (const bf16_t*)F.out;
    for (int t = F.blk * 8 + F.wave; t < T; t += F.G * 8) { const int b = t >> 12; f32x4 v[4]; float ss = 0.f;
#pragma unroll
        for (int j = 0; j < 4; ++j) { const int c0 = 4 * F.lane + 256 * j; f32x4 ys = (f32x4){0.f, 0.f, 0.f, 0.f};
#pragma unroll
            for (int k = 0; k < 6; ++k) { const u32x2 yw = (k < 4) ? *(const u32x2*)(Y4 + ((size_t)t * 4 + k) * 1024 + c0) : *(const u32x2*)(OB + ((size_t)t * 2 + (k - 4)) * 1024 + c0);
                ys += (f32x4){bflo(yw.x), bfhi(yw.x), bflo(yw.y), bfhi(yw.y)}; }
            const u32x2 xw = *(const u32x2*)(X1 + (size_t)t * 1024 + c0); const f32x4 g2 = *(const f32x4*)(mod + b * 6144 + 5120 + c0);
            v[j] = (f32x4){bflo(xw.x), bfhi(xw.x), bflo(xw.y), bfhi(xw.y)} + g2 * ys;
            ss += (v[j].x * v[j].x + v[j].y * v[j].y) + (v[j].z * v[j].z + v[j].w * v[j].w); }
        const float rstd = rsqrtf(wave_sum(ss) * (1.0f / D) + RMS_EPS);
        asm volatile("" ::: "memory");
#pragma unroll
        for (int j = 0; j < 4; ++j) { const int c0 = 4 * F.lane + 256 * j; const f32x4 gf = *(const f32x4*)(F.g_final + c0);
            *(f32x4*)(F.out + (size_t)t * 1024 + c0) = v[j] * rstd * gf; } }
}

constexpr int N_PHASES = 14;
__global__ void __launch_bounds__(512, 2) mk_fwd(Args args) {
    extern __shared__ __attribute__((aligned(16))) unsigned char lds_raw[];
    Frame F;
    F.lds = (LAS unsigned char*)lds_raw; F.tid = threadIdx.x; F.lane = F.tid & 63; F.wave = __builtin_amdgcn_readfirstlane(F.tid >> 6);
    F.blk = blockIdx.x; F.G = gridDim.x; F.vcu = (F.G % 8 == 0) ? (F.blk % 8) * (F.G / 8) + F.blk / 8 : F.blk;
    { const float* const* in = args.in;
      F.x = in[0]; F.c = in[1]; F.w_ada = in[2]; F.b_ada = in[3]; F.g_mix = in[4]; F.w_in = in[5]; F.conv_w = in[6]; F.conv_b = in[7]; F.g_conv = in[8];
      F.lam_re = in[9]; F.lam_im = in[10]; F.log_dt = in[11]; F.b_re = in[12]; F.b_im = in[13]; F.c_re = in[14]; F.c_im = in[15]; F.d_skip = in[16];
      F.w_glu = in[17]; F.b_glu = in[18]; F.g_ssm = in[19]; F.w_out = in[20]; F.g_ffn = in[21]; F.w_router = in[22]; F.router_bias = in[23];
      F.w1 = in[24]; F.w3 = in[25]; F.w2 = in[26]; F.ws1 = in[27]; F.ws3 = in[28]; F.ws2 = in[29]; F.g_final = in[30]; }
    F.out = args.out; F.ws = args.ws;
    const int lo = args.ph_lo, hi = args.ph_hi;
#ifndef PH_MASK
#define PH_MASK 0xFFFF
#endif
#define IN(k) (((PH_MASK >> (k)) & 1) && lo <= (k) && (k) < hi)
#if MK_N_LAUNCHES == 1
#define SEAM(k) do { if (IN(k) && IN((k) + 1)) { cg::this_grid().sync(); } } while (0)
#else
#define SEAM(k) do { } while (0)
#endif
    LAS unsigned char* ring = F.lds; LAS float* escr = (LAS float*)(F.lds + EPI_OFF);

    if (IN(0)) { p0_prologue(F); } SEAM(0);
    if (IN(1)) { p1_h(F); } SEAM(1);
    if (IN(2)) {
        SchedG1 S; S.o.init(256, 10, F.G, F.blk); S.A = (const char*)WSP(bf16_t, WS_H); S.B = (const char*)WSP(bf16_t, WS_WIN_T);
        EpiG1 E{WSP(bf16_t, WS_PROJC), WSP(bf16_t, WS_A2)};
        pg8::gemm_phase<EpiG1, SchedG1, false, false>(ring, pg8::Desc{1024, 1024, 1024}, S, E);
    } SEAM(2);
    if (IN(3)) {
        p3_conv(F); __syncthreads();
        SchedS5a S{F.G, F.blk, (const char*)WSP(bf16_t, WS_A2), (const char*)WSP(bf16_t, WS_T1)}; EpiS5a E{WSP(float, WS_S)};
        pg8::gemm_phase<EpiS5a, SchedS5a, false, false>(ring, pg8::Desc{KA2, KU, KU}, S, E);
    } SEAM(3);
    if (IN(4)) { p4_scan(F); } SEAM(4);
    if (IN(5)) {
        SchedS5b S{F.G, F.blk, (const char*)WSP(bf16_t, WS_A2), (const char*)WSP(bf16_t, WS_T2)}; EpiS5b E{WSP(bf16_t, WS_YS)};
        pg8::gemm_phase<EpiS5b, SchedS5b, false, false>(ring, pg8::Desc{KA2, KA2, KA2}, S, E);
    } SEAM(5);
    if (IN(6)) {
        SchedGlu S{F.G, F.blk, (const char*)WSP(bf16_t, WS_YS), (const char*)WSP(bf16_t, WS_WGLU_T)};
        EpiGlu E{WSP(bf16_t, WS_YS), F.b_glu, F.g_ssm, WSP(bf16_t, WS_YCAT), escr};
        pg8::gemm_phase<EpiGlu, SchedGlu, false, true>(ring, pg8::Desc{256, 256, 256}, S, E);
    } SEAM(6);
    if (IN(7)) {
        SchedG2 S{F.blk, (const char*)WSP(bf16_t, WS_YCAT), (const char*)WSP(bf16_t, WS_WOUT_T)};
        EpiG2 E{F.x, WSP(float, WS_MOD), WSP(bf16_t, WS_X1), escr};
        pg8::gemm_phase<EpiG2, SchedG2, false, false>(ring, pg8::Desc{1024, 1024, 1024}, S, E);
        p7_post(F);
    } SEAM(7);
    if (IN(8)) {
        SchedRS S; S.o.init(256, 3, F.G, F.blk); S.A = (const char*)WSP(bf16_t, WS_H2); S.B = (const char*)WSP(bf16_t, WS_WSR_T);
        EpiRS E{WSP(bf16_t, WS_ACTS), WSP(float, WS_LOGITS)};
        pg8::gemm_phase<EpiRS, SchedRS, false, false>(ring, pg8::Desc{1024, 1024, 1024}, S, E);
    } SEAM(8);
    if (IN(9)) { p9_topk(F); } SEAM(9);
    if (IN(10)) { p10_scatter(F); } SEAM(10);
    if (IN(11)) {
        const int nblk = __builtin_amdgcn_readfirstlane(ld_i32_agent(WSP(int, WS_CTL) + CW_NBLK));
        SchedUp S{F.G, F.vcu, nblk, WSP(int, WS_BLKE), (const int*)(F.ws + WS_ROUTE + RT_TOK), (const char*)WSP(bf16_t, WS_H2), (const char*)WSP(bf16_t, WS_W13T)};
        EpiUp E{WSP(bf16_t, WS_ACT)};
        pg8::gemm_phase<EpiUp, SchedUp, true, false>(ring, pg8::Desc{1024, 1024, 1024}, S, E);
    } SEAM(11);
    if (IN(12)) {
        const int nblk = __builtin_amdgcn_readfirstlane(ld_i32_agent(WSP(int, WS_CTL) + CW_NBLK));
        SchedDown S{F.G, F.vcu, nblk, WSP(int, WS_BLKE), (const char*)WSP(bf16_t, WS_ACT), (const char*)WSP(bf16_t, WS_ACTS), (const char*)WSP(bf16_t, WS_W2T), (const char*)WSP(bf16_t, WS_WS2_T)};
        EpiDown E{(const int*)(F.ws + WS_ROUTE + RT_DST), (const float*)(F.ws + WS_ROUTE + RT_WBUF), WSP(bf16_t, WS_Y4), (bf16_t*)F.out, WSP(bf16_t, WS_X1), WSP(float, WS_MOD)};
        pg8::gemm_phase<EpiDown, SchedDown, false, false>(ring, pg8::Desc{256, 256, 256}, S, E);
    } SEAM(12);
    if (IN(13)) { p13_final(F); }
#undef IN
#undef SEAM
}

extern "C" void kernel_launch(void* const* d_in, const int* in_sizes, int n_in, void* d_out, int out_size, void* d_ws, size_t ws_size, hipStream_t stream) {
    static int grid = 0;
    if (grid == 0) {
        if (n_in != 31 || in_sizes[0] != T * D || out_size != T * D || ws_size < WS_END) { fprintf(stderr, "kernel_launch: unexpected shapes (n_in %d, in0 %d, out %d, ws %zu)\n", n_in, n_in > 0 ? in_sizes[0] : -1, out_size, ws_size); grid = -1; return; }
        int dev = 0, cus = 0, per_cu = 0;
        if (hipGetDevice(&dev) != hipSuccess || hipDeviceGetAttribute(&cus, hipDeviceAttributeMultiprocessorCount, dev) != hipSuccess) { grid = -1; return; }
        if (hipFuncSetAttribute((const void*)mk_fwd, hipFuncAttributeMaxDynamicSharedMemorySize, LDS_BYTES) != hipSuccess) { fprintf(stderr, "kernel_launch: hipFuncSetAttribute failed\n"); grid = -1; return; }
        if (hipOccupancyMaxActiveBlocksPerMultiprocessor(&per_cu, (const void*)mk_fwd, 512, LDS_BYTES) != hipSuccess || per_cu < 1) { fprintf(stderr, "kernel_launch: occupancy query gives %d\n", per_cu); per_cu = 1; }
        (void)hipGetLastError();
        grid = cus;
        if (grid > 256) grid = 256;
    }
    if (grid < 0) return;
    Args a{};
    for (int i = 0; i < 31; ++i) a.in[i] = (const float*)d_in[i];
    a.out = (float*)d_out; a.ws = (unsigned char*)d_ws;
#if MK_N_LAUNCHES == 1
    a.ph_lo = 0; a.ph_hi = N_PHASES;
    void* kargs[] = {&a};
    hipError_t e = hipLaunchCooperativeKernel((const void*)mk_fwd, dim3(grid), dim3(512), kargs, LDS_BYTES, stream);
    if (e != hipSuccess) fprintf(stderr, "kernel_launch: cooperative launch failed: %s (grid %d)\n", hipGetErrorString(e), grid);
#else
    for (int p = 0; p < N_PHASES; ++p) { a.ph_lo = p; a.ph_hi = p + 1; hipLaunchKernelGGL(mk_fwd, dim3(grid), dim3(512), LDS_BYTES, stream, a); }
#endif
}
```

```cpp
#include <hip/hip_runtime.h>
#include <hip/hip_cooperative_groups.h>
#include <cstdio>
#include <cstdint>
namespace cg = cooperative_groups;

#ifndef MK_N_LAUNCHES
#define MK_N_LAUNCHES 1
#endif

#define LAS __attribute__((address_space(3)))
typedef unsigned short bf16_t;
typedef short bf16x8 __attribute__((ext_vector_type(8)));
typedef float f32x4 __attribute__((ext_vector_type(4)));
typedef float f32x2 __attribute__((ext_vector_type(2)));
typedef unsigned u32x4 __attribute__((ext_vector_type(4)));
typedef unsigned u32x2 __attribute__((ext_vector_type(2)));

constexpr int NB = 16, SEQ = 4096, D = 1024, T = NB * SEQ;
constexpr int DCONV = 768, DSSM = 256, DIN = 2560, NG = 16, GC = 16, NP = 64;
constexpr int NE = 64, TOPK = 6, DE = 256;
constexpr int LCH = 32;
constexpr int NCHUNK = T / LCH;
constexpr int KU = LCH * GC;
constexpr int KA2 = KU + 2 * NP;
constexpr int MAXBLK = 1600;
constexpr float RMS_EPS = 1e-6f;

constexpr size_t MiB = 1u << 20, KiB = 1u << 10;
constexpr size_t WS_CTL = 0;
constexpr size_t WS_MOD = 64 * KiB;
constexpr size_t WS_AB32 = 448 * KiB;
constexpr size_t WS_BLKE = 512 * KiB;
constexpr size_t WS_WIN_T = 1 * MiB;
constexpr size_t WS_WOUT_T = 6 * MiB;
constexpr size_t WS_WGLU_T = 8 * MiB;
constexpr size_t WS_WS2_T = 8 * MiB + 512 * KiB;
constexpr size_t WS_WSR_T = 9 * MiB;
constexpr size_t WS_T1 = 11 * MiB;
constexpr size_t WS_T2 = 15 * MiB;
constexpr size_t WS_W13T = 25 * MiB;
constexpr size_t WS_W2T = 89 * MiB;
constexpr size_t WS_H = 128 * MiB;
constexpr size_t WS_X1 = 128 * MiB;
constexpr size_t WS_PROJC = 256 * MiB;
constexpr size_t WS_ACT = 256 * MiB;
constexpr size_t WS_ACTS = 456 * MiB;
constexpr size_t WS_ROUTE = 488 * MiB;
constexpr size_t WS_H2 = 512 * MiB;
constexpr size_t WS_Y4 = 512 * MiB;
constexpr size_t WS_YCAT = 640 * MiB;
constexpr size_t WS_LOGITS = 640 * MiB;
constexpr size_t WS_A2 = 768 * MiB;
constexpr size_t WS_S = 808 * MiB;
constexpr size_t WS_YS = 824 * MiB;
constexpr size_t WS_END = 1024 * MiB;
constexpr size_t RT_SELE = 0;
constexpr size_t RT_SELW = 2 * MiB;
constexpr size_t RT_CNTW = 4 * MiB;
constexpr size_t RT_CNTB = 5 * MiB;
constexpr size_t RT_TOK = 6 * MiB;
constexpr size_t RT_WBUF = 8 * MiB;
constexpr size_t RT_DST = 10 * MiB;
constexpr int CW_NBLK = 16;
constexpr int CW_BAR = 1024;
constexpr size_t CTL_ZERO_BYTES = 32 * KiB;

constexpr int RING_BYTES = 131072;
constexpr int EPI_OFF = RING_BYTES;
constexpr int MISC_OFF = EPI_OFF + 16384;
constexpr int LDS_BYTES = 148480;

__device__ __forceinline__ unsigned f2bf(float f) { unsigned u = __builtin_bit_cast(unsigned, f); return (u + 0x7fffu + ((u >> 16) & 1u)) >> 16; }
__device__ __forceinline__ unsigned pk2(float lo, float hi) { return f2bf(lo) | (f2bf(hi) << 16); }
__device__ __forceinline__ float bflo(unsigned w) { return __builtin_bit_cast(float, w << 16); }
__device__ __forceinline__ float bfhi(unsigned w) { return __builtin_bit_cast(float, w & 0xffff0000u); }
__device__ __forceinline__ float bf2f(bf16_t b) { return __builtin_bit_cast(float, (unsigned)b << 16); }
__device__ __forceinline__ float sigmoidf_(float v) { return 1.0f / (1.0f + __expf(-v)); }
__device__ __forceinline__ float siluf_(float v) { return v / (1.0f + __expf(-v)); }
__device__ __forceinline__ float gelu_tanh(float v) {
    const float z = 0.7978845608028654f * (v + 0.044715f * v * v * v);
    const float e = __expf(2.0f * z);
    const float th = 1.0f - 2.0f / (e + 1.0f);
    return 0.5f * v * (1.0f + th);
}
__device__ __forceinline__ float wave_sum(float v) {
#pragma unroll
    for (int o = 1; o < 64; o <<= 1) v += __shfl_xor(v, o);
    return v;
}
__device__ __forceinline__ int ld_i32_agent(const int* p) { return __hip_atomic_load(p, __ATOMIC_RELAXED, __HIP_MEMORY_SCOPE_AGENT); }


#define XB_TMO      128
#define XB_XCNT(j)  (256  + 64 * (j))
#define XB_XSUB(j)  (1280 + 64 * (j))
#define XB_XGEN(j)  (2304 + 64 * (j))
#define XB_TOP      3328
#define XB_TOPGEN   3392
#define XCD_BAR_WORDS 3456
#define XB_SPIN_CAP (1u << 22)
__device__ __forceinline__ unsigned xb_ld(unsigned* p)              { return __hip_atomic_load(p, __ATOMIC_RELAXED, __HIP_MEMORY_SCOPE_AGENT); }
__device__ __forceinline__ unsigned xb_add(unsigned* p, unsigned v) { return __hip_atomic_fetch_add(p, v, __ATOMIC_RELAXED, __HIP_MEMORY_SCOPE_AGENT); }
__device__ __forceinline__ unsigned xb_xcc_id() { return (unsigned)__builtin_amdgcn_s_getreg((3 << 11) | 20) & 0xFu; }
#define XB_SPIN(cond, bar) do { unsigned _sp = 0; while (cond) { __builtin_amdgcn_s_sleep(1); \
    if ((++_sp & 255u) == 0u) { if (xb_ld(&(bar)[XB_TMO])) break; if (_sp > XB_SPIN_CAP) { atomicAdd(&(bar)[XB_TMO], 1u); break; } } } } while (0)
struct XcdBarrier { unsigned* bar; unsigned x; volatile LAS unsigned* st; };
__device__ __forceinline__ XcdBarrier xcd_barrier_post(unsigned* bar, volatile LAS unsigned* st) {
    XcdBarrier b; b.bar = bar; b.x = xb_xcc_id(); b.st = st;
    if (threadIdx.x == 0) (void)xb_add(&bar[XB_XCNT(b.x)], 1u);
    return b;
}
__device__ __forceinline__ void xcd_barrier_complete(unsigned* bar, unsigned x, unsigned& nloc, unsigned& nx) {
    const unsigned G = gridDim.x * gridDim.y * gridDim.z;
    unsigned sum, cnt, mine, sp = 0u;
    for (;;) {
        sum = 0u; cnt = 0u; mine = 0u;
#pragma unroll
        for (unsigned j = 0; j < 16; ++j) { const unsigned c = xb_ld(&bar[XB_XCNT(j)]); sum += c; cnt += (c > 0u) ? 1u : 0u; mine = (j == x) ? c : mine; }
        if (sum == G) break;
        __builtin_amdgcn_s_sleep(1);
        if ((++sp & 255u) == 0u) { if (xb_ld(&bar[XB_TMO])) break; if (sp > XB_SPIN_CAP) { atomicAdd(&bar[XB_TMO], 1u); break; } }
    }
    nloc = mine > 0u ? mine : 1u; nx = cnt > 0u ? cnt : 1u;
}
__device__ __forceinline__ void xcd_barrier(const XcdBarrier& b) {
    asm volatile("s_waitcnt vmcnt(0)" ::: "memory");
    __syncthreads();
    if (threadIdx.x == 0) {
        unsigned* bar = b.bar;
        __builtin_amdgcn_s_waitcnt(0);
        unsigned nloc = b.st[0], nx = b.st[1];
        if (nloc == 0u) { xcd_barrier_complete(bar, b.x, nloc, nx); b.st[0] = nloc; b.st[1] = nx; }
        const unsigned old = xb_add(&bar[XB_XSUB(b.x)], 1u);
        const unsigned gen = old / nloc;
        if (old + 1u == (gen + 1u) * nloc) {
            __builtin_amdgcn_fence(__ATOMIC_RELEASE, "agent");
            asm volatile("s_waitcnt vmcnt(0)" ::: "memory");
            const unsigned og = xb_add(&bar[XB_TOP], 1u);
            const unsigned tg = og / nx;
            if (og + 1u == (tg + 1u) * nx) xb_add(&bar[XB_TOPGEN], 1u);
            else XB_SPIN(xb_ld(&bar[XB_TOPGEN]) == tg, bar);
            __builtin_amdgcn_fence(__ATOMIC_ACQUIRE, "agent");
            xb_add(&bar[XB_XGEN(b.x)], 1u);
            asm volatile("s_waitcnt vmcnt(0)" ::: "memory");
        } else {
            XB_SPIN(xb_ld(&bar[XB_XGEN(b.x)]) == gen, bar);
            __builtin_amdgcn_fence(__ATOMIC_ACQUIRE, "agent");
            asm volatile("s_waitcnt vmcnt(0)" ::: "memory");
        }
    }
    __syncthreads();
}

namespace pg8 {
constexpr int BM = 256, BK = 64, HALF = 128, HTB = HALF * BK * 2, STAGE_BYTES = 8 * HTB;
__device__ __forceinline__ int lds_byte(int r, int c) { const int st = (r >> 4) * 2 + (c >> 5), rr = r & 15, cc = c & 31, ob = rr * 64 + cc * 2; return st * 1024 + (ob ^ (((ob >> 9) & 1) << 5)); }
__device__ __forceinline__ void stage_rc(int b, int& R, int& C) { const int st = b / 1024, sb = b % 1024, swz = sb ^ (((sb >> 9) & 1) << 5); R = (st >> 1) * 16 + swz / 64; C = (st & 1) * 32 + (swz % 64) / 2; }
__device__ __forceinline__ int perm32(int rho) { const int n = rho >> 4, i = rho & 15; return 8 * (i >> 2) + 4 * n + (i & 3); }

struct Unit { const char* A; const char* B; const int* rows; int pm, pn, aux; };
struct Desc { int lda, ldb, K; };

template <class Epi, class Sched, bool GATHER, bool ALIGN_EPI>
__device__ __forceinline__ void gemm_phase(LAS unsigned char* lds, const Desc g, const Sched& S, const Epi& E) {
    const int tid = threadIdx.x, wid = __builtin_amdgcn_readfirstlane(tid >> 6), lane = tid & 63, wr = wid >> 2, wc = wid & 3, fr = lane & 15, fq = lane >> 4;
    const int K = g.K, nt = K / BK;
    int Rr[2], Cc[2]; unsigned voffB[2];
#pragma unroll
    for (int i = 0; i < 2; ++i) { int R, C; stage_rc(tid * 16 + i * 8192, R, C); const int Rb = Epi::PERM ? ((R & ~31) + perm32(R & 31)) : R;
        Rr[i] = R; Cc[i] = C; voffB[i] = (unsigned)(Rb * g.ldb + C) * 2u; }
    const size_t kstep = (size_t)(BK * 2);
    const size_t hstepB = (size_t)HALF * g.ldb * 2;
    const unsigned ldsw = (unsigned)wid * 1024u;
    const int aoff = lds_byte(wr * 64 + fr, fq * 8), boff = lds_byte(wc * 32 + fr, fq * 8);
#define PG8_SA(b, h) (((b) * 2 + (h)) * HTB)
#define PG8_SB(b, h) ((4 + (b) * 2 + (h)) * HTB)
#define PG8_STAGE(bufoff, gbase, v0, v1) do { \
        __builtin_amdgcn_global_load_lds((const unsigned*)((const char*)(gbase) + (v0)), (LAS unsigned*)(lds + (bufoff) + ldsw), 16, 0, 0); \
        __builtin_amdgcn_global_load_lds((const unsigned*)((const char*)(gbase) + (v1)), (LAS unsigned*)(lds + (bufoff) + ldsw + 8192), 16, 0, 0); } while (0)
#define PG8_STAGEB(bufoff, gbase) PG8_STAGE(bufoff, gbase, voffB[0], voffB[1])
#define PG8_LDA(dst, b, h) do { _Pragma("unroll") for (int m = 0; m < 4; ++m) _Pragma("unroll") for (int k = 0; k < 2; ++k) dst[m][k] = *(const LAS bf16x8*)(lds + PG8_SA(b, h) + aoff + m * 2048 + k * 1024); } while (0)
#define PG8_LDB(dst, b, h) do { _Pragma("unroll") for (int n = 0; n < 2; ++n) _Pragma("unroll") for (int k = 0; k < 2; ++k) dst[n][k] = *(const LAS bf16x8*)(lds + PG8_SB(b, h) + boff + n * 2048 + k * 1024); } while (0)
#define PG8_MMA(ai, bj, At, Bt) do { __builtin_amdgcn_s_setprio(1); _Pragma("unroll") for (int m = 0; m < 4; ++m) _Pragma("unroll") for (int n = 0; n < 2; ++n) _Pragma("unroll") for (int k = 0; k < 2; ++k) \
        acc[ai][bj][m][n] = __builtin_amdgcn_mfma_f32_16x16x32_bf16(Bt[n][k], At[m][k], acc[ai][bj][m][n], 0, 0, 0); __builtin_amdgcn_s_setprio(0); } while (0)
#define PG8_WAIT_V(n) asm volatile("s_waitcnt vmcnt(" #n ")" ::: "memory")
#define PG8_WAIT_L(n) asm volatile("s_waitcnt lgkmcnt(" #n ")" ::: "memory")
#define PG8_BAR __builtin_amdgcn_s_barrier()
#define PG8_SCHED __builtin_amdgcn_sched_barrier(0)
    const unsigned hoffA = GATHER ? 0u : (unsigned)(HALF * g.lda) * 2u;
#define PG8_AOFFS(dst, u) do { if constexpr (GATHER) { _Pragma("unroll") for (int h = 0; h < 2; ++h) _Pragma("unroll") for (int i = 0; i < 2; ++i) { \
        const int row_ = (u).rows[h * HALF + Rr[i]]; dst[h][i] = (unsigned)(row_ * g.lda + Cc[i]) * 2u; } \
        asm volatile("" : "+v"(dst[0][0]), "+v"(dst[0][1]), "+v"(dst[1][0]), "+v"(dst[1][1])); } } while (0)
    Unit cur, nxt; int ui = 0;
    if (!S.next(0, cur)) return;
    unsigned cvo[2][2], nvo[2][2];
    if constexpr (GATHER) { PG8_AOFFS(cvo, cur); }
    else {
#pragma unroll
        for (int i = 0; i < 2; ++i) { cvo[0][i] = (unsigned)(Rr[i] * g.lda + Cc[i]) * 2u; cvo[1][i] = cvo[0][i] + hoffA; nvo[0][i] = cvo[0][i]; nvo[1][i] = cvo[1][i]; } }
    f32x4 acc[2][2][4][2];
#pragma unroll
    for (int a = 0; a < 2; ++a)
#pragma unroll
        for (int b = 0; b < 2; ++b)
#pragma unroll
            for (int m = 0; m < 4; ++m)
#pragma unroll
                for (int n = 0; n < 2; ++n) acc[a][b][m][n] = (f32x4){0.f, 0.f, 0.f, 0.f};
    bf16x8 At[4][2], B0[2][2], B1[2][2];
    const char* cA = cur.A; const char* cB = cur.B;
    PG8_STAGEB(PG8_SB(0, 0), cB); PG8_STAGEB(PG8_SB(0, 1), cB + hstepB); PG8_STAGE(PG8_SA(0, 0), cA, cvo[0][0], cvo[0][1]); PG8_STAGE(PG8_SA(0, 1), cA, cvo[1][0], cvo[1][1]);
    if (wr == 1) PG8_BAR;
    PG8_WAIT_V(2); PG8_BAR;
    PG8_STAGEB(PG8_SB(1, 0), cB + kstep); PG8_STAGE(PG8_SA(1, 0), cA + kstep, cvo[0][0], cvo[0][1]); PG8_STAGEB(PG8_SB(1, 1), cB + hstepB + kstep);
    PG8_WAIT_V(6); PG8_BAR;
    for (;;) {
        const bool has_next = S.next(ui + 1, nxt);
        const char* nA = has_next ? nxt.A : cA; const char* nB = has_next ? nxt.B : cB;
        if constexpr (GATHER) { if (has_next) { PG8_AOFFS(nvo, nxt); } else {
#pragma unroll
            for (int h = 0; h < 2; ++h)
#pragma unroll
                for (int i = 0; i < 2; ++i) nvo[h][i] = cvo[h][i]; } }
#pragma nounroll
        for (int t = 0; t < nt; t += 2) {
            const bool last = (t == nt - 2);
            const char* a1 = cA + (size_t)(t + 1) * kstep;
            const char* a2 = last ? nA : cA + (size_t)(t + 2) * kstep; const char* b2 = last ? nB : cB + (size_t)(t + 2) * kstep;
            const char* a3 = a2 + kstep; const char* b3 = b2 + kstep;
            const unsigned o00 = (GATHER && last) ? nvo[0][0] : cvo[0][0], o01 = (GATHER && last) ? nvo[0][1] : cvo[0][1], o10 = (GATHER && last) ? nvo[1][0] : cvo[1][0], o11 = (GATHER && last) ? nvo[1][1] : cvo[1][1];
            PG8_LDB(B0, 0, 0); PG8_LDB(B1, 0, 1); PG8_SCHED; PG8_LDA(At, 0, 0); PG8_STAGE(PG8_SA(1, 1), a1, cvo[1][0], cvo[1][1]);
            PG8_WAIT_V(8); PG8_WAIT_L(0); PG8_BAR; PG8_MMA(0, 0, At, B0); PG8_MMA(0, 1, At, B1); PG8_BAR; PG8_SCHED;
            PG8_LDA(At, 0, 1); PG8_STAGEB(PG8_SB(0, 0), b2); PG8_STAGEB(PG8_SB(0, 1), b2 + hstepB); PG8_STAGE(PG8_SA(0, 0), a2, o00, o01);
            PG8_WAIT_V(8); PG8_WAIT_L(0); PG8_BAR; PG8_MMA(1, 0, At, B0); PG8_MMA(1, 1, At, B1); PG8_BAR; PG8_SCHED;
            PG8_LDB(B0, 1, 0); PG8_LDB(B1, 1, 1); PG8_SCHED; PG8_LDA(At, 1, 0); PG8_STAGE(PG8_SA(0, 1), a2, o10, o11);
            PG8_WAIT_V(8); PG8_WAIT_L(0); PG8_BAR; PG8_MMA(0, 0, At, B0); PG8_MMA(0, 1, At, B1); PG8_BAR; PG8_SCHED;
            PG8_LDA(At, 1, 1); PG8_STAGEB(PG8_SB(1, 0), b3); PG8_STAGEB(PG8_SB(1, 1), b3 + hstepB); PG8_STAGE(PG8_SA(1, 0), a3, o00, o01);
            PG8_WAIT_V(8); PG8_WAIT_L(0); PG8_BAR; PG8_MMA(1, 0, At, B0); PG8_MMA(1, 1, At, B1); PG8_BAR; PG8_SCHED;
        }
        if constexpr (ALIGN_EPI) { if (wr == 0) PG8_BAR; }
        E(acc, cur, wr, wc, fr, fq);
        if (!has_next) break;
#pragma unroll
        for (int a = 0; a < 2; ++a)
#pragma unroll
            for (int b = 0; b < 2; ++b)
#pragma unroll
                for (int m = 0; m < 4; ++m)
#pragma unroll
                    for (int n = 0; n < 2; ++n) acc[a][b][m][n] = (f32x4){0.f, 0.f, 0.f, 0.f};
        cur = nxt; cA = nA; cB = nB; ++ui;
        if constexpr (GATHER) {
#pragma unroll
        for (int h = 0; h < 2; ++h)
#pragma unroll
            for (int i = 0; i < 2; ++i) cvo[h][i] = nvo[h][i]; }
        if constexpr (ALIGN_EPI) { if (wr == 1) PG8_BAR; }
    }
    PG8_WAIT_V(0);
    if constexpr (!ALIGN_EPI) { if (wr == 0) PG8_BAR; }
    PG8_BAR;
#undef PG8_SA
#undef PG8_SB
#undef PG8_STAGE
#undef PG8_STAGEB
#undef PG8_LDA
#undef PG8_LDB
#undef PG8_MMA
#undef PG8_WAIT_V
#undef PG8_WAIT_L
#undef PG8_BAR
#undef PG8_SCHED
#undef PG8_AOFFS
}
}
using pg8::Unit;

struct Args { const float* in[31]; float* out; unsigned char* ws; int ph_lo, ph_hi; };
struct Frame {
    LAS unsigned char* lds; int tid, lane, wave, blk, G, vcu;
    const float *x, *c, *w_ada, *b_ada, *g_mix, *w_in, *conv_w, *conv_b, *g_conv, *lam_re, *lam_im, *log_dt, *b_re, *b_im, *c_re, *c_im,
        *d_skip, *w_glu, *b_glu, *g_ssm, *w_out, *g_ffn, *w_router, *router_bias, *w1, *w3, *w2, *ws1, *ws3, *ws2, *g_final;
    float* out; unsigned char* ws; XcdBarrier bar;
};
#define WSP(T_, off) ((T_*)(F.ws + (off)))
#define LDS_WAIT() asm volatile("s_waitcnt lgkmcnt(0)" ::: "memory")
#define VM_WAIT() asm volatile("s_waitcnt vmcnt(0)" ::: "memory")

struct TileOrder {
    int nM, nN, nwg, G, c;
    __device__ __forceinline__ void init(int nM_, int nN_, int G_, int c_) { nM = nM_; nN = nN_; nwg = nM * nN; G = G_; c = c_; }
    __device__ __forceinline__ bool tile(int i, int& pm, int& pn) const {
        const long L = (long)i * G + c; if (L >= nwg) return false;
        int wgid = (int)L; { const int q = nwg / 8, r = nwg % 8, xcd = wgid % 8, off = wgid / 8; wgid = (xcd < r ? xcd * (q + 1) : r * (q + 1) + (xcd - r) * q) + off; }
        const int nig = 8 * nN, gid = wgid / nig, fm = gid * 8, gsz = (nM - fm) < 8 ? (nM - fm) : 8;
        pm = fm + ((wgid % nig) % gsz); pn = (wgid % nig) / gsz; return true;
    }
};

__device__ __forceinline__ void transpose_item(const float* W, int ldw, int k0, int n0, bf16_t* WT, int ldt, int drow0, LAS float* scr, int lane) {
#pragma unroll 8
    for (int i = 0; i < 32; ++i) { const int kk = 2 * i + (lane >> 5); scr[kk * 33 + (lane & 31)] = W[(size_t)(k0 + kk) * ldw + n0 + (lane & 31)]; }
    LDS_WAIT(); asm volatile("" ::: "memory");
    const int c = lane & 7;
#pragma unroll
    for (int j = 0; j < 4; ++j) { const int n = (lane >> 3) + 8 * j; const LAS float* s = scr + (8 * c) * 33 + n;
        u32x4 o; o.x = pk2(s[0 * 33], s[1 * 33]); o.y = pk2(s[2 * 33], s[3 * 33]); o.z = pk2(s[4 * 33], s[5 * 33]); o.w = pk2(s[6 * 33], s[7 * 33]);
        *(u32x4*)(WT + (size_t)(drow0 + n) * ldt + k0 + 8 * c) = o; }
    LDS_WAIT(); asm volatile("" ::: "memory");
}

__device__ __forceinline__ void p0_mod(Frame& F) {
    LAS float* sil = (LAS float*)F.lds;
    LAS float* red = (LAS float*)(F.lds + 65536);
    for (int i = F.tid; i < NB * D; i += 512) { const float v = F.c[i]; sil[i] = v / (1.0f + __expf(-v)); }
    __syncthreads();
    const int col = F.tid & 31, ks = F.tid >> 5, n0 = F.blk * 32;
    float acc[16];
#pragma unroll
    for (int b = 0; b < 16; ++b) acc[b] = 0.f;
    for (int kk = 0; kk < 64; ++kk) { const int k = ks * 64 + kk; const float w = F.w_ada[(size_t)k * 6144 + n0 + col];
#pragma unroll
        for (int b = 0; b < 16; ++b) acc[b] += sil[b * 1024 + k] * w; }
#pragma unroll
    for (int b = 0; b < 16; ++b) red[(ks * 16 + b) * 32 + col] = acc[b];
    __syncthreads();
    { const int b = F.tid >> 5; float s = 0.f;
#pragma unroll
      for (int k2 = 0; k2 < 16; ++k2) s += red[(k2 * 16 + b) * 32 + col];
      WSP(float, WS_MOD)[b * 6144 + n0 + col] = s + F.b_ada[n0 + col]; }
    __syncthreads();
}

__device__ __forceinline__ void p0_s5_tables(Frame& F, int g, int part) {
    LAS f32x2* pw = (LAS f32x2*)F.lds;
    LAS f32x2* Bb = (LAS f32x2*)(F.lds + 20480);
    LAS f32x2* Cc = (LAS f32x2*)(F.lds + 28672);
    LAS float* Kn = (LAS float*)(F.lds + 36864);
    const float dt = expf(F.log_dt[g]);
    for (int i = F.tid; i < 33 * 64; i += 512) { const int tau = i >> 6, p = i & 63; const float lr = F.lam_re[g * 64 + p], li = F.lam_im[g * 64 + p];
        const float mag = expf(lr * dt * (float)tau), ang = li * dt * (float)tau; float sn, cs; sincosf(ang, &sn, &cs); pw[i] = (f32x2){mag * cs, mag * sn}; }
    for (int i = F.tid; i < 1024; i += 512) { const int p = i >> 4, hi = i & 15; const float lr = F.lam_re[g * 64 + p], li = F.lam_im[g * 64 + p];
        const float mag = expf(lr * dt), ang = li * dt; float sn, cs; sincosf(ang, &sn, &cs);
        const float nr = mag * cs - 1.0f, ni = mag * sn, den = lr * lr + li * li, qr = (nr * lr + ni * li) / den, qi = (ni * lr - nr * li) / den;
        const float br = F.b_re[(g * 64 + p) * 16 + hi], bi = F.b_im[(g * 64 + p) * 16 + hi];
        Bb[i] = (f32x2){qr * br - qi * bi, qr * bi + qi * br};
        Cc[i] = (f32x2){F.c_re[g * 1024 + i], F.c_im[g * 1024 + i]}; }
    __syncthreads();
    for (int i = F.tid; i < 8192; i += 512) { const int tau = i >> 8, ho = (i >> 4) & 15, hi = i & 15; float s = 0.f;
        for (int p = 0; p < 64; ++p) { const f32x2 c = Cc[ho * 64 + p], a = pw[tau * 64 + p], b = Bb[p * 16 + hi];
            const float wr_ = c.x * a.x - c.y * a.y, wi_ = c.x * a.y + c.y * a.x; s += wr_ * b.x - wi_ * b.y; }
        Kn[i] = s; }
    __syncthreads();
    bf16_t* T2 = WSP(bf16_t, WS_T2); bf16_t* T1 = WSP(bf16_t, WS_T1);
    for (int i = F.tid; i < 64 * 320; i += 512) { const int n = 64 * part + i / 320, k = 2 * (i % 320), tl = n >> 4, ho = n & 15; float v0, v1;
        if (k < KU) { const int sl = k >> 4, hi = k & 15;
            if (sl <= tl) { v0 = Kn[((tl - sl) * 16 + ho) * 16 + hi]; v1 = Kn[((tl - sl) * 16 + ho) * 16 + hi + 1];
                if (sl == tl) { const float dsk = F.d_skip[g * 16 + ho]; if (hi == ho) v0 += dsk; if (hi + 1 == ho) v1 += dsk; } }
            else { v0 = 0.f; v1 = 0.f; } }
        else { const int p = (k - KU) >> 1; const f32x2 c = Cc[ho * 64 + p], a = pw[(tl + 1) * 64 + p]; v0 = c.x * a.x - c.y * a.y; v1 = -(c.x * a.y + c.y * a.x); }
        *(unsigned*)(T2 + ((size_t)(g * 512 + n) * KA2 + k)) = pk2(v0, v1); }
    for (int i = F.tid; i < 16 * 256; i += 512) { const int n1 = 16 * part + (i >> 8), k = 2 * (i & 255), p = n1 >> 1, ri = n1 & 1, sl = k >> 4, hi = k & 15;
        const f32x2 a = pw[(31 - sl) * 64 + p], b0 = Bb[p * 16 + hi], b1 = Bb[p * 16 + hi + 1];
        const float v0 = ri ? (a.x * b0.y + a.y * b0.x) : (a.x * b0.x - a.y * b0.y), v1 = ri ? (a.x * b1.y + a.y * b1.x) : (a.x * b1.x - a.y * b1.y);
        *(unsigned*)(T1 + ((size_t)(g * 256 + n1) * KU + k)) = pk2(v0, v1);
        *(unsigned*)(T1 + ((size_t)(g * 256 + 128 + n1) * KU + k)) = 0u; }
    if (part == 0 && F.tid < 64) { const f32x2 a = pw[32 * 64 + F.tid]; WSP(f32x2, WS_AB32)[g * 64 + F.tid] = a; }
    __syncthreads();
}

__device__ __forceinline__ void p0_prologue(Frame& F) {
    if (F.blk < 192) p0_mod(F);
    else { for (int it = F.blk - 192; it < 128; it += 64) p0_s5_tables(F, it >> 3, it & 7); }
    __syncthreads();
    { u32x4* z = (u32x4*)(WSP(bf16_t, WS_WSR_T) + (size_t)576 * 1024); const int nz = 192 * 1024 * 2 / 16;
      for (int i = F.blk * 512 + F.tid; i < nz; i += F.G * 512) z[i] = (u32x4){0u, 0u, 0u, 0u}; }
    LAS float* scr = (LAS float*)(F.lds + F.wave * 16384);
    const int gw = F.vcu * 8 + F.wave, NGW = F.G * 8;
    constexpr int I0 = 1280, I1 = 512, I2 = 32, I3 = 128, I4 = 128, I5 = 32, I6 = 128, I7 = 8192, I8 = 8192, I9 = 8192;
    constexpr int NITEMS = I0 + I1 + I2 + I3 + I4 + I5 + I6 + I7 + I8 + I9;
    for (int it = gw; it < NITEMS; it += NGW) {
        int r = it;
        if (r < I0) { const int kb = r / 80, nb = r % 80; transpose_item(F.w_in, DIN, 64 * kb, 32 * nb, WSP(bf16_t, WS_WIN_T), 1024, 32 * nb, scr, F.lane); continue; } r -= I0;
        if (r < I1) { const int kb = r / 32, nb = r % 32; transpose_item(F.w_out, 1024, 64 * kb, 32 * nb, WSP(bf16_t, WS_WOUT_T), 1024, 32 * nb, scr, F.lane); continue; } r -= I1;
        if (r < I2) { const int kb = r / 8, nb = r % 8; transpose_item(F.w_glu, 256, 64 * kb, 32 * nb, WSP(bf16_t, WS_WGLU_T), 256, 32 * nb, scr, F.lane); continue; } r -= I2;
        if (r < I3) { const int kb = r / 8, nb = r % 8, n0 = 32 * nb; transpose_item(F.ws1, 256, 64 * kb, n0, WSP(bf16_t, WS_WSR_T), 1024, (n0 >> 7) * 256 + (n0 & 127), scr, F.lane); continue; } r -= I3;
        if (r < I4) { const int kb = r / 8, nb = r % 8, n0 = 32 * nb; transpose_item(F.ws3, 256, 64 * kb, n0, WSP(bf16_t, WS_WSR_T), 1024, (n0 >> 7) * 256 + 128 + (n0 & 127), scr, F.lane); continue; } r -= I4;
        if (r < I5) { const int kb = r / 2, nb = r % 2; transpose_item(F.w_router, 64, 64 * kb, 32 * nb, WSP(bf16_t, WS_WSR_T), 1024, 512 + 32 * nb, scr, F.lane); continue; } r -= I5;
        if (r < I6) { const int kb = r / 32, nb = r % 32; transpose_item(F.ws2, 1024, 64 * kb, 32 * nb, WSP(bf16_t, WS_WS2_T), 256, 32 * nb, scr, F.lane); continue; } r -= I6;
        if (r < I7) { const int e = r >> 7, q = r & 127, kb = q / 8, nb = q % 8, n0 = 32 * nb;
            transpose_item(F.w1 + (size_t)e * 1024 * 256, 256, 64 * kb, n0, WSP(bf16_t, WS_W13T) + (size_t)e * 512 * 1024, 1024, (n0 >> 7) * 256 + (n0 & 127), scr, F.lane); continue; } r -= I7;
        if (r < I8) { const int e = r >> 7, q = r & 127, kb = q / 8, nb = q % 8, n0 = 32 * nb;
            transpose_item(F.w3 + (size_t)e * 1024 * 256, 256, 64 * kb, n0, WSP(bf16_t, WS_W13T) + (size_t)e * 512 * 1024, 1024, (n0 >> 7) * 256 + 128 + (n0 & 127), scr, F.lane); continue; } r -= I8;
        { const int e = r >> 7, q = r & 127, kb = q / 32, nb = q % 32;
            transpose_item(F.w2 + (size_t)e * 256 * 1024, 1024, 64 * kb, 32 * nb, WSP(bf16_t, WS_W2T) + (size_t)e * 1024 * 256, 256, 32 * nb, scr, F.lane); }
    }
}

__device__ __forceinline__ void p1_h(Frame& F) {
    const float* mod = WSP(float, WS_MOD); bf16_t* H = WSP(bf16_t, WS_H);
    for (int t = F.blk * 8 + F.wave; t < T; t += F.G * 8) {
        const int b = t >> 12; const f32x4* xr = (const f32x4*)(F.x + (size_t)t * D) + F.lane;
        f32x4 v[4]; float ss = 0.f;
#pragma unroll
        for (int j = 0; j < 4; ++j) { v[j] = xr[64 * j]; ss += (v[j].x * v[j].x + v[j].y * v[j].y) + (v[j].z * v[j].z + v[j].w * v[j].w); }
        const float rstd = rsqrtf(wave_sum(ss) * (1.0f / D) + RMS_EPS);
#pragma unroll
        for (int j = 0; j < 4; ++j) { const int c0 = 4 * F.lane + 256 * j;
            const f32x4 gm = *(const f32x4*)(F.g_mix + c0), sh = *(const f32x4*)(mod + b * 6144 + c0), sc = *(const f32x4*)(mod + b * 6144 + 1024 + c0);
            const f32x4 h = v[j] * rstd * gm * (sc + 1.0f) + sh;
            *(u32x2*)(H + (size_t)t * D + c0) = (u32x2){pk2(h.x, h.y), pk2(h.z, h.w)}; }
    }
}

__device__ __forceinline__ u32x4 pack8(const f32x4 a, const f32x4 b) { return (u32x4){pk2(a.x, a.y), pk2(a.z, a.w), pk2(b.x, b.y), pk2(b.z, b.w)}; }
#define EPI_FOR_ROWS _Pragma("unroll") for (int ai = 0; ai < 2; ++ai) _Pragma("unroll") for (int m = 0; m < 4; ++m)
#define EPI_ROWL (ai * 128 + wr * 64 + m * 16 + fr)

struct SchedG1 { TileOrder o; const char* A; const char* B;
    __device__ __forceinline__ bool next(int i, Unit& u) const { int pm, pn; if (!o.tile(i, pm, pn)) return false; u.pm = pm; u.pn = pn; u.aux = 0; u.rows = nullptr;
        u.A = A + (size_t)pm * 256 * 1024 * 2; u.B = B + (size_t)pn * 256 * 1024 * 2; return true; } };
struct EpiG1 { static constexpr bool PERM = true; bf16_t* projc; bf16_t* A2;
    __device__ __forceinline__ void operator()(const f32x4 (&acc)[2][2][4][2], const Unit& u_in, int wr, int wc, int fr_in, int fq_in) const {
        Unit u = u_in; asm volatile("" : "+s"(u.pm), "+s"(u.pn), "+s"(u.aux)); int fr = fr_in, fq = fq_in; asm volatile("" : "+v"(fr), "+v"(fq));
        EPI_FOR_ROWS { const int row = u.pm * 256 + EPI_ROWL;
#pragma unroll
            for (int bj = 0; bj < 2; ++bj) { const int col = bj * 128 + wc * 32 + 8 * fq; const u32x4 w = pack8(acc[ai][bj][m][0], acc[ai][bj][m][1]);
                if (u.pn < 9) *(u32x4*)(projc + (size_t)row * 2304 + u.pn * 256 + col) = w;
                else { const int g = col >> 4, hi0 = col & 15, chunk = row >> 5, sl = row & 31; *(u32x4*)(A2 + ((size_t)(g * NCHUNK + chunk) * KA2 + sl * 16 + hi0)) = w; } } }
    } };

struct SchedS5a { int G, c; const char* A2; const char* T1;
    __device__ __forceinline__ bool next(int i, Unit& u) const { const int L = i * G + c; if (L >= 128) return false; const int g = L >> 3, pm = L & 7; u.pm = pm; u.pn = 0; u.aux = g; u.rows = nullptr;
        u.A = A2 + (size_t)(g * NCHUNK + pm * 256) * KA2 * 2; u.B = T1 + (size_t)g * 256 * KU * 2; return true; } };
struct EpiS5a { static constexpr bool PERM = false; float* S;
    __device__ __forceinline__ void operator()(const f32x4 (&acc)[2][2][4][2], const Unit& u_in, int wr, int wc, int fr_in, int fq_in) const {
        Unit u = u_in; asm volatile("" : "+s"(u.pm), "+s"(u.pn), "+s"(u.aux)); int fr = fr_in, fq = fq_in; asm volatile("" : "+v"(fr), "+v"(fq));
        EPI_FOR_ROWS { const int row = u.pm * 256 + EPI_ROWL;
#pragma unroll
            for (int n = 0; n < 2; ++n) { const int col = wc * 32 + 16 * n + 4 * fq; *(f32x4*)(S + ((size_t)(u.aux * NCHUNK + row) * 128 + col)) = acc[ai][0][m][n]; } }
    } };

struct SchedS5b { int G, c; const char* A2; const char* T2;
    __device__ __forceinline__ bool next(int i, Unit& u) const { const int L = i * G + c; if (L >= 256) return false; const int g = L >> 4, pm = (L >> 1) & 7, pn = L & 1; u.pm = pm; u.pn = pn; u.aux = g; u.rows = nullptr;
        u.A = A2 + (size_t)(g * NCHUNK + pm * 256) * KA2 * 2; u.B = T2 + (size_t)(g * 512 + pn * 256) * KA2 * 2; return true; } };
struct EpiS5b { static constexpr bool PERM = true; bf16_t* ys;
    __device__ __forceinline__ void operator()(const f32x4 (&acc)[2][2][4][2], const Unit& u_in, int wr, int wc, int fr_in, int fq_in) const {
        Unit u = u_in; asm volatile("" : "+s"(u.pm), "+s"(u.pn), "+s"(u.aux)); int fr = fr_in, fq = fq_in; asm volatile("" : "+v"(fr), "+v"(fq));
        EPI_FOR_ROWS { const int chunk = u.pm * 256 + EPI_ROWL;
#pragma unroll
            for (int bj = 0; bj < 2; ++bj) { const int n = u.pn * 256 + bj * 128 + wc * 32 + 8 * fq, tl = n >> 4, ho0 = n & 15; const size_t t = (size_t)chunk * LCH + tl;
                f32x4 a = acc[ai][bj][m][0], b = acc[ai][bj][m][1];
#pragma unroll
                for (int j = 0; j < 4; ++j) { a[j] = gelu_tanh(a[j]); b[j] = gelu_tanh(b[j]); }
                *(u32x4*)(ys + t * 256 + u.aux * 16 + ho0) = pack8(a, b); } }
    } };

struct SchedGlu { int G, c; const char* ys; const char* W;
    __device__ __forceinline__ bool next(int i, Unit& u) const { const int L = i * G + c; if (L >= 256) return false; u.pm = L; u.pn = 0; u.aux = 0; u.rows = nullptr;
        u.A = ys + (size_t)L * 256 * 256 * 2; u.B = W; return true; } };
struct EpiGlu { static constexpr bool PERM = true; const bf16_t* ys; const float* b_glu; const float* g_ssm; bf16_t* ycat; LAS float* scr;
    __device__ __forceinline__ void operator()(f32x4 (&acc)[2][2][4][2], const Unit& u_in, int wr, int wc, int fr_in, int fq_in) const {
        Unit u = u_in; asm volatile("" : "+s"(u.pm), "+s"(u.pn), "+s"(u.aux)); int fr = fr_in, fq = fq_in; asm volatile("" : "+v"(fr), "+v"(fq));
        EPI_FOR_ROWS { const int rl = EPI_ROWL; const size_t row = (size_t)u.pm * 256 + rl; float ss = 0.f;
#pragma unroll
            for (int bj = 0; bj < 2; ++bj) { const int col = bj * 128 + wc * 32 + 8 * fq; const u32x4 yw = *(const u32x4*)(ys + row * 256 + col);
                const f32x4 bg0 = *(const f32x4*)(b_glu + col), bg1 = *(const f32x4*)(b_glu + col + 4);
                const f32x4 y0 = (f32x4){bflo(yw.x), bfhi(yw.x), bflo(yw.y), bfhi(yw.y)}, y1 = (f32x4){bflo(yw.z), bfhi(yw.z), bflo(yw.w), bfhi(yw.w)};
#pragma unroll
                for (int j = 0; j < 4; ++j) { const float o0 = y0[j] * sigmoidf_(acc[ai][bj][m][0][j] + bg0[j]), o1 = y1[j] * sigmoidf_(acc[ai][bj][m][1][j] + bg1[j]);
                    acc[ai][bj][m][0][j] = o0; acc[ai][bj][m][1][j] = o1; ss += o0 * o0 + o1 * o1; } }
            ss += __shfl_xor(ss, 16); ss += __shfl_xor(ss, 32);
            if (fq == 0) scr[rl * 4 + wc] = ss; asm volatile("" ::: "memory"); }
        LDS_WAIT(); __builtin_amdgcn_s_barrier(); asm volatile("" ::: "memory");
        EPI_FOR_ROWS { const int rl = EPI_ROWL; const size_t row = (size_t)u.pm * 256 + rl; const f32x4 p = *(const LAS f32x4*)(scr + rl * 4);
            const float rstd = rsqrtf(((p.x + p.y) + (p.z + p.w)) * (1.0f / 256.0f) + RMS_EPS);
#pragma unroll
            for (int bj = 0; bj < 2; ++bj) { const int col = bj * 128 + wc * 32 + 8 * fq; const f32x4 g0 = *(const f32x4*)(g_ssm + col), g1 = *(const f32x4*)(g_ssm + col + 4);
                *(u32x4*)(ycat + row * 1024 + 768 + col) = pack8(acc[ai][bj][m][0] * rstd * g0, acc[ai][bj][m][1] * rstd * g1); } asm volatile("" ::: "memory"); }
        LDS_WAIT(); __builtin_amdgcn_s_barrier(); asm volatile("" ::: "memory");
    } };

struct SchedG2 { int c; const char* A; const char* B;
    __device__ __forceinline__ bool next(int i, Unit& u) const { if (i >= 4 || c >= 256) return false; u.pm = c; u.pn = i; u.aux = 0; u.rows = nullptr;
        u.A = A + (size_t)c * 256 * 1024 * 2; u.B = B + (size_t)i * 256 * 1024 * 2; return true; } };
struct EpiG2 { static constexpr bool PERM = true; const float* x; const float* mod; bf16_t* x1; LAS float* scr;
    __device__ __forceinline__ void operator()(const f32x4 (&acc)[2][2][4][2], const Unit& u_in, int wr, int wc, int fr_in, int fq_in) const {
        Unit u = u_in; asm volatile("" : "+s"(u.pm), "+s"(u.pn), "+s"(u.aux)); int fr = fr_in, fq = fq_in; asm volatile("" : "+v"(fr), "+v"(fq));
        EPI_FOR_ROWS { const int rl = EPI_ROWL; const size_t row = (size_t)u.pm * 256 + rl; const int b = (int)(row >> 12); float ss = 0.f;
#pragma unroll
            for (int bj = 0; bj < 2; ++bj) { const int col = u.pn * 256 + bj * 128 + wc * 32 + 8 * fq;
                const f32x4 x0 = *(const f32x4*)(x + row * 1024 + col), x1v = *(const f32x4*)(x + row * 1024 + col + 4);
                const f32x4 g0 = *(const f32x4*)(mod + b * 6144 + 2048 + col), g1 = *(const f32x4*)(mod + b * 6144 + 2048 + col + 4);
                const f32x4 o0 = x0 + g0 * acc[ai][bj][m][0], o1 = x1v + g1 * acc[ai][bj][m][1];
                ss += (o0.x * o0.x + o0.y * o0.y) + (o0.z * o0.z + o0.w * o0.w) + (o1.x * o1.x + o1.y * o1.y) + (o1.z * o1.z + o1.w * o1.w);
                *(u32x4*)(x1 + row * 1024 + col) = pack8(o0, o1); }
            ss += __shfl_xor(ss, 16); ss += __shfl_xor(ss, 32);
            if (fq == 0) scr[rl * 16 + u.pn * 4 + wc] = ss; asm volatile("" ::: "memory"); }
    } };

struct SchedRS { TileOrder o; const char* A; const char* B;
    __device__ __forceinline__ bool next(int i, Unit& u) const { int pm, pn; if (!o.tile(i, pm, pn)) return false; u.pm = pm; u.pn = pn; u.aux = 0; u.rows = nullptr;
        u.A = A + (size_t)pm * 256 * 1024 * 2; u.B = B + (size_t)pn * 256 * 1024 * 2; return true; } };
struct EpiRS { static constexpr bool PERM = true; bf16_t* acts; float* logits;
    __device__ __forceinline__ void operator()(const f32x4 (&acc)[2][2][4][2], const Unit& u_in, int wr, int wc, int fr_in, int fq_in) const {
        Unit u = u_in; asm volatile("" : "+s"(u.pm), "+s"(u.pn), "+s"(u.aux)); int fr = fr_in, fq = fq_in; asm volatile("" : "+v"(fr), "+v"(fq));
        EPI_FOR_ROWS { const size_t row = (size_t)u.pm * 256 + EPI_ROWL;
            if (u.pn < 2) { f32x4 o0, o1;
#pragma unroll
                for (int j = 0; j < 4; ++j) { o0[j] = siluf_(acc[ai][0][m][0][j]) * acc[ai][1][m][0][j]; o1[j] = siluf_(acc[ai][0][m][1][j]) * acc[ai][1][m][1][j]; }
                *(u32x4*)(acts + row * 256 + u.pn * 128 + wc * 32 + 8 * fq) = pack8(o0, o1); }
            else if (wc < 2) { const int col = wc * 32 + 8 * fq; *(f32x4*)(logits + row * 64 + col) = acc[ai][0][m][0]; *(f32x4*)(logits + row * 64 + col + 4) = acc[ai][0][m][1]; } }
    } };

struct SchedUp { int G, c, nblk; const int* blk_e; const int* tok; const char* H2; const char* W13;
    __device__ __forceinline__ bool next(int i, Unit& u) const { const int L = i * G + c; if (L >= 2 * nblk) return false; const int j = L >> 1, h = L & 1;
        const int e = __builtin_amdgcn_readfirstlane(ld_i32_agent(blk_e + j)); u.pm = j; u.pn = h; u.aux = e; u.rows = tok + j * 256; u.A = H2; u.B = W13 + (size_t)(e * 2 + h) * 256 * 1024 * 2; return true; } };
struct EpiUp { static constexpr bool PERM = true; bf16_t* act;
    __device__ __forceinline__ void operator()(const f32x4 (&acc)[2][2][4][2], const Unit& u_in, int wr, int wc, int fr_in, int fq_in) const {
        Unit u = u_in; asm volatile("" : "+s"(u.pm), "+s"(u.pn), "+s"(u.aux)); int fr = fr_in, fq = fq_in; asm volatile("" : "+v"(fr), "+v"(fq));
        EPI_FOR_ROWS { const size_t row = (size_t)u.pm * 256 + EPI_ROWL; f32x4 o0, o1;
#pragma unroll
            for (int j = 0; j < 4; ++j) { o0[j] = siluf_(acc[ai][0][m][0][j]) * acc[ai][1][m][0][j]; o1[j] = siluf_(acc[ai][0][m][1][j]) * acc[ai][1][m][1][j]; }
            *(u32x4*)(act + row * 256 + u.pn * 128 + wc * 32 + 8 * fq) = pack8(o0, o1); }
    } };

struct SchedDown { int G, c, nblk; const int* blk_e; const char* act; const char* acts; const char* W2; const char* WS2;
    __device__ __forceinline__ bool next(int i, Unit& u) const { const int L = i * G + c; u.rows = nullptr;
        if (L < 4 * nblk) { const int j = L >> 2, pn = L & 3; const int e = __builtin_amdgcn_readfirstlane(ld_i32_agent(blk_e + j)); u.pm = j; u.pn = pn; u.aux = 0;
            u.A = act + (size_t)j * 256 * 256 * 2; u.B = W2 + (size_t)(e * 1024 + pn * 256) * 256 * 2; return true; }
        const int L2 = L - 4 * nblk; if (L2 >= 1024) return false; u.pm = L2 >> 2; u.pn = L2 & 3; u.aux = 1;
        u.A = acts + (size_t)u.pm * 256 * 256 * 2; u.B = WS2 + (size_t)u.pn * 256 * 256 * 2; return true; } };
struct EpiDown { static constexpr bool PERM = true; const int* dst; const float* wbuf; bf16_t* Y4; bf16_t* outbf; bf16_t* x1; const float* mod;
    __device__ __forceinline__ void operator()(const f32x4 (&acc)[2][2][4][2], const Unit& u_in, int wr, int wc, int fr_in, int fq_in) const {
        Unit u = u_in; asm volatile("" : "+s"(u.pm), "+s"(u.pn), "+s"(u.aux)); int fr = fr_in, fq = fq_in; asm volatile("" : "+v"(fr), "+v"(fq));
        if (u.aux == 0) {
            EPI_FOR_ROWS { const int r = u.pm * 256 + EPI_ROWL; const int d = dst[r]; const float wt = wbuf[r];
                if (d >= 0) { const int tok = d / 6, k = d - tok * 6; bf16_t* p = (k < 4) ? (Y4 + ((size_t)tok * 4 + k) * 1024) : (outbf + ((size_t)tok * 2 + (k - 4)) * 1024);
#pragma unroll
                    for (int bj = 0; bj < 2; ++bj) { const int col = u.pn * 256 + bj * 128 + wc * 32 + 8 * fq; *(u32x4*)(p + col) = pack8(acc[ai][bj][m][0] * wt, acc[ai][bj][m][1] * wt); } } asm volatile("" ::: "memory"); }
        } else {
            EPI_FOR_ROWS { const size_t row = (size_t)u.pm * 256 + EPI_ROWL; const int b = (int)(row >> 12);
#pragma unroll
                for (int bj = 0; bj < 2; ++bj) { const int col = u.pn * 256 + bj * 128 + wc * 32 + 8 * fq; const u32x4 xw = *(const u32x4*)(x1 + row * 1024 + col);
                    const f32x4 g0 = *(const f32x4*)(mod + b * 6144 + 5120 + col), g1 = *(const f32x4*)(mod + b * 6144 + 5120 + col + 4);
                    const f32x4 x0 = (f32x4){bflo(xw.x), bfhi(xw.x), bflo(xw.y), bfhi(xw.y)}, x1v = (f32x4){bflo(xw.z), bfhi(xw.z), bflo(xw.w), bfhi(xw.w)};
                    *(u32x4*)(x1 + row * 1024 + col) = pack8(x0 + g0 * acc[ai][bj][m][0], x1v + g1 * acc[ai][bj][m][1]); } asm volatile("" ::: "memory"); }
        }
    } };

__device__ __forceinline__ void p3_conv(Frame& F) {
    const bf16_t* P = WSP(bf16_t, WS_PROJC); bf16_t* Y = WSP(bf16_t, WS_YCAT);
    for (int chunk = F.blk * 8 + F.wave; chunk < NCHUNK; chunk += F.G * 8) {
        const int t0 = chunk * LCH;
        f32x4 w0[3], w1[3], w2[3], cb[3], gc[3], z1[3], z2[3];
#pragma unroll
        for (int j = 0; j < 3; ++j) { const int c0 = 4 * F.lane + 256 * j;
            w0[j] = *(const f32x4*)(F.conv_w + c0); w1[j] = *(const f32x4*)(F.conv_w + DCONV + c0); w2[j] = *(const f32x4*)(F.conv_w + 2 * DCONV + c0);
            cb[j] = *(const f32x4*)(F.conv_b + c0); gc[j] = *(const f32x4*)(F.g_conv + c0); z1[j] = (f32x4){0.f, 0.f, 0.f, 0.f}; z2[j] = z1[j]; }
        if ((t0 & (SEQ - 1)) != 0) {
#pragma unroll
            for (int j = 0; j < 3; ++j) { const int c0 = 4 * F.lane + 256 * j;
                const u32x2 ca = *(const u32x2*)(P + (size_t)(t0 - 2) * 2304 + 768 + c0), va = *(const u32x2*)(P + (size_t)(t0 - 2) * 2304 + 1536 + c0);
                const u32x2 cb_ = *(const u32x2*)(P + (size_t)(t0 - 1) * 2304 + 768 + c0), vb = *(const u32x2*)(P + (size_t)(t0 - 1) * 2304 + 1536 + c0);
                z2[j] = (f32x4){bflo(ca.x) * bflo(va.x), bfhi(ca.x) * bfhi(va.x), bflo(ca.y) * bflo(va.y), bfhi(ca.y) * bfhi(va.y)};
                z1[j] = (f32x4){bflo(cb_.x) * bflo(vb.x), bfhi(cb_.x) * bfhi(vb.x), bflo(cb_.y) * bflo(vb.y), bfhi(cb_.y) * bfhi(vb.y)}; }
        }
#pragma unroll 2
        for (int tt = 0; tt < LCH; ++tt) { const size_t t = (size_t)t0 + tt; f32x4 val[3]; float ss = 0.f;
#pragma unroll
            for (int j = 0; j < 3; ++j) { const int c0 = 4 * F.lane + 256 * j;
                const u32x2 bw = *(const u32x2*)(P + t * 2304 + c0), cw = *(const u32x2*)(P + t * 2304 + 768 + c0), vw = *(const u32x2*)(P + t * 2304 + 1536 + c0);
                const f32x4 bg = (f32x4){bflo(bw.x), bfhi(bw.x), bflo(bw.y), bfhi(bw.y)};
                const f32x4 z = (f32x4){bflo(cw.x) * bflo(vw.x), bfhi(cw.x) * bfhi(vw.x), bflo(cw.y) * bflo(vw.y), bfhi(cw.y) * bfhi(vw.y)};
                val[j] = bg * (w0[j] * z2[j] + w1[j] * z1[j] + w2[j] * z + cb[j]); z2[j] = z1[j]; z1[j] = z;
                ss += (val[j].x * val[j].x + val[j].y * val[j].y) + (val[j].z * val[j].z + val[j].w * val[j].w); }
            const float rstd = rsqrtf(wave_sum(ss) * (1.0f / DCONV) + RMS_EPS);
#pragma unroll
            for (int j = 0; j < 3; ++j) { const int c0 = 4 * F.lane + 256 * j; const f32x4 o = val[j] * rstd * gc[j];
                *(u32x2*)(Y + t * 1024 + c0) = (u32x2){pk2(o.x, o.y), pk2(o.z, o.w)}; } }
    }
}

__device__ __forceinline__ void p4_scan(Frame& F) {
    if (F.wave != 0) return;
    const float* S = WSP(float, WS_S); bf16_t* A2 = WSP(bf16_t, WS_A2);
    for (int bg = F.blk; bg < NB * NG; bg += F.G) { const int b = bg >> 4, g = bg & 15, p = F.lane;
        const f32x2 a = WSP(f32x2, WS_AB32)[g * 64 + p]; float xr = 0.f, xi = 0.f;
#pragma unroll 8
        for (int c = 0; c < 128; ++c) { const size_t chunk = (size_t)g * NCHUNK + b * 128 + c;
            *(unsigned*)(A2 + chunk * KA2 + KU + 2 * p) = pk2(xr, xi);
            const f32x2 s = *(const f32x2*)(S + chunk * 128 + 2 * p);
            const float nr = a.x * xr - a.y * xi + s.x, ni = a.x * xi + a.y * xr + s.y; xr = nr; xi = ni; }
    }
}

__device__ __forceinline__ void p7_post(Frame& F) {
    const float* mod = WSP(float, WS_MOD); const bf16_t* X1 = WSP(bf16_t, WS_X1); bf16_t* H2 = WSP(bf16_t, WS_H2);
    LAS float* scr = (LAS float*)(F.lds + EPI_OFF);
    VM_WAIT(); LDS_WAIT(); __syncthreads();
    if (F.blk >= 256) return;
    for (int i = 0; i < 32; ++i) { const int rl = F.wave * 32 + i; const size_t row = (size_t)F.blk * 256 + rl; const int b = (int)(row >> 12);
        float tot = 0.f;
#pragma unroll
        for (int q = 0; q < 4; ++q) { const f32x4 pq = *(const LAS f32x4*)(scr + rl * 16 + 4 * q); tot += (pq.x + pq.y) + (pq.z + pq.w); }
        const float rstd = rsqrtf(tot * (1.0f / D) + RMS_EPS);
#pragma unroll
        for (int j = 0; j < 4; ++j) { const int c0 = 4 * F.lane + 256 * j; const u32x2 xw = *(const u32x2*)(X1 + row * 1024 + c0);
            const f32x4 xv = (f32x4){bflo(xw.x), bfhi(xw.x), bflo(xw.y), bfhi(xw.y)};
            const f32x4 gf = *(const f32x4*)(F.g_ffn + c0), sh = *(const f32x4*)(mod + b * 6144 + 3072 + c0), sc = *(const f32x4*)(mod + b * 6144 + 4096 + c0);
            const f32x4 h = xv * rstd * gf * (sc + 1.0f) + sh;
            *(u32x2*)(H2 + row * 1024 + c0) = (u32x2){pk2(h.x, h.y), pk2(h.z, h.w)}; } }
}

__device__ __forceinline__ void p9_topk(Frame& F) {
    const float* LG = WSP(float, WS_LOGITS); unsigned char* R = F.ws + WS_ROUTE;
    int* sele = (int*)(R + RT_SELE); float* selw = (float*)(R + RT_SELW); int* cntw = (int*)(R + RT_CNTW); int* cntb = (int*)(R + RT_CNTB);
    int* tokb = (int*)(R + RT_TOK); int* dstb = (int*)(R + RT_DST);
    LAS int* lcnt = (LAS int*)F.lds;
    const float NEG = -INFINITY;
    for (int blk = F.blk; blk < 256; blk += F.G) {
        for (int i = F.tid; i < MAXBLK; i += 512) { tokb[blk * MAXBLK + i] = 0; dstb[blk * MAXBLK + i] = -1; }
        const int lane = F.lane; const float rb = F.router_bias[lane]; int cnt = 0;
        for (int i = 0; i < 32; ++i) { const int tok = blk * 256 + F.wave * 32 + i;
            const float s = sigmoidf_(LG[(size_t)tok * 64 + lane]), bsd = s + rb;
            float m1 = bsd; int i1 = lane;
#pragma unroll
            for (int o = 1; o < 8; o <<= 1) { const float ov = __shfl_xor(m1, o); const int oi = __shfl_xor(i1, o); if (ov > m1 || (ov == m1 && oi < i1)) { m1 = ov; i1 = oi; } }
            float m2 = (lane == i1) ? NEG : bsd;
#pragma unroll
            for (int o = 1; o < 8; o <<= 1) m2 = fmaxf(m2, __shfl_xor(m2, o));
            const float gs = m1 + m2; const int myg = lane >> 3; int grank = 0;
#pragma unroll
            for (int g2 = 0; g2 < 8; ++g2) { const float s2 = __builtin_bit_cast(float, __builtin_amdgcn_readlane(__builtin_bit_cast(int, gs), 8 * g2)); grank += (s2 > gs || (s2 == gs && g2 < myg)) ? 1 : 0; }
            const float mv = (grank < 4) ? bsd : NEG; int rank = 0;
#pragma unroll
            for (int e2 = 0; e2 < 64; ++e2) { const float v2 = __builtin_bit_cast(float, __builtin_amdgcn_readlane(__builtin_bit_cast(int, mv), e2)); rank += (v2 > mv || (v2 == mv && e2 < lane)) ? 1 : 0; }
            const bool sel = rank < TOPK;
            const float wsum = wave_sum(sel ? s : 0.f);
            if (sel) { sele[(size_t)tok * 6 + rank] = lane | (cnt << 8); selw[(size_t)tok * 6 + rank] = s / wsum * 2.5f; ++cnt; } }
        cntw[(blk * 8 + F.wave) * 64 + lane] = cnt; lcnt[F.wave * 64 + lane] = cnt;
        __syncthreads();
        if (F.tid < 64) { int s = 0;
#pragma unroll
            for (int w = 0; w < 8; ++w) s += lcnt[w * 64 + F.tid];
            cntb[blk * 64 + F.tid] = s; }
        __syncthreads();
    }
}

__device__ __forceinline__ void p10_scatter(Frame& F) {
    unsigned char* R = F.ws + WS_ROUTE;
    const int* sele = (const int*)(R + RT_SELE); const float* selw = (const float*)(R + RT_SELW); const int* cntw = (const int*)(R + RT_CNTW); const int* cntb = (const int*)(R + RT_CNTB);
    int* tokb = (int*)(R + RT_TOK); float* wbuf = (float*)(R + RT_WBUF); int* dstb = (int*)(R + RT_DST);
    LAS int* ptot = (LAS int*)F.lds; LAS int* ppre = ptot + 512; LAS int* pst = ppre + 512; LAS int* pad = pst + 64; LAS int* base = pad + 64;
    for (int blk = F.blk; blk < 256; blk += F.G) {
        { const int p8 = F.tid >> 6, e = F.tid & 63; int tot = 0, pre = 0;
          for (int b2 = 32 * p8; b2 < 32 * p8 + 32; ++b2) { const int c = cntb[b2 * 64 + e]; tot += c; pre += (b2 < blk) ? c : 0; }
          ptot[p8 * 64 + e] = tot; ppre[p8 * 64 + e] = pre; }
        __syncthreads();
        if (F.tid < 64) { const int e = F.tid; int total = 0, bb = 0;
#pragma unroll
            for (int q = 0; q < 8; ++q) { total += ptot[q * 64 + e]; bb += ppre[q * 64 + e]; }
            const int padded = (total + 255) & ~255; int v = padded;
#pragma unroll
            for (int o = 1; o < 64; o <<= 1) { const int tv = __shfl_up(v, o); if (e >= o) v += tv; }
            const int pstart = v - padded; pst[e] = pstart; pad[e] = padded;
            int run = pstart + bb;
#pragma unroll
            for (int w = 0; w < 8; ++w) { base[w * 64 + e] = run; run += cntw[(blk * 8 + w) * 64 + e]; }
            if (blk == 0 && e == 63) { const int nblk = (pstart + padded) >> 8; __hip_atomic_store(WSP(int, WS_CTL) + CW_NBLK, nblk, __ATOMIC_RELAXED, __HIP_MEMORY_SCOPE_AGENT); } }
        __syncthreads();
        for (int a = F.tid; a < 256 * TOPK; a += 512) { const int tl = a / 6, k = a - tl * 6, tok = blk * 256 + tl, w = tl >> 5;
            const int se = sele[(size_t)tok * 6 + k]; const int e = se & 255, r = se >> 8; const int dest = base[w * 64 + e] + r;
            tokb[dest] = tok; wbuf[dest] = selw[(size_t)tok * 6 + k]; dstb[dest] = tok * 6 + k; }
        if (blk == 0) { const int nblk = (pst[63] + pad[63]) >> 8; int* blke = WSP(int, WS_BLKE);
            for (int j = F.tid; j < nblk; j += 512) { const int r0 = j * 256; int e = 0;
                for (int q = 0; q < 64; ++q) if (pad[q] > 0 && pst[q] <= r0 && r0 < pst[q] + pad[q]) e = q;
                blke[j] = e; } }
        __syncthreads();
    }
}

__device__ __forceinline__ void p13_final(Frame& F) {
    const float* mod = WSP(float, WS_MOD); const bf16_t* X1 = WSP(bf16_t, WS_X1); const bf16_t* Y4 = WSP(bf16_t, WS_Y4); const bf16_t* OB = (const bf16_t*)F.out;
    for (int t = F.blk * 8 + F.wave; t < T; t += F.G * 8) { const int b = t >> 12; f32x4 v[4]; float ss = 0.f;
#pragma unroll
        for (int j = 0; j < 4; ++j) { const int c0 = 4 * F.lane + 256 * j; f32x4 ys = (f32x4){0.f, 0.f, 0.f, 0.f};
#pragma unroll
            for (int k = 0; k < 6; ++k) { const u32x2 yw = (k < 4) ? *(const u32x2*)(Y4 + ((size_t)t * 4 + k) * 1024 + c0) : *(const u32x2*)(OB + ((size_t)t * 2 + (k - 4)) * 1024 + c0);
                ys += (f32x4){bflo(yw.x), bfhi(yw.x), bflo(yw.y), bfhi(yw.y)}; }
            const u32x2 xw = *(const u32x2*)(X1 + (size_t)t * 1024 + c0); const f32x4 g2 = *(const f32x4*)(mod + b * 6144 + 5120 + c0);
            v[j] = (f32x4){bflo(xw.x), bfhi(xw.x), bflo(xw.y), bfhi(xw.y)} + g2 * ys;
            ss += (v[j].x * v[j].x + v[j].y * v[j].y) + (v[j].z * v[j].z + v[j].w * v[j].w); }
        const float rstd = rsqrtf(wave_sum(ss) * (1.0f / D) + RMS_EPS);
        asm volatile("" ::: "memory");
#pragma unroll
        for (int j = 0; j < 4; ++j) { const int c0 = 4 * F.lane + 256 * j; const f32x4 gf = *(const f32x4*)(F.g_final + c0);
            *(f32x4*)(F.out + (size_t)t * 1024 + c0) = v[j] * rstd * gf; } }
}

constexpr int N_PHASES = 14;
template <int K> __device__ __forceinline__ void run_phase(Frame& F) {
    LAS unsigned char* ring = F.lds; LAS float* escr = (LAS float*)(F.lds + EPI_OFF);
    if constexpr (K == 0) { p0_prologue(F); }
    if constexpr (K == 1) { p1_h(F); }
    if constexpr (K == 2) {
        SchedG1 S; S.o.init(256, 10, F.G, F.blk); S.A = (const char*)WSP(bf16_t, WS_H); S.B = (const char*)WSP(bf16_t, WS_WIN_T);
        EpiG1 E{WSP(bf16_t, WS_PROJC), WSP(bf16_t, WS_A2)};
        pg8::gemm_phase<EpiG1, SchedG1, false, false>(ring, pg8::Desc{1024, 1024, 1024}, S, E);
    }
    if constexpr (K == 3) {
        p3_conv(F); __syncthreads();
        SchedS5a S{F.G, F.blk, (const char*)WSP(bf16_t, WS_A2), (const char*)WSP(bf16_t, WS_T1)}; EpiS5a E{WSP(float, WS_S)};
        pg8::gemm_phase<EpiS5a, SchedS5a, false, false>(ring, pg8::Desc{KA2, KU, KU}, S, E);
    }
    if constexpr (K == 4) { p4_scan(F); }
    if constexpr (K == 5) {
        SchedS5b S{F.G, F.blk, (const char*)WSP(bf16_t, WS_A2), (const char*)WSP(bf16_t, WS_T2)}; EpiS5b E{WSP(bf16_t, WS_YS)};
        pg8::gemm_phase<EpiS5b, SchedS5b, false, false>(ring, pg8::Desc{KA2, KA2, KA2}, S, E);
    }
    if constexpr (K == 6) {
        SchedGlu S{F.G, F.blk, (const char*)WSP(bf16_t, WS_YS), (const char*)WSP(bf16_t, WS_WGLU_T)};
        EpiGlu E{WSP(bf16_t, WS_YS), F.b_glu, F.g_ssm, WSP(bf16_t, WS_YCAT), escr};
        pg8::gemm_phase<EpiGlu, SchedGlu, false, true>(ring, pg8::Desc{256, 256, 256}, S, E);
    }
    if constexpr (K == 7) {
        SchedG2 S{F.blk, (const char*)WSP(bf16_t, WS_YCAT), (const char*)WSP(bf16_t, WS_WOUT_T)};
        EpiG2 E{F.x, WSP(float, WS_MOD), WSP(bf16_t, WS_X1), escr};
        pg8::gemm_phase<EpiG2, SchedG2, false, false>(ring, pg8::Desc{1024, 1024, 1024}, S, E);
        p7_post(F);
    }
    if constexpr (K == 8) {
        SchedRS S; S.o.init(256, 3, F.G, F.blk); S.A = (const char*)WSP(bf16_t, WS_H2); S.B = (const char*)WSP(bf16_t, WS_WSR_T);
        EpiRS E{WSP(bf16_t, WS_ACTS), WSP(float, WS_LOGITS)};
        pg8::gemm_phase<EpiRS, SchedRS, false, false>(ring, pg8::Desc{1024, 1024, 1024}, S, E);
    }
    if constexpr (K == 9) { p9_topk(F); }
    if constexpr (K == 10) { p10_scatter(F); }
    if constexpr (K == 11) {
        const int nblk = __builtin_amdgcn_readfirstlane(ld_i32_agent(WSP(int, WS_CTL) + CW_NBLK));
        SchedUp S{F.G, F.vcu, nblk, WSP(int, WS_BLKE), (const int*)(F.ws + WS_ROUTE + RT_TOK), (const char*)WSP(bf16_t, WS_H2), (const char*)WSP(bf16_t, WS_W13T)};
        EpiUp E{WSP(bf16_t, WS_ACT)};
        pg8::gemm_phase<EpiUp, SchedUp, true, false>(ring, pg8::Desc{1024, 1024, 1024}, S, E);
    }
    if constexpr (K == 12) {
        const int nblk = __builtin_amdgcn_readfirstlane(ld_i32_agent(WSP(int, WS_CTL) + CW_NBLK));
        SchedDown S{F.G, F.vcu, nblk, WSP(int, WS_BLKE), (const char*)WSP(bf16_t, WS_ACT), (const char*)WSP(bf16_t, WS_ACTS), (const char*)WSP(bf16_t, WS_W2T), (const char*)WSP(bf16_t, WS_WS2_T)};
        EpiDown E{(const int*)(F.ws + WS_ROUTE + RT_DST), (const float*)(F.ws + WS_ROUTE + RT_WBUF), WSP(bf16_t, WS_Y4), (bf16_t*)F.out, WSP(bf16_t, WS_X1), WSP(float, WS_MOD)};
        pg8::gemm_phase<EpiDown, SchedDown, false, false>(ring, pg8::Desc{256, 256, 256}, S, E);
    }
    if constexpr (K == 13) { p13_final(F); }
}
#ifndef REP_PHASE
#define REP_PHASE -1
#endif
#ifndef PH_MASK
#define PH_MASK 0xFFFF
#endif
#ifndef USE_CG_FIRST
#define USE_CG_FIRST 1
#endif
template <int K> __device__ __forceinline__ void grid_sync(Frame& F) {
#if MK_N_LAUNCHES == 1
    if constexpr (K == 0 && USE_CG_FIRST) cg::this_grid().sync(); else xcd_barrier(F.bar);
#endif
}
template <int K> __device__ __forceinline__ void phase_and_seam(Frame& F, int lo, int hi) {
    if (((PH_MASK >> K) & 1) && lo <= K && K < hi) {
        run_phase<K>(F);
        if constexpr (K == REP_PHASE) { grid_sync<K>(F); run_phase<K>(F); }
        if (K + 1 < hi) grid_sync<K>(F);
    }
}
__global__ void __launch_bounds__(512, 2) mk_fwd(Args args) {
    extern __shared__ __attribute__((aligned(16))) unsigned char lds_raw[];
    Frame F;
    F.lds = (LAS unsigned char*)lds_raw; F.tid = threadIdx.x; F.lane = F.tid & 63; F.wave = __builtin_amdgcn_readfirstlane(F.tid >> 6);
    F.blk = blockIdx.x; F.G = gridDim.x; F.vcu = (F.G % 8 == 0) ? (F.blk % 8) * (F.G / 8) + F.blk / 8 : F.blk;
    { const float* const* in = args.in;
      F.x = in[0]; F.c = in[1]; F.w_ada = in[2]; F.b_ada = in[3]; F.g_mix = in[4]; F.w_in = in[5]; F.conv_w = in[6]; F.conv_b = in[7]; F.g_conv = in[8];
      F.lam_re = in[9]; F.lam_im = in[10]; F.log_dt = in[11]; F.b_re = in[12]; F.b_im = in[13]; F.c_re = in[14]; F.c_im = in[15]; F.d_skip = in[16];
      F.w_glu = in[17]; F.b_glu = in[18]; F.g_ssm = in[19]; F.w_out = in[20]; F.g_ffn = in[21]; F.w_router = in[22]; F.router_bias = in[23];
      F.w1 = in[24]; F.w3 = in[25]; F.w2 = in[26]; F.ws1 = in[27]; F.ws3 = in[28]; F.ws2 = in[29]; F.g_final = in[30]; }
    F.out = args.out; F.ws = args.ws;
    const int lo = args.ph_lo, hi = args.ph_hi;
    if (F.tid < 64) ((LAS unsigned*)(F.lds + MISC_OFF))[F.tid] = 0u;
    __syncthreads();
    F.bar = xcd_barrier_post((unsigned*)(F.ws + WS_CTL) + CW_BAR, (volatile LAS unsigned*)(F.lds + MISC_OFF) + 8);
    phase_and_seam<0>(F, lo, hi); phase_and_seam<1>(F, lo, hi); phase_and_seam<2>(F, lo, hi); phase_and_seam<3>(F, lo, hi);
    phase_and_seam<4>(F, lo, hi); phase_and_seam<5>(F, lo, hi); phase_and_seam<6>(F, lo, hi); phase_and_seam<7>(F, lo, hi);
    phase_and_seam<8>(F, lo, hi); phase_and_seam<9>(F, lo, hi); phase_and_seam<10>(F, lo, hi); phase_and_seam<11>(F, lo, hi);
    phase_and_seam<12>(F, lo, hi); phase_and_seam<13>(F, lo, hi);
}

extern "C" void kernel_launch(void* const* d_in, const int* in_sizes, int n_in, void* d_out, int out_size, void* d_ws, size_t ws_size, hipStream_t stream) {
    static int grid = 0;
    if (grid == 0) {
        if (n_in != 31 || in_sizes[0] != T * D || out_size != T * D || ws_size < WS_END) { fprintf(stderr, "kernel_launch: unexpected shapes (n_in %d, in0 %d, out %d, ws %zu)\n", n_in, n_in > 0 ? in_sizes[0] : -1, out_size, ws_size); grid = -1; return; }
        int dev = 0, cus = 0, per_cu = 0;
        if (hipGetDevice(&dev) != hipSuccess || hipDeviceGetAttribute(&cus, hipDeviceAttributeMultiprocessorCount, dev) != hipSuccess) { grid = -1; return; }
        if (hipFuncSetAttribute((const void*)mk_fwd, hipFuncAttributeMaxDynamicSharedMemorySize, LDS_BYTES) != hipSuccess) { fprintf(stderr, "kernel_launch: hipFuncSetAttribute failed\n"); grid = -1; return; }
        if (hipOccupancyMaxActiveBlocksPerMultiprocessor(&per_cu, (const void*)mk_fwd, 512, LDS_BYTES) != hipSuccess || per_cu < 1) { fprintf(stderr, "kernel_launch: occupancy query gives %d\n", per_cu); per_cu = 1; }
        (void)hipGetLastError();
        grid = cus;
        if (grid > 256) grid = 256;
    }
    if (grid < 0) return;
    (void)hipMemsetAsync((char*)d_ws + WS_CTL, 0, CTL_ZERO_BYTES, stream);
    Args a{};
    for (int i = 0; i < 31; ++i) a.in[i] = (const float*)d_in[i];
    a.out = (float*)d_out; a.ws = (unsigned char*)d_ws;
#if MK_N_LAUNCHES == 1
    a.ph_lo = 0; a.ph_hi = N_PHASES;
    void* kargs[] = {&a};
    hipError_t e = hipLaunchCooperativeKernel((const void*)mk_fwd, dim3(grid), dim3(512), kargs, LDS_BYTES, stream);
    if (e != hipSuccess) fprintf(stderr, "kernel_launch: cooperative launch failed: %s (grid %d)\n", hipGetErrorString(e), grid);
#else
    for (int p = 0; p < N_PHASES; ++p) { a.ph_lo = p; a.ph_hi = p + 1; hipLaunchKernelGGL(mk_fwd, dim3(grid), dim3(512), LDS_BYTES, stream, a); }
#endif
}
```

```cpp
#include <hip/hip_runtime.h>
#include <hip/hip_cooperative_groups.h>
#include <cstdio>
#include <cstdint>
namespace cg = cooperative_groups;

#ifndef MK_N_LAUNCHES
#define MK_N_LAUNCHES 1
#endif

#define LAS __attribute__((address_space(3)))
typedef unsigned short bf16_t;
typedef short bf16x8 __attribute__((ext_vector_type(8)));
typedef float f32x4 __attribute__((ext_vector_type(4)));
typedef float f32x2 __attribute__((ext_vector_type(2)));
typedef unsigned u32x4 __attribute__((ext_vector_type(4)));
typedef unsigned u32x2 __attribute__((ext_vector_type(2)));

constexpr int NB = 16, SEQ = 4096, D = 1024, T = NB * SEQ;
constexpr int DCONV = 768, DSSM = 256, DIN = 2560, NG = 16, GC = 16, NP = 64;
constexpr int NE = 64, TOPK = 6, DE = 256;
constexpr int LCH = 32;
constexpr int NCHUNK = T / LCH;
constexpr int KU = LCH * GC;
constexpr int KA2 = KU + 2 * NP;
constexpr int MAXBLK = 1600;
constexpr float RMS_EPS = 1e-6f;

constexpr size_t MiB = 1u << 20, KiB = 1u << 10;
constexpr size_t WS_CTL = 0;
constexpr size_t WS_MOD = 64 * KiB;
constexpr size_t WS_AB32 = 448 * KiB;
constexpr size_t WS_BLKE = 512 * KiB;
constexpr size_t WS_WIN_T = 1 * MiB;
constexpr size_t WS_WOUT_T = 6 * MiB;
constexpr size_t WS_WGLU_T = 8 * MiB;
constexpr size_t WS_WS2_T = 8 * MiB + 512 * KiB;
constexpr size_t WS_WSR_T = 9 * MiB;
constexpr size_t WS_T1 = 11 * MiB;
constexpr size_t WS_T2 = 15 * MiB;
constexpr size_t WS_W13T = 25 * MiB;
constexpr size_t WS_W2T = 89 * MiB;
constexpr size_t WS_H = 128 * MiB;
constexpr size_t WS_X1 = 128 * MiB;
constexpr size_t WS_PROJC = 256 * MiB;
constexpr size_t WS_ACT = 256 * MiB;
constexpr size_t WS_ACTS = 456 * MiB;
constexpr size_t WS_ROUTE = 488 * MiB;
constexpr size_t WS_H2 = 512 * MiB;
constexpr size_t WS_Y4 = 512 * MiB;
constexpr size_t WS_YCAT = 640 * MiB;
constexpr size_t WS_LOGITS = 640 * MiB;
constexpr size_t WS_A2 = 768 * MiB;
constexpr size_t WS_S = 808 * MiB;
constexpr size_t WS_YS = 824 * MiB;
constexpr size_t WS_END = 1024 * MiB;
constexpr size_t RT_SELE = 0;
constexpr size_t RT_SELW = 2 * MiB;
constexpr size_t RT_CNTW = 4 * MiB;
constexpr size_t RT_CNTB = 5 * MiB;
constexpr size_t RT_REC = 6 * MiB;
constexpr int CW_NBLK = 16;
constexpr int CW_BAR = 1024;
constexpr size_t CTL_ZERO_BYTES = 32 * KiB;

constexpr int RING_BYTES = 131072;
constexpr int EPI_OFF = RING_BYTES;
constexpr int MISC_OFF = EPI_OFF + 16384;
constexpr int LDS_BYTES = 148480;

__device__ __forceinline__ unsigned f2bf(float f) { unsigned u = __builtin_bit_cast(unsigned, f); return (u + 0x7fffu + ((u >> 16) & 1u)) >> 16; }
__device__ __forceinline__ unsigned pk2(float lo, float hi) { return f2bf(lo) | (f2bf(hi) << 16); }
__device__ __forceinline__ float bflo(unsigned w) { return __builtin_bit_cast(float, w << 16); }
__device__ __forceinline__ float bfhi(unsigned w) { return __builtin_bit_cast(float, w & 0xffff0000u); }
__device__ __forceinline__ float bf2f(bf16_t b) { return __builtin_bit_cast(float, (unsigned)b << 16); }
__device__ __forceinline__ float sigmoidf_(float v) { return 1.0f / (1.0f + __expf(-v)); }
__device__ __forceinline__ float siluf_(float v) { return v / (1.0f + __expf(-v)); }
__device__ __forceinline__ float gelu_tanh(float v) {
    const float z = 0.7978845608028654f * (v + 0.044715f * v * v * v);
    const float e = __expf(2.0f * z);
    const float th = 1.0f - 2.0f / (e + 1.0f);
    return 0.5f * v * (1.0f + th);
}
__device__ __forceinline__ float wave_sum(float v) {
#pragma unroll
    for (int o = 1; o < 64; o <<= 1) v += __shfl_xor(v, o);
    return v;
}
__device__ __forceinline__ int ld_i32_agent(const int* p) { return __hip_atomic_load(p, __ATOMIC_RELAXED, __HIP_MEMORY_SCOPE_AGENT); }


#define XB_TMO      128
#define XB_XCNT(j)  (256  + 64 * (j))
#define XB_XSUB(j)  (1280 + 64 * (j))
#define XB_XGEN(j)  (2304 + 64 * (j))
#define XB_TOP      3328
#define XB_TOPGEN   3392
#define XCD_BAR_WORDS 3456
#define XB_SPIN_CAP (1u << 22)
__device__ __forceinline__ unsigned xb_ld(unsigned* p)              { return __hip_atomic_load(p, __ATOMIC_RELAXED, __HIP_MEMORY_SCOPE_AGENT); }
__device__ __forceinline__ unsigned xb_add(unsigned* p, unsigned v) { return __hip_atomic_fetch_add(p, v, __ATOMIC_RELAXED, __HIP_MEMORY_SCOPE_AGENT); }
__device__ __forceinline__ unsigned xb_xcc_id() { return (unsigned)__builtin_amdgcn_s_getreg((3 << 11) | 20) & 0xFu; }
#define XB_SPIN(cond, bar) do { unsigned _sp = 0; while (cond) { __builtin_amdgcn_s_sleep(1); \
    if ((++_sp & 255u) == 0u) { if (xb_ld(&(bar)[XB_TMO])) break; if (_sp > XB_SPIN_CAP) { atomicAdd(&(bar)[XB_TMO], 1u); break; } } } } while (0)
struct XcdBarrier { unsigned* bar; unsigned x; volatile LAS unsigned* st; };
__device__ __forceinline__ XcdBarrier xcd_barrier_post(unsigned* bar, volatile LAS unsigned* st) {
    XcdBarrier b; b.bar = bar; b.x = xb_xcc_id(); b.st = st;
    if (threadIdx.x == 0) (void)xb_add(&bar[XB_XCNT(b.x)], 1u);
    return b;
}
__device__ __forceinline__ void xcd_barrier_complete(unsigned* bar, unsigned x, unsigned& nloc, unsigned& nx) {
    const unsigned G = gridDim.x * gridDim.y * gridDim.z;
    unsigned sum, cnt, mine, sp = 0u;
    for (;;) {
        sum = 0u; cnt = 0u; mine = 0u;
#pragma unroll
        for (unsigned j = 0; j < 16; ++j) { const unsigned c = xb_ld(&bar[XB_XCNT(j)]); sum += c; cnt += (c > 0u) ? 1u : 0u; mine = (j == x) ? c : mine; }
        if (sum == G) break;
        __builtin_amdgcn_s_sleep(1);
        if ((++sp & 255u) == 0u) { if (xb_ld(&bar[XB_TMO])) break; if (sp > XB_SPIN_CAP) { atomicAdd(&bar[XB_TMO], 1u); break; } }
    }
    nloc = mine > 0u ? mine : 1u; nx = cnt > 0u ? cnt : 1u;
}
__device__ __forceinline__ void xcd_barrier(const XcdBarrier& b) {
    asm volatile("s_waitcnt vmcnt(0)" ::: "memory");
    __syncthreads();
    if (threadIdx.x == 0) {
        unsigned* bar = b.bar;
        __builtin_amdgcn_s_waitcnt(0);
        unsigned nloc = b.st[0], nx = b.st[1];
        if (nloc == 0u) { xcd_barrier_complete(bar, b.x, nloc, nx); b.st[0] = nloc; b.st[1] = nx; }
        const unsigned old = xb_add(&bar[XB_XSUB(b.x)], 1u);
        const unsigned gen = old / nloc;
        if (old + 1u == (gen + 1u) * nloc) {
            __builtin_amdgcn_fence(__ATOMIC_RELEASE, "agent");
            asm volatile("s_waitcnt vmcnt(0)" ::: "memory");
            const unsigned og = xb_add(&bar[XB_TOP], 1u);
            const unsigned tg = og / nx;
            if (og + 1u == (tg + 1u) * nx) xb_add(&bar[XB_TOPGEN], 1u);
            else XB_SPIN(xb_ld(&bar[XB_TOPGEN]) == tg, bar);
            __builtin_amdgcn_fence(__ATOMIC_ACQUIRE, "agent");
            xb_add(&bar[XB_XGEN(b.x)], 1u);
            asm volatile("s_waitcnt vmcnt(0)" ::: "memory");
        } else {
            XB_SPIN(xb_ld(&bar[XB_XGEN(b.x)]) == gen, bar);
            __builtin_amdgcn_fence(__ATOMIC_ACQUIRE, "agent");
            asm volatile("s_waitcnt vmcnt(0)" ::: "memory");
        }
    }
    __syncthreads();
}

namespace pg8 {
constexpr int BM = 256, BK = 64, HALF = 128, HTB = HALF * BK * 2, STAGE_BYTES = 8 * HTB;
__device__ __forceinline__ int lds_byte(int r, int c) { const int st = (r >> 4) * 2 + (c >> 5), rr = r & 15, cc = c & 31, ob = rr * 64 + cc * 2; return st * 1024 + (ob ^ (((ob >> 9) & 1) << 5)); }
__device__ __forceinline__ void stage_rc(int b, int& R, int& C) { const int st = b / 1024, sb = b % 1024, swz = sb ^ (((sb >> 9) & 1) << 5); R = (st >> 1) * 16 + swz / 64; C = (st & 1) * 32 + (swz % 64) / 2; }
__device__ __forceinline__ int perm32(int rho) { const int n = rho >> 4, i = rho & 15; return 8 * (i >> 2) + 4 * n + (i & 3); }

struct Unit { const char* A; const char* B; const int* rows; int pm, pn, aux; };
struct Desc { int lda, ldb, K; };

template <class Epi, class Sched, bool GATHER, bool ALIGN_EPI>
__device__ __forceinline__ void gemm_phase(LAS unsigned char* lds, const Desc g, const Sched& S, const Epi& E) {
    const int tid = threadIdx.x, wid = __builtin_amdgcn_readfirstlane(tid >> 6), lane = tid & 63, wr = wid >> 2, wc = wid & 3, fr = lane & 15, fq = lane >> 4;
    const int K = g.K, nt = K / BK;
    int Rr[2], Cc[2]; unsigned voffB[2];
#pragma unroll
    for (int i = 0; i < 2; ++i) { int R, C; stage_rc(tid * 16 + i * 8192, R, C); const int Rb = Epi::PERM ? ((R & ~31) + perm32(R & 31)) : R;
        Rr[i] = R; Cc[i] = C; voffB[i] = (unsigned)(Rb * g.ldb + C) * 2u; }
    const size_t kstep = (size_t)(BK * 2);
    const size_t hstepB = (size_t)HALF * g.ldb * 2;
    const unsigned ldsw = (unsigned)wid * 1024u;
    const int aoff = lds_byte(wr * 64 + fr, fq * 8), boff = lds_byte(wc * 32 + fr, fq * 8);
#define PG8_SA(b, h) (((b) * 2 + (h)) * HTB)
#define PG8_SB(b, h) ((4 + (b) * 2 + (h)) * HTB)
#define PG8_STAGE(bufoff, gbase, v0, v1) do { \
        __builtin_amdgcn_global_load_lds((const unsigned*)((const char*)(gbase) + (v0)), (LAS unsigned*)(lds + (bufoff) + ldsw), 16, 0, 0); \
        __builtin_amdgcn_global_load_lds((const unsigned*)((const char*)(gbase) + (v1)), (LAS unsigned*)(lds + (bufoff) + ldsw + 8192), 16, 0, 0); } while (0)
#define PG8_STAGEB(bufoff, gbase) PG8_STAGE(bufoff, gbase, voffB[0], voffB[1])
#define PG8_LDA(dst, b, h) do { _Pragma("unroll") for (int m = 0; m < 4; ++m) _Pragma("unroll") for (int k = 0; k < 2; ++k) dst[m][k] = *(const LAS bf16x8*)(lds + PG8_SA(b, h) + aoff + m * 2048 + k * 1024); } while (0)
#define PG8_LDB(dst, b, h) do { _Pragma("unroll") for (int n = 0; n < 2; ++n) _Pragma("unroll") for (int k = 0; k < 2; ++k) dst[n][k] = *(const LAS bf16x8*)(lds + PG8_SB(b, h) + boff + n * 2048 + k * 1024); } while (0)
#define PG8_MMA(ai, bj, At, Bt) do { __builtin_amdgcn_s_setprio(1); _Pragma("unroll") for (int m = 0; m < 4; ++m) _Pragma("unroll") for (int n = 0; n < 2; ++n) _Pragma("unroll") for (int k = 0; k < 2; ++k) \
        acc[ai][bj][m][n] = __builtin_amdgcn_mfma_f32_16x16x32_bf16(Bt[n][k], At[m][k], acc[ai][bj][m][n], 0, 0, 0); __builtin_amdgcn_s_setprio(0); } while (0)
#define PG8_WAIT_V(n) asm volatile("s_waitcnt vmcnt(" #n ")" ::: "memory")
#define PG8_WAIT_L(n) asm volatile("s_waitcnt lgkmcnt(" #n ")" ::: "memory")
#define PG8_BAR __builtin_amdgcn_s_barrier()
#define PG8_SCHED __builtin_amdgcn_sched_barrier(0)
    const unsigned hoffA = GATHER ? 0u : (unsigned)(HALF * g.lda) * 2u;
#define PG8_AOFFS(dst, u) do { if constexpr (GATHER) { _Pragma("unroll") for (int h = 0; h < 2; ++h) _Pragma("unroll") for (int i = 0; i < 2; ++i) { \
        const int rec_ = (u).rows[2 * (h * HALF + Rr[i])]; const int row_ = rec_ < 0 ? 0 : (rec_ & 0xffff); dst[h][i] = (unsigned)(row_ * g.lda + Cc[i]) * 2u; } \
        asm volatile("" : "+v"(dst[0][0]), "+v"(dst[0][1]), "+v"(dst[1][0]), "+v"(dst[1][1])); } } while (0)
    Unit cur, nxt; int ui = 0;
    if (!S.next(0, cur)) return;
    unsigned cvo[2][2], nvo[2][2];
    if constexpr (GATHER) { PG8_AOFFS(cvo, cur); }
    else {
#pragma unroll
        for (int i = 0; i < 2; ++i) { cvo[0][i] = (unsigned)(Rr[i] * g.lda + Cc[i]) * 2u; cvo[1][i] = cvo[0][i] + hoffA; nvo[0][i] = cvo[0][i]; nvo[1][i] = cvo[1][i]; } }
    f32x4 acc[2][2][4][2];
#pragma unroll
    for (int a = 0; a < 2; ++a)
#pragma unroll
        for (int b = 0; b < 2; ++b)
#pragma unroll
            for (int m = 0; m < 4; ++m)
#pragma unroll
                for (int n = 0; n < 2; ++n) acc[a][b][m][n] = (f32x4){0.f, 0.f, 0.f, 0.f};
    bf16x8 At[4][2], B0[2][2], B1[2][2];
    const char* cA = cur.A; const char* cB = cur.B;
    PG8_STAGEB(PG8_SB(0, 0), cB); PG8_STAGEB(PG8_SB(0, 1), cB + hstepB); PG8_STAGE(PG8_SA(0, 0), cA, cvo[0][0], cvo[0][1]); PG8_STAGE(PG8_SA(0, 1), cA, cvo[1][0], cvo[1][1]);
    if (wr == 1) PG8_BAR;
    PG8_WAIT_V(2); PG8_BAR;
    PG8_STAGEB(PG8_SB(1, 0), cB + kstep); PG8_STAGE(PG8_SA(1, 0), cA + kstep, cvo[0][0], cvo[0][1]); PG8_STAGEB(PG8_SB(1, 1), cB + hstepB + kstep);
    PG8_WAIT_V(6); PG8_BAR;
    for (;;) {
        const bool has_next = S.next(ui + 1, nxt);
        const char* nA = has_next ? nxt.A : cA; const char* nB = has_next ? nxt.B : cB;
        if constexpr (GATHER) { if (has_next) { PG8_AOFFS(nvo, nxt); } else {
#pragma unroll
            for (int h = 0; h < 2; ++h)
#pragma unroll
                for (int i = 0; i < 2; ++i) nvo[h][i] = cvo[h][i]; } }
#pragma nounroll
        for (int t = 0; t < nt; t += 2) {
            const bool last = (t == nt - 2);
            const char* a1 = cA + (size_t)(t + 1) * kstep;
            const char* a2 = last ? nA : cA + (size_t)(t + 2) * kstep; const char* b2 = last ? nB : cB + (size_t)(t + 2) * kstep;
            const char* a3 = a2 + kstep; const char* b3 = b2 + kstep;
            const unsigned o00 = (GATHER && last) ? nvo[0][0] : cvo[0][0], o01 = (GATHER && last) ? nvo[0][1] : cvo[0][1], o10 = (GATHER && last) ? nvo[1][0] : cvo[1][0], o11 = (GATHER && last) ? nvo[1][1] : cvo[1][1];
            PG8_LDB(B0, 0, 0); PG8_LDB(B1, 0, 1); PG8_SCHED; PG8_LDA(At, 0, 0); PG8_STAGE(PG8_SA(1, 1), a1, cvo[1][0], cvo[1][1]);
            PG8_WAIT_V(8); PG8_WAIT_L(0); PG8_BAR; PG8_MMA(0, 0, At, B0); PG8_MMA(0, 1, At, B1); PG8_BAR; PG8_SCHED;
            PG8_LDA(At, 0, 1); PG8_STAGEB(PG8_SB(0, 0), b2); PG8_STAGEB(PG8_SB(0, 1), b2 + hstepB); PG8_STAGE(PG8_SA(0, 0), a2, o00, o01);
            PG8_WAIT_V(8); PG8_WAIT_L(0); PG8_BAR; PG8_MMA(1, 0, At, B0); PG8_MMA(1, 1, At, B1); PG8_BAR; PG8_SCHED;
            PG8_LDB(B0, 1, 0); PG8_LDB(B1, 1, 1); PG8_SCHED; PG8_LDA(At, 1, 0); PG8_STAGE(PG8_SA(0, 1), a2, o10, o11);
            PG8_WAIT_V(8); PG8_WAIT_L(0); PG8_BAR; PG8_MMA(0, 0, At, B0); PG8_MMA(0, 1, At, B1); PG8_BAR; PG8_SCHED;
            PG8_LDA(At, 1, 1); PG8_STAGEB(PG8_SB(1, 0), b3); PG8_STAGEB(PG8_SB(1, 1), b3 + hstepB); PG8_STAGE(PG8_SA(1, 0), a3, o00, o01);
            PG8_WAIT_V(8); PG8_WAIT_L(0); PG8_BAR; PG8_MMA(1, 0, At, B0); PG8_MMA(1, 1, At, B1); PG8_BAR; PG8_SCHED;
        }
        if constexpr (ALIGN_EPI) { if (wr == 0) PG8_BAR; }
        E(acc, cur, wr, wc, fr, fq);
        if (!has_next) break;
#pragma unroll
        for (int a = 0; a < 2; ++a)
#pragma unroll
            for (int b = 0; b < 2; ++b)
#pragma unroll
                for (int m = 0; m < 4; ++m)
#pragma unroll
                    for (int n = 0; n < 2; ++n) acc[a][b][m][n] = (f32x4){0.f, 0.f, 0.f, 0.f};
        cur = nxt; cA = nA; cB = nB; ++ui;
        if constexpr (GATHER) {
#pragma unroll
        for (int h = 0; h < 2; ++h)
#pragma unroll
            for (int i = 0; i < 2; ++i) cvo[h][i] = nvo[h][i]; }
        if constexpr (ALIGN_EPI) { if (wr == 1) PG8_BAR; }
    }
    PG8_WAIT_V(0);
    if constexpr (!ALIGN_EPI) { if (wr == 0) PG8_BAR; }
    PG8_BAR;
#undef PG8_SA
#undef PG8_SB
#undef PG8_STAGE
#undef PG8_STAGEB
#undef PG8_LDA
#undef PG8_LDB
#undef PG8_MMA
#undef PG8_WAIT_V
#undef PG8_WAIT_L
#undef PG8_BAR
#undef PG8_SCHED
#undef PG8_AOFFS
}
}
using pg8::Unit;

struct Args { const float* in[31]; float* out; unsigned char* ws; int ph_lo, ph_hi; };
struct Frame {
    LAS unsigned char* lds; int tid, lane, wave, blk, G, vcu;
    const float *x, *c, *w_ada, *b_ada, *g_mix, *w_in, *conv_w, *conv_b, *g_conv, *lam_re, *lam_im, *log_dt, *b_re, *b_im, *c_re, *c_im,
        *d_skip, *w_glu, *b_glu, *g_ssm, *w_out, *g_ffn, *w_router, *router_bias, *w1, *w3, *w2, *ws1, *ws3, *ws2, *g_final;
    float* out; unsigned char* ws; XcdBarrier bar;
};
#define WSP(T_, off) ((T_*)(F.ws + (off)))
#define LDS_WAIT() asm volatile("s_waitcnt lgkmcnt(0)" ::: "memory")
#define VM_WAIT() asm volatile("s_waitcnt vmcnt(0)" ::: "memory")

struct TileOrder {
    int nM, nN, nwg, G, c;
    __device__ __forceinline__ void init(int nM_, int nN_, int G_, int c_) { nM = nM_; nN = nN_; nwg = nM * nN; G = G_; c = c_; }
    __device__ __forceinline__ bool tile(int i, int& pm, int& pn) const {
        const long L = (long)i * G + c; if (L >= nwg) return false;
        int wgid = (int)L; { const int q = nwg / 8, r = nwg % 8, xcd = wgid % 8, off = wgid / 8; wgid = (xcd < r ? xcd * (q + 1) : r * (q + 1) + (xcd - r) * q) + off; }
        const int nig = 8 * nN, gid = wgid / nig, fm = gid * 8, gsz = (nM - fm) < 8 ? (nM - fm) : 8;
        pm = fm + ((wgid % nig) % gsz); pn = (wgid % nig) / gsz; return true;
    }
};

__device__ __forceinline__ int down_perm_row(int c) { const int cl = c & 255; return (c & ~255) + ((cl >> 3) & 1) * 128 + (cl >> 6) * 32 + ((cl >> 4) & 3) * 8 + (cl & 7); }
template <int PMODE = 0>
__device__ __forceinline__ void transpose_item(const float* W, int ldw, int k0, int n0, bf16_t* WT, int ldt, int drow0, LAS float* scr, int lane) {
    float tv[32];
#pragma unroll
    for (int i = 0; i < 32; ++i) { const int kk = 2 * i + (lane >> 5); tv[i] = W[(size_t)(k0 + kk) * ldw + n0 + (lane & 31)]; }
#pragma unroll
    for (int i = 0; i < 32; ++i) { const int kk = 2 * i + (lane >> 5); scr[kk * 33 + (lane & 31)] = tv[i]; }
    LDS_WAIT(); asm volatile("" ::: "memory");
    const int c = lane & 7;
#pragma unroll
    for (int j = 0; j < 4; ++j) { const int n = (lane >> 3) + 8 * j; const LAS float* s = scr + (8 * c) * 33 + n;
        u32x4 o; o.x = pk2(s[0 * 33], s[1 * 33]); o.y = pk2(s[2 * 33], s[3 * 33]); o.z = pk2(s[4 * 33], s[5 * 33]); o.w = pk2(s[6 * 33], s[7 * 33]);
        const int drow = PMODE ? down_perm_row(drow0 + n) : (drow0 + n);
        *(u32x4*)(WT + (size_t)drow * ldt + k0 + 8 * c) = o; }
    LDS_WAIT(); asm volatile("" ::: "memory");
}

__device__ __forceinline__ void p0_mod(Frame& F) {
    LAS float* sil = (LAS float*)F.lds;
    LAS float* red = (LAS float*)(F.lds + 65536);
    for (int i = F.tid; i < NB * D; i += 512) { const float v = F.c[i]; sil[i] = v / (1.0f + __expf(-v)); }
    __syncthreads();
    const int col = F.tid & 31, ks = F.tid >> 5, n0 = F.blk * 32;
    float acc[16];
#pragma unroll
    for (int b = 0; b < 16; ++b) acc[b] = 0.f;
    for (int k0 = 0; k0 < 64; k0 += 32) { float wv[32];
#pragma unroll
        for (int kk = 0; kk < 32; ++kk) wv[kk] = F.w_ada[(size_t)(ks * 64 + k0 + kk) * 6144 + n0 + col];
#pragma unroll
        for (int kk = 0; kk < 32; ++kk) { const int k = ks * 64 + k0 + kk;
#pragma unroll
            for (int b = 0; b < 16; ++b) acc[b] += sil[b * 1024 + k] * wv[kk]; } }
#pragma unroll
    for (int b = 0; b < 16; ++b) red[(ks * 16 + b) * 32 + col] = acc[b];
    __syncthreads();
    { const int b = F.tid >> 5; float s = 0.f;
#pragma unroll
      for (int k2 = 0; k2 < 16; ++k2) s += red[(k2 * 16 + b) * 32 + col];
      WSP(float, WS_MOD)[b * 6144 + n0 + col] = s + F.b_ada[n0 + col]; }
    __syncthreads();
}

__device__ __forceinline__ void p0_s5_tables(Frame& F, int g, int part) {
    LAS f32x2* pw = (LAS f32x2*)F.lds;
    LAS f32x2* Bb = (LAS f32x2*)(F.lds + 20480);
    LAS f32x2* Cc = (LAS f32x2*)(F.lds + 28672);
    LAS float* Kn = (LAS float*)(F.lds + 36864);
    const float dt = expf(F.log_dt[g]);
    for (int i = F.tid; i < 33 * 64; i += 512) { const int tau = i >> 6, p = i & 63; const float lr = F.lam_re[g * 64 + p], li = F.lam_im[g * 64 + p];
        const float mag = expf(lr * dt * (float)tau), ang = li * dt * (float)tau; float sn, cs; sincosf(ang, &sn, &cs); pw[i] = (f32x2){mag * cs, mag * sn}; }
    for (int i = F.tid; i < 1024; i += 512) { const int p = i >> 4, hi = i & 15; const float lr = F.lam_re[g * 64 + p], li = F.lam_im[g * 64 + p];
        const float mag = expf(lr * dt), ang = li * dt; float sn, cs; sincosf(ang, &sn, &cs);
        const float nr = mag * cs - 1.0f, ni = mag * sn, den = lr * lr + li * li, qr = (nr * lr + ni * li) / den, qi = (ni * lr - nr * li) / den;
        const float br = F.b_re[(g * 64 + p) * 16 + hi], bi = F.b_im[(g * 64 + p) * 16 + hi];
        Bb[i] = (f32x2){qr * br - qi * bi, qr * bi + qi * br};
        Cc[i] = (f32x2){F.c_re[g * 1024 + i], F.c_im[g * 1024 + i]}; }
    __syncthreads();
    { const int tau = F.tid >> 4, ho = F.tid & 15;
      if (tau <= 4 * part + 3) { float kacc[16];
#pragma unroll
        for (int hi = 0; hi < 16; ++hi) kacc[hi] = 0.f;
        for (int p = 0; p < 64; ++p) { const f32x2 c = Cc[ho * 64 + p], a = pw[tau * 64 + p];
            const float wr_ = c.x * a.x - c.y * a.y, wi_ = c.x * a.y + c.y * a.x;
#pragma unroll
            for (int hi = 0; hi < 16; ++hi) { const f32x2 b = Bb[p * 16 + hi]; kacc[hi] += wr_ * b.x - wi_ * b.y; } }
#pragma unroll
        for (int hi = 0; hi < 16; ++hi) Kn[F.tid * 16 + hi] = kacc[hi]; } }
    __syncthreads();
    bf16_t* T2 = WSP(bf16_t, WS_T2); bf16_t* T1 = WSP(bf16_t, WS_T1);
    for (int i = F.tid; i < 64 * 320; i += 512) { const int n = 64 * part + i / 320, k = 2 * (i % 320), tl = n >> 4, ho = n & 15; float v0, v1;
        if (k < KU) { const int sl = k >> 4, hi = k & 15;
            if (sl <= tl) { v0 = Kn[((tl - sl) * 16 + ho) * 16 + hi]; v1 = Kn[((tl - sl) * 16 + ho) * 16 + hi + 1];
                if (sl == tl) { const float dsk = F.d_skip[g * 16 + ho]; if (hi == ho) v0 += dsk; if (hi + 1 == ho) v1 += dsk; } }
            else { v0 = 0.f; v1 = 0.f; } }
        else { const int p = (k - KU) >> 1; const f32x2 c = Cc[ho * 64 + p], a = pw[(tl + 1) * 64 + p]; v0 = c.x * a.x - c.y * a.y; v1 = -(c.x * a.y + c.y * a.x); }
        *(unsigned*)(T2 + ((size_t)(g * 512 + n) * KA2 + k)) = pk2(v0, v1); }
    for (int i = F.tid; i < 16 * 256; i += 512) { const int n1 = 16 * part + (i >> 8), k = 2 * (i & 255), p = n1 >> 1, ri = n1 & 1, sl = k >> 4, hi = k & 15;
        const f32x2 a = pw[(31 - sl) * 64 + p], b0 = Bb[p * 16 + hi], b1 = Bb[p * 16 + hi + 1];
        const float v0 = ri ? (a.x * b0.y + a.y * b0.x) : (a.x * b0.x - a.y * b0.y), v1 = ri ? (a.x * b1.y + a.y * b1.x) : (a.x * b1.x - a.y * b1.y);
        *(unsigned*)(T1 + ((size_t)(g * 256 + n1) * KU + k)) = pk2(v0, v1);
        *(unsigned*)(T1 + ((size_t)(g * 256 + 128 + n1) * KU + k)) = 0u; }
    if (part == 0 && F.tid < 64) { const f32x2 a = pw[32 * 64 + F.tid]; WSP(f32x2, WS_AB32)[g * 64 + F.tid] = a; }
    __syncthreads();
}

__device__ __forceinline__ void p0_prologue(Frame& F) {
#ifndef P0_REPS_MOD
#define P0_REPS_MOD 1
#define P0_REPS_TAB 1
#define P0_REPS_TR 1
#endif
    for (int rp = 0; rp < P0_REPS_MOD; ++rp) if (F.blk < 192) p0_mod(F);
    for (int rp = 0; rp < P0_REPS_TAB; ++rp) { const int it = 255 - F.blk; if (it < 128) p0_s5_tables(F, it >> 3, 7 - (it & 7)); }
    __syncthreads();
    { u32x4* z = (u32x4*)(WSP(bf16_t, WS_WSR_T) + (size_t)576 * 1024); const int nz = 192 * 1024 * 2 / 16;
      for (int i = F.blk * 512 + F.tid; i < nz; i += F.G * 512) z[i] = (u32x4){0u, 0u, 0u, 0u}; }
    LAS float* scr = (LAS float*)(F.lds + F.wave * 16384);
    const int gw = F.vcu * 8 + F.wave, NGW = F.G * 8;
    constexpr int I0 = 1280, I1 = 512, I2 = 32, I3 = 128, I4 = 128, I5 = 32, I6 = 128, I7 = 8192, I8 = 8192, I9 = 8192;
    constexpr int NITEMS = I0 + I1 + I2 + I3 + I4 + I5 + I6 + I7 + I8 + I9;
    for (int rp = 0; rp < P0_REPS_TR; ++rp)
    for (int it = gw; it < NITEMS; it += NGW) {
        int r = it;
        if (r < I0) { const int kb = r / 80, nb = r % 80; transpose_item(F.w_in, DIN, 64 * kb, 32 * nb, WSP(bf16_t, WS_WIN_T), 1024, 32 * nb, scr, F.lane); continue; } r -= I0;
        if (r < I1) { const int kb = r / 32, nb = r % 32; transpose_item(F.w_out, 1024, 64 * kb, 32 * nb, WSP(bf16_t, WS_WOUT_T), 1024, 32 * nb, scr, F.lane); continue; } r -= I1;
        if (r < I2) { const int kb = r / 8, nb = r % 8; transpose_item(F.w_glu, 256, 64 * kb, 32 * nb, WSP(bf16_t, WS_WGLU_T), 256, 32 * nb, scr, F.lane); continue; } r -= I2;
        if (r < I3) { const int kb = r / 8, nb = r % 8, n0 = 32 * nb; transpose_item(F.ws1, 256, 64 * kb, n0, WSP(bf16_t, WS_WSR_T), 1024, (n0 >> 7) * 256 + (n0 & 127), scr, F.lane); continue; } r -= I3;
        if (r < I4) { const int kb = r / 8, nb = r % 8, n0 = 32 * nb; transpose_item(F.ws3, 256, 64 * kb, n0, WSP(bf16_t, WS_WSR_T), 1024, (n0 >> 7) * 256 + 128 + (n0 & 127), scr, F.lane); continue; } r -= I4;
        if (r < I5) { const int kb = r / 2, nb = r % 2; transpose_item(F.w_router, 64, 64 * kb, 32 * nb, WSP(bf16_t, WS_WSR_T), 1024, 512 + 32 * nb, scr, F.lane); continue; } r -= I5;
        if (r < I6) { const int kb = r / 32, nb = r % 32; transpose_item<1>(F.ws2, 1024, 64 * kb, 32 * nb, WSP(bf16_t, WS_WS2_T), 256, 32 * nb, scr, F.lane); continue; } r -= I6;
        if (r < I7) { const int e = r >> 7, q = r & 127, kb = q / 8, nb = q % 8, n0 = 32 * nb;
            transpose_item(F.w1 + (size_t)e * 1024 * 256, 256, 64 * kb, n0, WSP(bf16_t, WS_W13T) + (size_t)e * 512 * 1024, 1024, (n0 >> 7) * 256 + (n0 & 127), scr, F.lane); continue; } r -= I7;
        if (r < I8) { const int e = r >> 7, q = r & 127, kb = q / 8, nb = q % 8, n0 = 32 * nb;
            transpose_item(F.w3 + (size_t)e * 1024 * 256, 256, 64 * kb, n0, WSP(bf16_t, WS_W13T) + (size_t)e * 512 * 1024, 1024, (n0 >> 7) * 256 + 128 + (n0 & 127), scr, F.lane); continue; } r -= I8;
        { const int e = r >> 7, q = r & 127, kb = q / 32, nb = q % 32;
            transpose_item<1>(F.w2 + (size_t)e * 256 * 1024, 1024, 64 * kb, 32 * nb, WSP(bf16_t, WS_W2T) + (size_t)e * 1024 * 256, 256, 32 * nb, scr, F.lane); }
    }
}

__device__ __forceinline__ void p1_h(Frame& F) {
    const float* mod = WSP(float, WS_MOD); bf16_t* H = WSP(bf16_t, WS_H);
    const int NGW = F.G * 8;
    for (int t0 = F.blk * 8 + F.wave; t0 < T; t0 += 4 * NGW) {
        f32x4 v[4][4]; float ss[4];
#pragma unroll
        for (int q = 0; q < 4; ++q) { const int t = t0 + q * NGW; const f32x4* xr = (const f32x4*)(F.x + (size_t)t * D) + F.lane;
#pragma unroll
            for (int j = 0; j < 4; ++j) v[q][j] = xr[64 * j]; }
#pragma unroll
        for (int q = 0; q < 4; ++q) { float a = 0.f;
#pragma unroll
            for (int j = 0; j < 4; ++j) a += (v[q][j].x * v[q][j].x + v[q][j].y * v[q][j].y) + (v[q][j].z * v[q][j].z + v[q][j].w * v[q][j].w);
            ss[q] = a; }
#pragma unroll
        for (int o = 1; o < 64; o <<= 1) {
#pragma unroll
            for (int q = 0; q < 4; ++q) ss[q] += __shfl_xor(ss[q], o); }
#pragma unroll
        for (int q = 0; q < 4; ++q) { const int t = t0 + q * NGW; const int b = t >> 12; const float rstd = rsqrtf(ss[q] * (1.0f / D) + RMS_EPS);
#pragma unroll
            for (int j = 0; j < 4; ++j) { const int c0 = 4 * F.lane + 256 * j;
                const f32x4 gm = *(const f32x4*)(F.g_mix + c0), sh = *(const f32x4*)(mod + b * 6144 + c0), sc = *(const f32x4*)(mod + b * 6144 + 1024 + c0);
                const f32x4 h = v[q][j] * rstd * gm * (sc + 1.0f) + sh;
                *(u32x2*)(H + (size_t)t * D + c0) = (u32x2){pk2(h.x, h.y), pk2(h.z, h.w)}; } }
    }
}

__device__ __forceinline__ u32x4 pack8(const f32x4 a, const f32x4 b) { return (u32x4){pk2(a.x, a.y), pk2(a.z, a.w), pk2(b.x, b.y), pk2(b.z, b.w)}; }
#define EPI_FOR_ROWS _Pragma("unroll") for (int ai = 0; ai < 2; ++ai) _Pragma("unroll") for (int m = 0; m < 4; ++m)
#define EPI_ROWL (ai * 128 + wr * 64 + m * 16 + fr)

struct SchedG1 { TileOrder o; const char* A; const char* B;
    __device__ __forceinline__ bool next(int i, Unit& u) const { int pm, pn; if (!o.tile(i, pm, pn)) return false; u.pm = pm; u.pn = pn; u.aux = 0; u.rows = nullptr;
        u.A = A + (size_t)pm * 256 * 1024 * 2; u.B = B + (size_t)pn * 256 * 1024 * 2; return true; } };
struct EpiG1 { static constexpr bool PERM = true; bf16_t* projc; bf16_t* A2;
    __device__ __forceinline__ void operator()(const f32x4 (&acc)[2][2][4][2], const Unit& u_in, int wr, int wc, int fr_in, int fq_in) const {
        Unit u = u_in; asm volatile("" : "+s"(u.pm), "+s"(u.pn), "+s"(u.aux)); int fr = fr_in, fq = fq_in; asm volatile("" : "+v"(fr), "+v"(fq));
        EPI_FOR_ROWS { const int row = u.pm * 256 + EPI_ROWL;
#pragma unroll
            for (int bj = 0; bj < 2; ++bj) { const int col = bj * 128 + wc * 32 + 8 * fq; const u32x4 w = pack8(acc[ai][bj][m][0], acc[ai][bj][m][1]);
                if (u.pn < 9) *(u32x4*)(projc + (size_t)row * 2304 + u.pn * 256 + col) = w;
                else { const int g = col >> 4, hi0 = col & 15, chunk = row >> 5, sl = row & 31; *(u32x4*)(A2 + ((size_t)(g * NCHUNK + chunk) * KA2 + sl * 16 + hi0)) = w; } } }
    } };

struct SchedS5a { int G, c; const char* A2; const char* T1;
    __device__ __forceinline__ bool next(int i, Unit& u) const { const int L = i * G + c; if (L >= 128) return false; const int g = L >> 3, pm = L & 7; u.pm = pm; u.pn = 0; u.aux = g; u.rows = nullptr;
        u.A = A2 + (size_t)(g * NCHUNK + pm * 256) * KA2 * 2; u.B = T1 + (size_t)g * 256 * KU * 2; return true; } };
struct EpiS5a { static constexpr bool PERM = false; float* S;
    __device__ __forceinline__ void operator()(const f32x4 (&acc)[2][2][4][2], const Unit& u_in, int wr, int wc, int fr_in, int fq_in) const {
        Unit u = u_in; asm volatile("" : "+s"(u.pm), "+s"(u.pn), "+s"(u.aux)); int fr = fr_in, fq = fq_in; asm volatile("" : "+v"(fr), "+v"(fq));
        EPI_FOR_ROWS { const int row = u.pm * 256 + EPI_ROWL;
#pragma unroll
            for (int n = 0; n < 2; ++n) { const int col = wc * 32 + 16 * n + 4 * fq; *(f32x4*)(S + ((size_t)(u.aux * NCHUNK + row) * 128 + col)) = acc[ai][0][m][n]; } }
    } };

struct SchedS5b { int G, c; const char* A2; const char* T2;
    __device__ __forceinline__ bool next(int i, Unit& u) const { const int L = i * G + c; if (L >= 256) return false; const int g = L >> 4, pm = (L >> 1) & 7, pn = L & 1; u.pm = pm; u.pn = pn; u.aux = g; u.rows = nullptr;
        u.A = A2 + (size_t)(g * NCHUNK + pm * 256) * KA2 * 2; u.B = T2 + (size_t)(g * 512 + pn * 256) * KA2 * 2; return true; } };
struct EpiS5b { static constexpr bool PERM = true; bf16_t* ys;
    __device__ __forceinline__ void operator()(const f32x4 (&acc)[2][2][4][2], const Unit& u_in, int wr, int wc, int fr_in, int fq_in) const {
        Unit u = u_in; asm volatile("" : "+s"(u.pm), "+s"(u.pn), "+s"(u.aux)); int fr = fr_in, fq = fq_in; asm volatile("" : "+v"(fr), "+v"(fq));
        EPI_FOR_ROWS { const int chunk = u.pm * 256 + EPI_ROWL;
#pragma unroll
            for (int bj = 0; bj < 2; ++bj) { const int n = u.pn * 256 + bj * 128 + wc * 32 + 8 * fq, tl = n >> 4, ho0 = n & 15; const size_t t = (size_t)chunk * LCH + tl;
                f32x4 a = acc[ai][bj][m][0], b = acc[ai][bj][m][1];
#pragma unroll
                for (int j = 0; j < 4; ++j) { a[j] = gelu_tanh(a[j]); b[j] = gelu_tanh(b[j]); }
                *(u32x4*)(ys + t * 256 + u.aux * 16 + ho0) = pack8(a, b); } }
    } };

struct SchedGlu { int G, c; const char* ys; const char* W;
    __device__ __forceinline__ bool next(int i, Unit& u) const { const int L = i * G + c; if (L >= 256) return false; u.pm = L; u.pn = 0; u.aux = 0; u.rows = nullptr;
        u.A = ys + (size_t)L * 256 * 256 * 2; u.B = W; return true; } };
struct EpiGlu { static constexpr bool PERM = true; const bf16_t* ys; const float* b_glu; const float* g_ssm; bf16_t* ycat; LAS float* scr;
    __device__ __forceinline__ void operator()(f32x4 (&acc)[2][2][4][2], const Unit& u_in, int wr, int wc, int fr_in, int fq_in) const {
        Unit u = u_in; asm volatile("" : "+s"(u.pm), "+s"(u.pn), "+s"(u.aux)); int fr = fr_in, fq = fq_in; asm volatile("" : "+v"(fr), "+v"(fq));
        f32x4 bg[2][2];
#pragma unroll
        for (int bj = 0; bj < 2; ++bj) { const int col = bj * 128 + wc * 32 + 8 * fq; bg[bj][0] = *(const f32x4*)(b_glu + col); bg[bj][1] = *(const f32x4*)(b_glu + col + 4); }
#pragma unroll
        for (int ai = 0; ai < 2; ++ai) {
            u32x4 yw[4][2];
#pragma unroll
            for (int m = 0; m < 4; ++m)
#pragma unroll
                for (int bj = 0; bj < 2; ++bj) yw[m][bj] = *(const u32x4*)(ys + ((size_t)u.pm * 256 + EPI_ROWL) * 256 + bj * 128 + wc * 32 + 8 * fq);
#pragma unroll
            for (int m = 0; m < 4; ++m) { const int rl = EPI_ROWL; float ss = 0.f;
#pragma unroll
                for (int bj = 0; bj < 2; ++bj) { const u32x4 w = yw[m][bj];
                    const f32x4 y0 = (f32x4){bflo(w.x), bfhi(w.x), bflo(w.y), bfhi(w.y)}, y1 = (f32x4){bflo(w.z), bfhi(w.z), bflo(w.w), bfhi(w.w)};
#pragma unroll
                    for (int j = 0; j < 4; ++j) { const float o0 = y0[j] * sigmoidf_(acc[ai][bj][m][0][j] + bg[bj][0][j]), o1 = y1[j] * sigmoidf_(acc[ai][bj][m][1][j] + bg[bj][1][j]);
                        acc[ai][bj][m][0][j] = o0; acc[ai][bj][m][1][j] = o1; ss += o0 * o0 + o1 * o1; } }
                ss += __shfl_xor(ss, 16); ss += __shfl_xor(ss, 32);
                if (fq == 0) scr[rl * 4 + wc] = ss; }
            asm volatile("" ::: "memory"); }
        LDS_WAIT(); __builtin_amdgcn_s_barrier(); asm volatile("" ::: "memory");
        f32x4 gs[2][2];
#pragma unroll
        for (int bj = 0; bj < 2; ++bj) { const int col = bj * 128 + wc * 32 + 8 * fq; gs[bj][0] = *(const f32x4*)(g_ssm + col); gs[bj][1] = *(const f32x4*)(g_ssm + col + 4); }
        EPI_FOR_ROWS { const int rl = EPI_ROWL; const size_t row = (size_t)u.pm * 256 + rl; const f32x4 p = *(const LAS f32x4*)(scr + rl * 4);
            const float rstd = rsqrtf(((p.x + p.y) + (p.z + p.w)) * (1.0f / 256.0f) + RMS_EPS);
#pragma unroll
            for (int bj = 0; bj < 2; ++bj) { const int col = bj * 128 + wc * 32 + 8 * fq;
                *(u32x4*)(ycat + row * 1024 + 768 + col) = pack8(acc[ai][bj][m][0] * rstd * gs[bj][0], acc[ai][bj][m][1] * rstd * gs[bj][1]); } }
        LDS_WAIT(); __builtin_amdgcn_s_barrier(); asm volatile("" ::: "memory");
    } };

struct SchedG2 { int c; const char* A; const char* B;
    __device__ __forceinline__ bool next(int i, Unit& u) const { if (i >= 4 || c >= 256) return false; u.pm = c; u.pn = i; u.aux = 0; u.rows = nullptr;
        u.A = A + (size_t)c * 256 * 1024 * 2; u.B = B + (size_t)i * 256 * 1024 * 2; return true; } };
struct EpiG2 { static constexpr bool PERM = true; const float* x; const float* mod; bf16_t* x1; LAS float* scr;
    __device__ __forceinline__ void operator()(const f32x4 (&acc)[2][2][4][2], const Unit& u_in, int wr, int wc, int fr_in, int fq_in) const {
        Unit u = u_in; asm volatile("" : "+s"(u.pm), "+s"(u.pn), "+s"(u.aux)); int fr = fr_in, fq = fq_in; asm volatile("" : "+v"(fr), "+v"(fq));
        const int b = u.pm >> 4;
        f32x4 gt[2][2];
#pragma unroll
        for (int bj = 0; bj < 2; ++bj) { const int col = u.pn * 256 + bj * 128 + wc * 32 + 8 * fq; gt[bj][0] = *(const f32x4*)(mod + b * 6144 + 2048 + col); gt[bj][1] = *(const f32x4*)(mod + b * 6144 + 2048 + col + 4); }
#pragma unroll
        for (int ai = 0; ai < 2; ++ai) {
            f32x4 xv[4][2][2];
#pragma unroll
            for (int m = 0; m < 4; ++m)
#pragma unroll
                for (int bj = 0; bj < 2; ++bj) { const float* p = x + ((size_t)u.pm * 256 + EPI_ROWL) * 1024 + u.pn * 256 + bj * 128 + wc * 32 + 8 * fq; xv[m][bj][0] = *(const f32x4*)p; xv[m][bj][1] = *(const f32x4*)(p + 4); }
#pragma unroll
            for (int m = 0; m < 4; ++m) { const int rl = EPI_ROWL; const size_t row = (size_t)u.pm * 256 + rl; float ss = 0.f;
#pragma unroll
                for (int bj = 0; bj < 2; ++bj) { const int col = u.pn * 256 + bj * 128 + wc * 32 + 8 * fq;
                    const f32x4 o0 = xv[m][bj][0] + gt[bj][0] * acc[ai][bj][m][0], o1 = xv[m][bj][1] + gt[bj][1] * acc[ai][bj][m][1];
                    ss += (o0.x * o0.x + o0.y * o0.y) + (o0.z * o0.z + o0.w * o0.w) + (o1.x * o1.x + o1.y * o1.y) + (o1.z * o1.z + o1.w * o1.w);
                    *(u32x4*)(x1 + row * 1024 + col) = pack8(o0, o1); }
                ss += __shfl_xor(ss, 16); ss += __shfl_xor(ss, 32);
                if (fq == 0) scr[rl * 16 + u.pn * 4 + wc] = ss; }
            asm volatile("" ::: "memory"); }
    } };

struct SchedRS { TileOrder o; const char* A; const char* B;
    __device__ __forceinline__ bool next(int i, Unit& u) const { int pm, pn; if (!o.tile(i, pm, pn)) return false; u.pm = pm; u.pn = pn; u.aux = 0; u.rows = nullptr;
        u.A = A + (size_t)pm * 256 * 1024 * 2; u.B = B + (size_t)pn * 256 * 1024 * 2; return true; } };
struct EpiRS { static constexpr bool PERM = true; bf16_t* acts; float* logits;
    __device__ __forceinline__ void operator()(const f32x4 (&acc)[2][2][4][2], const Unit& u_in, int wr, int wc, int fr_in, int fq_in) const {
        Unit u = u_in; asm volatile("" : "+s"(u.pm), "+s"(u.pn), "+s"(u.aux)); int fr = fr_in, fq = fq_in; asm volatile("" : "+v"(fr), "+v"(fq));
        EPI_FOR_ROWS { const size_t row = (size_t)u.pm * 256 + EPI_ROWL;
            if (u.pn < 2) { f32x4 o0, o1;
#pragma unroll
                for (int j = 0; j < 4; ++j) { o0[j] = siluf_(acc[ai][0][m][0][j]) * acc[ai][1][m][0][j]; o1[j] = siluf_(acc[ai][0][m][1][j]) * acc[ai][1][m][1][j]; }
                *(u32x4*)(acts + row * 256 + u.pn * 128 + wc * 32 + 8 * fq) = pack8(o0, o1); }
            else if (wc < 2) { const int col = wc * 32 + 8 * fq; *(f32x4*)(logits + row * 64 + col) = acc[ai][0][m][0]; *(f32x4*)(logits + row * 64 + col + 4) = acc[ai][0][m][1]; } }
    } };

struct SchedUp { int G, c, nblk; const int* blk_e; const int* tok; const char* H2; const char* W13;
    __device__ __forceinline__ bool next(int i, Unit& u) const { const int L = i * G + c; if (L >= 2 * nblk) return false; const int j = L >> 1, h = L & 1;
        const int e = __builtin_amdgcn_readfirstlane(ld_i32_agent(blk_e + j)); u.pm = j; u.pn = h; u.aux = e; u.rows = tok + 2 * j * 256; u.A = H2; u.B = W13 + (size_t)(e * 2 + h) * 256 * 1024 * 2; return true; } };
struct EpiUp { static constexpr bool PERM = true; bf16_t* act;
    __device__ __forceinline__ void operator()(const f32x4 (&acc)[2][2][4][2], const Unit& u_in, int wr, int wc, int fr_in, int fq_in) const {
        Unit u = u_in; asm volatile("" : "+s"(u.pm), "+s"(u.pn), "+s"(u.aux)); int fr = fr_in, fq = fq_in; asm volatile("" : "+v"(fr), "+v"(fq));
        EPI_FOR_ROWS { const size_t row = (size_t)u.pm * 256 + EPI_ROWL; f32x4 o0, o1;
#pragma unroll
            for (int j = 0; j < 4; ++j) { o0[j] = siluf_(acc[ai][0][m][0][j]) * acc[ai][1][m][0][j]; o1[j] = siluf_(acc[ai][0][m][1][j]) * acc[ai][1][m][1][j]; }
            *(u32x4*)(act + row * 256 + u.pn * 128 + wc * 32 + 8 * fq) = pack8(o0, o1); }
    } };

struct SchedDown { int G, c, nblk; const int* blk_e; const char* act; const char* acts; const char* W2; const char* WS2;
    __device__ __forceinline__ bool next(int i, Unit& u) const { const int L = i * G + c; u.rows = nullptr;
        if (L < 4 * nblk) { const int j = L >> 2, pn = L & 3; const int e = __builtin_amdgcn_readfirstlane(ld_i32_agent(blk_e + j)); u.pm = j; u.pn = pn; u.aux = 0;
            u.A = act + (size_t)j * 256 * 256 * 2; u.B = W2 + (size_t)(e * 1024 + pn * 256) * 256 * 2; return true; }
        const int L2 = L - 4 * nblk; if (L2 >= 1024) return false; u.pm = L2 >> 2; u.pn = L2 & 3; u.aux = 1;
        u.A = acts + (size_t)u.pm * 256 * 256 * 2; u.B = WS2 + (size_t)u.pn * 256 * 256 * 2; return true; } };
struct EpiDown { static constexpr bool PERM = true; const u32x2* rec; unsigned char* Y8; bf16_t* x1; const float* mod;
    __device__ __forceinline__ void operator()(const f32x4 (&acc)[2][2][4][2], const Unit& u_in, int wr, int wc, int fr_in, int fq_in) const {
        Unit u = u_in; asm volatile("" : "+s"(u.pm), "+s"(u.pn), "+s"(u.aux)); int fr = fr_in, fq = fq_in; asm volatile("" : "+v"(fr), "+v"(fq));
        const int col0 = u.pn * 256 + wc * 64 + fq * 16;
        if (u.aux == 0) {
            int dd[2][4]; float ww[2][4]; unsigned du[2][4], wu[2][4];
            EPI_FOR_ROWS { const unsigned* rp = (const unsigned*)rec + 2 * (u.pm * 256 + EPI_ROWL); du[ai][m] = rp[0]; wu[ai][m] = rp[1]; }
            EPI_FOR_ROWS { asm volatile("" : "+v"(du[ai][m]), "+v"(wu[ai][m])); dd[ai][m] = (int)du[ai][m]; ww[ai][m] = __builtin_bit_cast(float, wu[ai][m]) * 16.0f; }
            EPI_FOR_ROWS { const int d = dd[ai][m]; const float wt = ww[ai][m];
                if (d >= 0) { const int tok = d & 0xffff, k = d >> 16; u32x4 w;
#pragma unroll
                    for (int q = 0; q < 4; ++q) { const f32x4 v = acc[ai][q >> 1][m][q & 1] * wt; int pk = 0;
                        pk = __builtin_amdgcn_cvt_pk_fp8_f32(v.x, v.y, pk, false); pk = __builtin_amdgcn_cvt_pk_fp8_f32(v.z, v.w, pk, true); w[q] = (unsigned)pk; }
                    *(u32x4*)(Y8 + ((size_t)tok * 6 + k) * 1024 + col0) = w; } }
        } else {
            const int b = u.pm >> 4;
            f32x4 gt[2][2];
#pragma unroll
            for (int bj = 0; bj < 2; ++bj) { gt[bj][0] = *(const f32x4*)(mod + b * 6144 + 5120 + col0 + 8 * bj); gt[bj][1] = *(const f32x4*)(mod + b * 6144 + 5120 + col0 + 8 * bj + 4); }
#pragma unroll
            for (int ai = 0; ai < 2; ++ai) {
                u32x4 xw[4][2];
#pragma unroll
                for (int m = 0; m < 4; ++m)
#pragma unroll
                    for (int bj = 0; bj < 2; ++bj) xw[m][bj] = *(const u32x4*)(x1 + ((size_t)u.pm * 256 + EPI_ROWL) * 1024 + col0 + 8 * bj);
#pragma unroll
                for (int m = 0; m < 4; ++m) { const size_t row = (size_t)u.pm * 256 + EPI_ROWL;
#pragma unroll
                    for (int bj = 0; bj < 2; ++bj) { const u32x4 w = xw[m][bj];
                        const f32x4 x0 = (f32x4){bflo(w.x), bfhi(w.x), bflo(w.y), bfhi(w.y)}, x1v = (f32x4){bflo(w.z), bfhi(w.z), bflo(w.w), bfhi(w.w)};
                        *(u32x4*)(x1 + row * 1024 + col0 + 8 * bj) = pack8(x0 + gt[bj][0] * acc[ai][bj][m][0], x1v + gt[bj][1] * acc[ai][bj][m][1]); } }
                asm volatile("" ::: "memory"); }
        }
    } };

__device__ __forceinline__ void p3_conv(Frame& F) {
    const bf16_t* P = WSP(bf16_t, WS_PROJC); bf16_t* Y = WSP(bf16_t, WS_YCAT);
    for (int chunk = F.blk * 8 + F.wave; chunk < NCHUNK; chunk += F.G * 8) {
        const int t0 = chunk * LCH;
        f32x4 w0[3], w1[3], w2[3], cb[3], gc[3], z1[3], z2[3];
#pragma unroll
        for (int j = 0; j < 3; ++j) { const int c0 = 4 * F.lane + 256 * j;
            w0[j] = *(const f32x4*)(F.conv_w + c0); w1[j] = *(const f32x4*)(F.conv_w + DCONV + c0); w2[j] = *(const f32x4*)(F.conv_w + 2 * DCONV + c0);
            cb[j] = *(const f32x4*)(F.conv_b + c0); gc[j] = *(const f32x4*)(F.g_conv + c0); z1[j] = (f32x4){0.f, 0.f, 0.f, 0.f}; z2[j] = z1[j]; }
        if ((t0 & (SEQ - 1)) != 0) {
#pragma unroll
            for (int j = 0; j < 3; ++j) { const int c0 = 4 * F.lane + 256 * j;
                const u32x2 ca = *(const u32x2*)(P + (size_t)(t0 - 2) * 2304 + 768 + c0), va = *(const u32x2*)(P + (size_t)(t0 - 2) * 2304 + 1536 + c0);
                const u32x2 cb_ = *(const u32x2*)(P + (size_t)(t0 - 1) * 2304 + 768 + c0), vb = *(const u32x2*)(P + (size_t)(t0 - 1) * 2304 + 1536 + c0);
                z2[j] = (f32x4){bflo(ca.x) * bflo(va.x), bfhi(ca.x) * bfhi(va.x), bflo(ca.y) * bflo(va.y), bfhi(ca.y) * bfhi(va.y)};
                z1[j] = (f32x4){bflo(cb_.x) * bflo(vb.x), bfhi(cb_.x) * bfhi(vb.x), bflo(cb_.y) * bflo(vb.y), bfhi(cb_.y) * bfhi(vb.y)}; }
        }
        for (int tt = 0; tt < LCH; tt += 4) {
            u32x2 bw[4][3], cw[4][3], vw[4][3];
#pragma unroll
            for (int q = 0; q < 4; ++q) { const size_t t = (size_t)t0 + tt + q;
#pragma unroll
                for (int j = 0; j < 3; ++j) { const int c0 = 4 * F.lane + 256 * j;
                    bw[q][j] = *(const u32x2*)(P + t * 2304 + c0); cw[q][j] = *(const u32x2*)(P + t * 2304 + 768 + c0); vw[q][j] = *(const u32x2*)(P + t * 2304 + 1536 + c0); } }
            f32x4 val[4][3]; float ss[4];
#pragma unroll
            for (int q = 0; q < 4; ++q) { float a = 0.f;
#pragma unroll
                for (int j = 0; j < 3; ++j) {
                    const f32x4 bg = (f32x4){bflo(bw[q][j].x), bfhi(bw[q][j].x), bflo(bw[q][j].y), bfhi(bw[q][j].y)};
                    const f32x4 z = (f32x4){bflo(cw[q][j].x) * bflo(vw[q][j].x), bfhi(cw[q][j].x) * bfhi(vw[q][j].x), bflo(cw[q][j].y) * bflo(vw[q][j].y), bfhi(cw[q][j].y) * bfhi(vw[q][j].y)};
                    val[q][j] = bg * (w0[j] * z2[j] + w1[j] * z1[j] + w2[j] * z + cb[j]); z2[j] = z1[j]; z1[j] = z;
                    a += (val[q][j].x * val[q][j].x + val[q][j].y * val[q][j].y) + (val[q][j].z * val[q][j].z + val[q][j].w * val[q][j].w); }
                ss[q] = a; }
#pragma unroll
            for (int o = 1; o < 64; o <<= 1) {
#pragma unroll
                for (int q = 0; q < 4; ++q) ss[q] += __shfl_xor(ss[q], o); }
#pragma unroll
            for (int q = 0; q < 4; ++q) { const size_t t = (size_t)t0 + tt + q; const float rstd = rsqrtf(ss[q] * (1.0f / DCONV) + RMS_EPS);
#pragma unroll
                for (int j = 0; j < 3; ++j) { const int c0 = 4 * F.lane + 256 * j; const f32x4 o = val[q][j] * rstd * gc[j];
                    *(u32x2*)(Y + t * 1024 + c0) = (u32x2){pk2(o.x, o.y), pk2(o.z, o.w)}; } }
        }
    }
}

__device__ __forceinline__ void p4_scan(Frame& F) {
    if (F.wave != 0) return;
    const float* S = WSP(float, WS_S); bf16_t* A2 = WSP(bf16_t, WS_A2);
    for (int bg = F.blk; bg < NB * NG; bg += F.G) { const int b = bg >> 4, g = bg & 15, p = F.lane;
        const f32x2 a = WSP(f32x2, WS_AB32)[g * 64 + p]; float xr = 0.f, xi = 0.f;
#pragma unroll 8
        for (int c = 0; c < 128; ++c) { const size_t chunk = (size_t)g * NCHUNK + b * 128 + c;
            *(unsigned*)(A2 + chunk * KA2 + KU + 2 * p) = pk2(xr, xi);
            const f32x2 s = *(const f32x2*)(S + chunk * 128 + 2 * p);
            const float nr = a.x * xr - a.y * xi + s.x, ni = a.x * xi + a.y * xr + s.y; xr = nr; xi = ni; }
    }
}

__device__ __forceinline__ void p7_post(Frame& F) {
    const float* mod = WSP(float, WS_MOD); const bf16_t* X1 = WSP(bf16_t, WS_X1); bf16_t* H2 = WSP(bf16_t, WS_H2);
    LAS float* scr = (LAS float*)(F.lds + EPI_OFF);
    VM_WAIT(); LDS_WAIT(); __syncthreads();
    if (F.blk >= 256) return;
    const int b = F.blk >> 4;
    f32x4 gf[4], sh[4], sc[4];
#pragma unroll
    for (int j = 0; j < 4; ++j) { const int c0 = 4 * F.lane + 256 * j; gf[j] = *(const f32x4*)(F.g_ffn + c0); sh[j] = *(const f32x4*)(mod + b * 6144 + 3072 + c0); sc[j] = *(const f32x4*)(mod + b * 6144 + 4096 + c0) + 1.0f; gf[j] = gf[j] * sc[j]; }
    for (int i = 0; i < 32; i += 4) {
        u32x2 xw[4][4]; float rstd[4];
#pragma unroll
        for (int q = 0; q < 4; ++q) { const int rl = F.wave * 32 + i + q; const size_t row = (size_t)F.blk * 256 + rl;
#pragma unroll
            for (int j = 0; j < 4; ++j) xw[q][j] = *(const u32x2*)(X1 + row * 1024 + 4 * F.lane + 256 * j);
            float tot = 0.f;
#pragma unroll
            for (int p = 0; p < 4; ++p) { const f32x4 pq = *(const LAS f32x4*)(scr + rl * 16 + 4 * p); tot += (pq.x + pq.y) + (pq.z + pq.w); }
            rstd[q] = rsqrtf(tot * (1.0f / D) + RMS_EPS); }
#pragma unroll
        for (int q = 0; q < 4; ++q) { const size_t row = (size_t)F.blk * 256 + F.wave * 32 + i + q;
#pragma unroll
            for (int j = 0; j < 4; ++j) { const int c0 = 4 * F.lane + 256 * j;
                const f32x4 xv = (f32x4){bflo(xw[q][j].x), bfhi(xw[q][j].x), bflo(xw[q][j].y), bfhi(xw[q][j].y)};
                const f32x4 h = xv * rstd[q] * gf[j] + sh[j];
                *(u32x2*)(H2 + row * 1024 + c0) = (u32x2){pk2(h.x, h.y), pk2(h.z, h.w)}; } }
    }
}

__device__ __forceinline__ void p9_topk(Frame& F) {
    const float* LG = WSP(float, WS_LOGITS); unsigned char* R = F.ws + WS_ROUTE;
    int* sele = (int*)(R + RT_SELE); float* selw = (float*)(R + RT_SELW); int* cntw = (int*)(R + RT_CNTW); int* cntb = (int*)(R + RT_CNTB);
    u32x2* rec = (u32x2*)(R + RT_REC);
    LAS int* lcnt = (LAS int*)F.lds;
    const float NEG = -INFINITY;
    for (int blk = F.blk; blk < 256; blk += F.G) {
        for (int i = F.tid; i < MAXBLK; i += 512) rec[blk * MAXBLK + i] = (u32x2){0xffffffffu, 0u};
        if (F.wave < 4) {
            const int tok = blk * 256 + F.tid;
            float s[64], bb[64];
#pragma unroll
            for (int q = 0; q < 16; ++q) { const f32x4 lg = *(const f32x4*)(LG + (size_t)tok * 64 + 4 * q);
#pragma unroll
                for (int j = 0; j < 4; ++j) { s[4 * q + j] = sigmoidf_(lg[j]); bb[4 * q + j] = s[4 * q + j] + F.router_bias[4 * q + j]; } }
            float gs[8];
#pragma unroll
            for (int g = 0; g < 8; ++g) { float m1 = NEG, m2 = NEG;
#pragma unroll
                for (int j = 0; j < 8; ++j) { const float v = bb[8 * g + j]; if (v > m1) { m2 = m1; m1 = v; } else if (v > m2) { m2 = v; } }
                gs[g] = m1 + m2; }
            unsigned gsel = 0u;
#pragma unroll
            for (int g = 0; g < 8; ++g) { int rk = 0;
#pragma unroll
                for (int g2 = 0; g2 < 8; ++g2) rk += (gs[g2] > gs[g] || (gs[g2] == gs[g] && g2 < g)) ? 1 : 0;
                gsel |= (rk < 4) ? (1u << g) : 0u; }
#pragma unroll
            for (int e = 0; e < 64; ++e) bb[e] = ((gsel >> (e >> 3)) & 1u) ? bb[e] : NEG;
            int ek[6]; float sk[6]; unsigned long long taken = 0ull; float ssum = 0.f;
#pragma unroll
            for (int k = 0; k < 6; ++k) { float best = NEG, bs = 0.f; int bi = 0;
#pragma unroll
                for (int e = 0; e < 64; ++e) { const bool c = (((taken >> e) & 1ull) == 0ull) && (bb[e] > best); best = c ? bb[e] : best; bs = c ? s[e] : bs; bi = c ? e : bi; }
                ek[k] = bi; sk[k] = bs; taken |= 1ull << bi; ssum += bs; }
            int rk[6] = {0, 0, 0, 0, 0, 0}; int mycnt = 0;
#pragma unroll
            for (int e = 0; e < 64; ++e) { const bool hit = ((taken >> e) & 1ull) != 0ull; const unsigned long long m = __ballot(hit);
                const int pre = __builtin_amdgcn_mbcnt_hi((unsigned)(m >> 32), __builtin_amdgcn_mbcnt_lo((unsigned)m, 0u));
#pragma unroll
                for (int k = 0; k < 6; ++k) rk[k] = (ek[k] == e) ? pre : rk[k];
                mycnt = (F.lane == e) ? __popcll(m) : mycnt; }
            const float inv = 2.5f / ssum;
#pragma unroll
            for (int k = 0; k < 6; ++k) { sele[(size_t)tok * 6 + k] = ek[k] | (rk[k] << 8); selw[(size_t)tok * 6 + k] = sk[k] * inv; }
            cntw[(blk * 4 + F.wave) * 64 + F.lane] = mycnt; lcnt[F.wave * 64 + F.lane] = mycnt;
        }
        __syncthreads();
        if (F.tid < 64) cntb[blk * 64 + F.tid] = (lcnt[F.tid] + lcnt[64 + F.tid]) + (lcnt[128 + F.tid] + lcnt[192 + F.tid]);
        __syncthreads();
    }
}

__device__ __forceinline__ void p10_scatter(Frame& F) {
    unsigned char* R = F.ws + WS_ROUTE;
    const int* sele = (const int*)(R + RT_SELE); const float* selw = (const float*)(R + RT_SELW); const int* cntw = (const int*)(R + RT_CNTW); const int* cntb = (const int*)(R + RT_CNTB);
    u32x2* rec = (u32x2*)(R + RT_REC);
    LAS int* ptot = (LAS int*)F.lds; LAS int* ppre = ptot + 512; LAS int* pst = ppre + 512; LAS int* pad = pst + 64; LAS int* base = pad + 64;
    for (int blk = F.blk; blk < 256; blk += F.G) {
        { const int p8 = F.tid >> 6, e = F.tid & 63; int tot = 0, pre = 0;
          for (int b2 = 32 * p8; b2 < 32 * p8 + 32; ++b2) { const int c = cntb[b2 * 64 + e]; tot += c; pre += (b2 < blk) ? c : 0; }
          ptot[p8 * 64 + e] = tot; ppre[p8 * 64 + e] = pre; }
        __syncthreads();
        if (F.tid < 64) { const int e = F.tid; int total = 0, bb = 0;
#pragma unroll
            for (int q = 0; q < 8; ++q) { total += ptot[q * 64 + e]; bb += ppre[q * 64 + e]; }
            const int padded = (total + 255) & ~255; int v = padded;
#pragma unroll
            for (int o = 1; o < 64; o <<= 1) { const int tv = __shfl_up(v, o); if (e >= o) v += tv; }
            const int pstart = v - padded; pst[e] = pstart; pad[e] = padded;
            int run = pstart + bb;
#pragma unroll
            for (int w = 0; w < 4; ++w) { base[w * 64 + e] = run; run += cntw[(blk * 4 + w) * 64 + e]; }
            if (blk == 0 && e == 63) { const int nblk = (pstart + padded) >> 8; __hip_atomic_store(WSP(int, WS_CTL) + CW_NBLK, nblk, __ATOMIC_RELAXED, __HIP_MEMORY_SCOPE_AGENT); } }
        __syncthreads();
        for (int a = F.tid; a < 256 * TOPK; a += 512) { const int tl = a / 6, k = a - tl * 6, tok = blk * 256 + tl, w = tl >> 6;
            const int se = sele[(size_t)tok * 6 + k]; const int e = se & 255, r = se >> 8; const int dest = base[w * 64 + e] + r;
            rec[dest] = (u32x2){(unsigned)(tok | (k << 16)), __builtin_bit_cast(unsigned, selw[(size_t)tok * 6 + k])}; }
        { const int nblk = (pst[63] + pad[63]) >> 8; int* blke = WSP(int, WS_BLKE);
            if (F.tid < 8) { const int j = blk * 8 + F.tid; if (j < nblk) { const int r0 = j * 256; int e = 0;
                for (int q = 0; q < 64; ++q) if (pad[q] > 0 && pst[q] <= r0 && r0 < pst[q] + pad[q]) e = q;
                blke[j] = e; } } }
        __syncthreads();
    }
}

__device__ __forceinline__ void p13_final(Frame& F) {
    const float* mod = WSP(float, WS_MOD); const bf16_t* X1 = WSP(bf16_t, WS_X1); const unsigned char* Y8 = F.ws + WS_Y4;
    const int NGW = F.G * 8, c0 = 16 * F.lane;
    for (int t0 = F.blk * 8 + F.wave; t0 < T; t0 += 2 * NGW) {
        u32x4 yw[2][6], xw[2][2];
#pragma unroll
        for (int q = 0; q < 2; ++q) { const size_t t = (size_t)t0 + (size_t)q * NGW;
#pragma unroll
            for (int k = 0; k < 6; ++k) yw[q][k] = *(const u32x4*)(Y8 + (t * 6 + k) * 1024 + c0);
            xw[q][0] = *(const u32x4*)(X1 + t * 1024 + c0); xw[q][1] = *(const u32x4*)(X1 + t * 1024 + c0 + 8); }
        f32x4 v[2][4]; float ss[2];
#pragma unroll
        for (int q = 0; q < 2; ++q) { const int b = (t0 + q * NGW) >> 12; float a = 0.f;
#pragma unroll
            for (int j = 0; j < 4; ++j) { f32x4 ys = (f32x4){0.f, 0.f, 0.f, 0.f};
#pragma unroll
                for (int k = 0; k < 6; ++k) { const f32x2 lo = __builtin_amdgcn_cvt_pk_f32_fp8((int)yw[q][k][j], false), hi = __builtin_amdgcn_cvt_pk_f32_fp8((int)yw[q][k][j], true);
                    ys += (f32x4){lo.x, lo.y, hi.x, hi.y}; }
                const f32x4 g2 = *(const f32x4*)(mod + b * 6144 + 5120 + c0 + 4 * j) * 0.0625f;
                const unsigned w0 = xw[q][j >> 1][(j & 1) * 2], w1 = xw[q][j >> 1][(j & 1) * 2 + 1];
                v[q][j] = (f32x4){bflo(w0), bfhi(w0), bflo(w1), bfhi(w1)} + g2 * ys;
                a += (v[q][j].x * v[q][j].x + v[q][j].y * v[q][j].y) + (v[q][j].z * v[q][j].z + v[q][j].w * v[q][j].w); }
            ss[q] = a; }
#pragma unroll
        for (int o = 1; o < 64; o <<= 1) { ss[0] += __shfl_xor(ss[0], o); ss[1] += __shfl_xor(ss[1], o); }
#pragma unroll
        for (int q = 0; q < 2; ++q) { const size_t t = (size_t)t0 + (size_t)q * NGW; const float rstd = rsqrtf(ss[q] * (1.0f / D) + RMS_EPS);
#pragma unroll
            for (int j = 0; j < 4; ++j) { const f32x4 gf = *(const f32x4*)(F.g_final + c0 + 4 * j);
                *(f32x4*)(F.out + t * 1024 + c0 + 4 * j) = v[q][j] * rstd * gf; } }
    }
}

constexpr int N_PHASES = 14;
template <int K> __device__ __forceinline__ void run_phase(Frame& F) {
    LAS unsigned char* ring = F.lds; LAS float* escr = (LAS float*)(F.lds + EPI_OFF);
    if constexpr (K == 0) { p0_prologue(F); }
    if constexpr (K == 1) { p1_h(F); }
    if constexpr (K == 2) {
        SchedG1 S; S.o.init(256, 10, F.G, F.blk); S.A = (const char*)WSP(bf16_t, WS_H); S.B = (const char*)WSP(bf16_t, WS_WIN_T);
        EpiG1 E{WSP(bf16_t, WS_PROJC), WSP(bf16_t, WS_A2)};
        pg8::gemm_phase<EpiG1, SchedG1, false, false>(ring, pg8::Desc{1024, 1024, 1024}, S, E);
    }
    if constexpr (K == 3) {
        p3_conv(F); __syncthreads();
        SchedS5a S{F.G, F.blk, (const char*)WSP(bf16_t, WS_A2), (const char*)WSP(bf16_t, WS_T1)}; EpiS5a E{WSP(float, WS_S)};
        pg8::gemm_phase<EpiS5a, SchedS5a, false, false>(ring, pg8::Desc{KA2, KU, KU}, S, E);
    }
    if constexpr (K == 4) { p4_scan(F); }
    if constexpr (K == 5) {
        SchedS5b S{F.G, F.blk, (const char*)WSP(bf16_t, WS_A2), (const char*)WSP(bf16_t, WS_T2)}; EpiS5b E{WSP(bf16_t, WS_YS)};
        pg8::gemm_phase<EpiS5b, SchedS5b, false, false>(ring, pg8::Desc{KA2, KA2, KA2}, S, E);
    }
    if constexpr (K == 6) {
        SchedGlu S{F.G, F.blk, (const char*)WSP(bf16_t, WS_YS), (const char*)WSP(bf16_t, WS_WGLU_T)};
        EpiGlu E{WSP(bf16_t, WS_YS), F.b_glu, F.g_ssm, WSP(bf16_t, WS_YCAT), escr};
        pg8::gemm_phase<EpiGlu, SchedGlu, false, true>(ring, pg8::Desc{256, 256, 256}, S, E);
    }
    if constexpr (K == 7) {
        SchedG2 S{F.blk, (const char*)WSP(bf16_t, WS_YCAT), (const char*)WSP(bf16_t, WS_WOUT_T)};
        EpiG2 E{F.x, WSP(float, WS_MOD), WSP(bf16_t, WS_X1), escr};
        pg8::gemm_phase<EpiG2, SchedG2, false, false>(ring, pg8::Desc{1024, 1024, 1024}, S, E);
        p7_post(F);
    }
    if constexpr (K == 8) {
        SchedRS S; S.o.init(256, 3, F.G, F.blk); S.A = (const char*)WSP(bf16_t, WS_H2); S.B = (const char*)WSP(bf16_t, WS_WSR_T);
        EpiRS E{WSP(bf16_t, WS_ACTS), WSP(float, WS_LOGITS)};
        pg8::gemm_phase<EpiRS, SchedRS, false, false>(ring, pg8::Desc{1024, 1024, 1024}, S, E);
    }
    if constexpr (K == 9) { p9_topk(F); }
    if constexpr (K == 10) { p10_scatter(F); }
    if constexpr (K == 11) {
        const int nblk = __builtin_amdgcn_readfirstlane(ld_i32_agent(WSP(int, WS_CTL) + CW_NBLK));
        SchedUp S{F.G, F.vcu, nblk, WSP(int, WS_BLKE), (const int*)(F.ws + WS_ROUTE + RT_REC), (const char*)WSP(bf16_t, WS_H2), (const char*)WSP(bf16_t, WS_W13T)};
        EpiUp E{WSP(bf16_t, WS_ACT)};
        pg8::gemm_phase<EpiUp, SchedUp, true, false>(ring, pg8::Desc{1024, 1024, 1024}, S, E);
    }
    if constexpr (K == 12) {
        const int nblk = __builtin_amdgcn_readfirstlane(ld_i32_agent(WSP(int, WS_CTL) + CW_NBLK));
        SchedDown S{F.G, F.vcu, nblk, WSP(int, WS_BLKE), (const char*)WSP(bf16_t, WS_ACT), (const char*)WSP(bf16_t, WS_ACTS), (const char*)WSP(bf16_t, WS_W2T), (const char*)WSP(bf16_t, WS_WS2_T)};
        EpiDown E{(const u32x2*)(F.ws + WS_ROUTE + RT_REC), F.ws + WS_Y4, WSP(bf16_t, WS_X1), WSP(float, WS_MOD)};
        pg8::gemm_phase<EpiDown, SchedDown, false, false>(ring, pg8::Desc{256, 256, 256}, S, E);
    }
    if constexpr (K == 13) { p13_final(F); }
}
#ifndef REP_PHASE
#define REP_PHASE -1
#endif
#ifndef PH_MASK
#define PH_MASK 0xFFFF
#endif
#ifndef USE_CG_FIRST
#define USE_CG_FIRST 0
#endif
template <int K> __device__ __forceinline__ void grid_sync(Frame& F) {
#if MK_N_LAUNCHES == 1
    if constexpr (K == 0 && USE_CG_FIRST) cg::this_grid().sync(); else xcd_barrier(F.bar);
#endif
}
template <int K> __device__ __forceinline__ void phase_and_seam(Frame& F, int lo, int hi) {
    if (((PH_MASK >> K) & 1) && lo <= K && K < hi) {
        run_phase<K>(F);
        if constexpr (K == REP_PHASE) { grid_sync<K>(F); run_phase<K>(F); }
        if (K + 1 < hi) grid_sync<K>(F);
    }
}
__global__ void __launch_bounds__(512, 2) mk_fwd(Args args) {
    extern __shared__ __attribute__((aligned(16))) unsigned char lds_raw[];
    Frame F;
    F.lds = (LAS unsigned char*)lds_raw; F.tid = threadIdx.x; F.lane = F.tid & 63; F.wave = __builtin_amdgcn_readfirstlane(F.tid >> 6);
    F.blk = blockIdx.x; F.G = gridDim.x; F.vcu = (F.G % 8 == 0) ? (F.blk % 8) * (F.G / 8) + F.blk / 8 : F.blk;
    { const float* const* in = args.in;
      F.x = in[0]; F.c = in[1]; F.w_ada = in[2]; F.b_ada = in[3]; F.g_mix = in[4]; F.w_in = in[5]; F.conv_w = in[6]; F.conv_b = in[7]; F.g_conv = in[8];
      F.lam_re = in[9]; F.lam_im = in[10]; F.log_dt = in[11]; F.b_re = in[12]; F.b_im = in[13]; F.c_re = in[14]; F.c_im = in[15]; F.d_skip = in[16];
      F.w_glu = in[17]; F.b_glu = in[18]; F.g_ssm = in[19]; F.w_out = in[20]; F.g_ffn = in[21]; F.w_router = in[22]; F.router_bias = in[23];
      F.w1 = in[24]; F.w3 = in[25]; F.w2 = in[26]; F.ws1 = in[27]; F.ws3 = in[28]; F.ws2 = in[29]; F.g_final = in[30]; }
    F.out = args.out; F.ws = args.ws;
    const int lo = args.ph_lo, hi = args.ph_hi;
    if (F.tid < 64) ((LAS unsigned*)(F.lds + MISC_OFF))[F.tid] = 0u;
    __syncthreads();
    F.bar = xcd_barrier_post((unsigned*)(F.ws + WS_CTL) + CW_BAR, (volatile LAS unsigned*)(F.lds + MISC_OFF) + 8);
    phase_and_seam<0>(F, lo, hi); phase_and_seam<1>(F, lo, hi); phase_and_seam<2>(F, lo, hi); phase_and_seam<3>(F, lo, hi);
    phase_and_seam<4>(F, lo, hi); phase_and_seam<5>(F, lo, hi); phase_and_seam<6>(F, lo, hi); phase_and_seam<7>(F, lo, hi);
    phase_and_seam<8>(F, lo, hi); phase_and_seam<9>(F, lo, hi); phase_and_seam<10>(F, lo, hi); phase_and_seam<11>(F, lo, hi);
    phase_and_seam<12>(F, lo, hi); phase_and_seam<13>(F, lo, hi);
}

extern "C" void kernel_launch(void* const* d_in, const int* in_sizes, int n_in, void* d_out, int out_size, void* d_ws, size_t ws_size, hipStream_t stream) {
    static int grid = 0;
    if (grid == 0) {
        if (n_in != 31 || in_sizes[0] != T * D || out_size != T * D || ws_size < WS_END) { fprintf(stderr, "kernel_launch: unexpected shapes (n_in %d, in0 %d, out %d, ws %zu)\n", n_in, n_in > 0 ? in_sizes[0] : -1, out_size, ws_size); grid = -1; return; }
        int dev = 0, cus = 0, per_cu = 0;
        if (hipGetDevice(&dev) != hipSuccess || hipDeviceGetAttribute(&cus, hipDeviceAttributeMultiprocessorCount, dev) != hipSuccess) { grid = -1; return; }
        if (hipFuncSetAttribute((const void*)mk_fwd, hipFuncAttributeMaxDynamicSharedMemorySize, LDS_BYTES) != hipSuccess) { fprintf(stderr, "kernel_launch: hipFuncSetAttribute failed\n"); grid = -1; return; }
        if (hipOccupancyMaxActiveBlocksPerMultiprocessor(&per_cu, (const void*)mk_fwd, 512, LDS_BYTES) != hipSuccess || per_cu < 1) { fprintf(stderr, "kernel_launch: occupancy query gives %d\n", per_cu); per_cu = 1; }
        (void)hipGetLastError();
        grid = cus;
        if (grid > 256) grid = 256;
    }
    if (grid < 0) return;
    (void)hipMemsetAsync((char*)d_ws + WS_CTL, 0, CTL_ZERO_BYTES, stream);
    Args a{};
    for (int i = 0; i < 31; ++i) a.in[i] = (const float*)d_in[i];
    a.out = (float*)d_out; a.ws = (unsigned char*)d_ws;
#if MK_N_LAUNCHES == 1
    a.ph_lo = 0; a.ph_hi = N_PHASES;
    void* kargs[] = {&a};
    hipError_t e = hipLaunchCooperativeKernel((const void*)mk_fwd, dim3(grid), dim3(512), kargs, LDS_BYTES, stream);
    if (e != hipSuccess) fprintf(stderr, "kernel_launch: cooperative launch failed: %s (grid %d)\n", hipGetErrorString(e), grid);
#else
    for (int p = 0; p < N_PHASES; ++p) { a.ph_lo = p; a.ph_hi = p + 1; hipLaunchKernelGGL(mk_fwd, dim3(grid), dim3(512), LDS_BYTES, stream, a); }
#endif
}
```

```cpp
#include <hip/hip_runtime.h>
#include <hip/hip_cooperative_groups.h>
#include <cstdio>
#include <cstdint>
namespace cg = cooperative_groups;

#ifndef MK_N_LAUNCHES
#define MK_N_LAUNCHES 1
#endif

#define LAS __attribute__((address_space(3)))
typedef unsigned short bf16_t;
typedef short bf16x8 __attribute__((ext_vector_type(8)));
typedef float f32x4 __attribute__((ext_vector_type(4)));
typedef float f32x2 __attribute__((ext_vector_type(2)));
typedef unsigned u32x4 __attribute__((ext_vector_type(4)));
typedef unsigned u32x2 __attribute__((ext_vector_type(2)));

constexpr int NB = 16, SEQ = 4096, D = 1024, T = NB * SEQ;
constexpr int DCONV = 768, DSSM = 256, DIN = 2560, NG = 16, GC = 16, NP = 64;
constexpr int NE = 64, TOPK = 6, DE = 256;
constexpr int LCH = 32;
constexpr int NCHUNK = T / LCH;
constexpr int KU = LCH * GC;
constexpr int KA2 = KU + 2 * NP;
constexpr int MAXBLK = 1600;
constexpr float RMS_EPS = 1e-6f;

constexpr size_t MiB = 1u << 20, KiB = 1u << 10;
constexpr size_t WS_CTL = 0;
constexpr size_t WS_MOD = 64 * KiB;
constexpr size_t WS_AB32 = 448 * KiB;
constexpr size_t WS_BLKE = 512 * KiB;
constexpr size_t WS_WIN_T = 1 * MiB;
constexpr size_t WS_WOUT_T = 6 * MiB;
constexpr size_t WS_WGLU_T = 8 * MiB;
constexpr size_t WS_WS2_T = 8 * MiB + 512 * KiB;
constexpr size_t WS_WSR_T = 9 * MiB;
constexpr size_t WS_T1 = 11 * MiB;
constexpr size_t WS_T2 = 15 * MiB;
constexpr size_t WS_W13T = 25 * MiB;
constexpr size_t WS_W2T = 89 * MiB;
constexpr size_t WS_H = 128 * MiB;
constexpr size_t WS_X1 = 128 * MiB;
constexpr size_t WS_PROJC = 256 * MiB;
constexpr size_t WS_ACT = 256 * MiB;
constexpr size_t WS_ACTS = 456 * MiB;
constexpr size_t WS_ROUTE = 488 * MiB;
constexpr size_t WS_H2 = 512 * MiB;
constexpr size_t WS_Y4 = 512 * MiB;
constexpr size_t WS_YCAT = 640 * MiB;
constexpr size_t WS_LOGITS = 640 * MiB;
constexpr size_t WS_A2 = 768 * MiB;
constexpr size_t WS_S = 808 * MiB;
constexpr size_t WS_YS = 824 * MiB;
constexpr size_t WS_END = 1024 * MiB;
constexpr size_t RT_SELE = 0;
constexpr size_t RT_SELW = 2 * MiB;
constexpr size_t RT_CNTW = 4 * MiB;
constexpr size_t RT_CNTB = 5 * MiB;
constexpr size_t RT_REC = 6 * MiB;
constexpr int CW_NBLK = 16;
constexpr int CW_BAR = 1024;
constexpr size_t CTL_ZERO_BYTES = 32 * KiB;

constexpr int RING_BYTES = 131072;
constexpr int EPI_OFF = RING_BYTES;
constexpr int MISC_OFF = EPI_OFF + 16384;
constexpr int LDS_BYTES = 148480;

__device__ __forceinline__ unsigned f2bf(float f) { unsigned u = __builtin_bit_cast(unsigned, f); return (u + 0x7fffu + ((u >> 16) & 1u)) >> 16; }
typedef __bf16 bf16x2_t __attribute__((ext_vector_type(2)));
__device__ __forceinline__ unsigned pk2(float lo, float hi) { const f32x2 v = {lo, hi}; const bf16x2_t b = __builtin_convertvector(v, bf16x2_t); return __builtin_bit_cast(unsigned, b); }
__device__ __forceinline__ float bflo(unsigned w) { return __builtin_bit_cast(float, w << 16); }
__device__ __forceinline__ float bfhi(unsigned w) { return __builtin_bit_cast(float, w & 0xffff0000u); }
__device__ __forceinline__ float bf2f(bf16_t b) { return __builtin_bit_cast(float, (unsigned)b << 16); }
__device__ __forceinline__ float sigmoidf_(float v) { return 1.0f / (1.0f + __expf(-v)); }
__device__ __forceinline__ float siluf_(float v) { return v / (1.0f + __expf(-v)); }
__device__ __forceinline__ float gelu_tanh(float v) {
    const float z = 0.7978845608028654f * (v + 0.044715f * v * v * v);
    const float e = __expf(2.0f * z);
    const float th = 1.0f - 2.0f / (e + 1.0f);
    return 0.5f * v * (1.0f + th);
}
__device__ __forceinline__ float wave_sum(float v) {
#pragma unroll
    for (int o = 1; o < 64; o <<= 1) v += __shfl_xor(v, o);
    return v;
}
__device__ __forceinline__ int ld_i32_agent(const int* p) { return __hip_atomic_load(p, __ATOMIC_RELAXED, __HIP_MEMORY_SCOPE_AGENT); }


#define XB_TMO      128
#define XB_XCNT(j)  (256  + 64 * (j))
#define XB_XSUB(j)  (1280 + 64 * (j))
#define XB_XGEN(j)  (2304 + 64 * (j))
#define XB_TOP      3328
#define XB_TOPGEN   3392
#define XCD_BAR_WORDS 3456
#define XB_SPIN_CAP (1u << 22)
__device__ __forceinline__ unsigned xb_ld(unsigned* p)              { return __hip_atomic_load(p, __ATOMIC_RELAXED, __HIP_MEMORY_SCOPE_AGENT); }
__device__ __forceinline__ unsigned xb_add(unsigned* p, unsigned v) { return __hip_atomic_fetch_add(p, v, __ATOMIC_RELAXED, __HIP_MEMORY_SCOPE_AGENT); }
__device__ __forceinline__ unsigned xb_xcc_id() { return (unsigned)__builtin_amdgcn_s_getreg((3 << 11) | 20) & 0xFu; }
#define XB_SPIN(cond, bar) do { unsigned _sp = 0; while (cond) { __builtin_amdgcn_s_sleep(1); \
    if ((++_sp & 255u) == 0u) { if (xb_ld(&(bar)[XB_TMO])) break; if (_sp > XB_SPIN_CAP) { atomicAdd(&(bar)[XB_TMO], 1u); break; } } } } while (0)
struct XcdBarrier { unsigned* bar; unsigned x; volatile LAS unsigned* st; };
__device__ __forceinline__ XcdBarrier xcd_barrier_post(unsigned* bar, volatile LAS unsigned* st) {
    XcdBarrier b; b.bar = bar; b.x = xb_xcc_id(); b.st = st;
    if (threadIdx.x == 0) (void)xb_add(&bar[XB_XCNT(b.x)], 1u);
    return b;
}
__device__ __forceinline__ void xcd_barrier_complete(unsigned* bar, unsigned x, unsigned& nloc, unsigned& nx) {
    const unsigned G = gridDim.x * gridDim.y * gridDim.z;
    unsigned sum, cnt, mine, sp = 0u;
    for (;;) {
        sum = 0u; cnt = 0u; mine = 0u;
#pragma unroll
        for (unsigned j = 0; j < 16; ++j) { const unsigned c = xb_ld(&bar[XB_XCNT(j)]); sum += c; cnt += (c > 0u) ? 1u : 0u; mine = (j == x) ? c : mine; }
        if (sum == G) break;
        __builtin_amdgcn_s_sleep(1);
        if ((++sp & 255u) == 0u) { if (xb_ld(&bar[XB_TMO])) break; if (sp > XB_SPIN_CAP) { atomicAdd(&bar[XB_TMO], 1u); break; } }
    }
    nloc = mine > 0u ? mine : 1u; nx = cnt > 0u ? cnt : 1u;
}
__device__ __forceinline__ void xcd_barrier(const XcdBarrier& b) {
    asm volatile("s_waitcnt vmcnt(0)" ::: "memory");
    __syncthreads();
    if (threadIdx.x == 0) {
        unsigned* bar = b.bar;
        __builtin_amdgcn_s_waitcnt(0);
        unsigned nloc = b.st[0], nx = b.st[1];
        if (nloc == 0u) { xcd_barrier_complete(bar, b.x, nloc, nx); b.st[0] = nloc; b.st[1] = nx; }
        const unsigned old = xb_add(&bar[XB_XSUB(b.x)], 1u);
        const unsigned gen = old / nloc;
        if (old + 1u == (gen + 1u) * nloc) {
            __builtin_amdgcn_fence(__ATOMIC_RELEASE, "agent");
            asm volatile("s_waitcnt vmcnt(0)" ::: "memory");
            const unsigned og = xb_add(&bar[XB_TOP], 1u);
            const unsigned tg = og / nx;
            if (og + 1u == (tg + 1u) * nx) xb_add(&bar[XB_TOPGEN], 1u);
            else XB_SPIN(xb_ld(&bar[XB_TOPGEN]) == tg, bar);
            __builtin_amdgcn_fence(__ATOMIC_ACQUIRE, "agent");
            xb_add(&bar[XB_XGEN(b.x)], 1u);
            asm volatile("s_waitcnt vmcnt(0)" ::: "memory");
        } else {
            XB_SPIN(xb_ld(&bar[XB_XGEN(b.x)]) == gen, bar);
            __builtin_amdgcn_fence(__ATOMIC_ACQUIRE, "agent");
            asm volatile("s_waitcnt vmcnt(0)" ::: "memory");
        }
    }
    __syncthreads();
}

namespace pg8 {
constexpr int BM = 256, BK = 64, HALF = 128, HTB = HALF * BK * 2, STAGE_BYTES = 8 * HTB;
__device__ __forceinline__ int lds_byte(int r, int c) { const int st = (r >> 4) * 2 + (c >> 5), rr = r & 15, cc = c & 31, ob = rr * 64 + cc * 2; return st * 1024 + (ob ^ (((ob >> 9) & 1) << 5)); }
__device__ __forceinline__ void stage_rc(int b, int& R, int& C) { const int st = b / 1024, sb = b % 1024, swz = sb ^ (((sb >> 9) & 1) << 5); R = (st >> 1) * 16 + swz / 64; C = (st & 1) * 32 + (swz % 64) / 2; }
__device__ __forceinline__ int perm32(int rho) { const int n = rho >> 4, i = rho & 15; return 8 * (i >> 2) + 4 * n + (i & 3); }

struct Unit { const char* A; const char* B; const int* rows; int pm, pn, aux; };
struct Desc { int lda, ldb, K; };

template <class Epi, class Sched, bool GATHER, bool ALIGN_EPI>
__device__ __forceinline__ void gemm_phase(LAS unsigned char* lds, const Desc g, const Sched& S, const Epi& E) {
    const int tid = threadIdx.x, wid = __builtin_amdgcn_readfirstlane(tid >> 6), lane = tid & 63, wr = wid >> 2, wc = wid & 3, fr = lane & 15, fq = lane >> 4;
    const int K = g.K, nt = K / BK;
    int Rr[2], Cc[2]; unsigned voffB[2];
#pragma unroll
    for (int i = 0; i < 2; ++i) { int R, C; stage_rc(tid * 16 + i * 8192, R, C); const int Rb = Epi::PERM ? ((R & ~31) + perm32(R & 31)) : R;
        Rr[i] = R; Cc[i] = C; voffB[i] = (unsigned)(Rb * g.ldb + C) * 2u; }
    const size_t kstep = (size_t)(BK * 2);
    const size_t hstepB = (size_t)HALF * g.ldb * 2;
    const unsigned ldsw = (unsigned)wid * 1024u;
    const int aoff = lds_byte(wr * 64 + fr, fq * 8), boff = lds_byte(wc * 32 + fr, fq * 8);
#define PG8_SA(b, h) (((b) * 2 + (h)) * HTB)
#define PG8_SB(b, h) ((4 + (b) * 2 + (h)) * HTB)
#define PG8_STAGE(bufoff, gbase, v0, v1) do { \
        __builtin_amdgcn_global_load_lds((const unsigned*)((const char*)(gbase) + (v0)), (LAS unsigned*)(lds + (bufoff) + ldsw), 16, 0, 0); \
        __builtin_amdgcn_global_load_lds((const unsigned*)((const char*)(gbase) + (v1)), (LAS unsigned*)(lds + (bufoff) + ldsw + 8192), 16, 0, 0); } while (0)
#define PG8_STAGEB(bufoff, gbase) PG8_STAGE(bufoff, gbase, voffB[0], voffB[1])
#define PG8_LDA(dst, b, h) do { _Pragma("unroll") for (int m = 0; m < 4; ++m) _Pragma("unroll") for (int k = 0; k < 2; ++k) dst[m][k] = *(const LAS bf16x8*)(lds + PG8_SA(b, h) + aoff + m * 2048 + k * 1024); } while (0)
#define PG8_LDB(dst, b, h) do { _Pragma("unroll") for (int n = 0; n < 2; ++n) _Pragma("unroll") for (int k = 0; k < 2; ++k) dst[n][k] = *(const LAS bf16x8*)(lds + PG8_SB(b, h) + boff + n * 2048 + k * 1024); } while (0)
#define PG8_MMA(ai, bj, At, Bt) do { __builtin_amdgcn_s_setprio(1); _Pragma("unroll") for (int m = 0; m < 4; ++m) _Pragma("unroll") for (int n = 0; n < 2; ++n) _Pragma("unroll") for (int k = 0; k < 2; ++k) \
        acc[ai][bj][m][n] = __builtin_amdgcn_mfma_f32_16x16x32_bf16(Bt[n][k], At[m][k], acc[ai][bj][m][n], 0, 0, 0); __builtin_amdgcn_s_setprio(0); } while (0)
#define PG8_WAIT_V(n) asm volatile("s_waitcnt vmcnt(" #n ")" ::: "memory")
#define PG8_WAIT_L(n) asm volatile("s_waitcnt lgkmcnt(" #n ")" ::: "memory")
#define PG8_BAR __builtin_amdgcn_s_barrier()
#define PG8_SCHED __builtin_amdgcn_sched_barrier(0)
    const unsigned hoffA = GATHER ? 0u : (unsigned)(HALF * g.lda) * 2u;
#define PG8_AOFFS(dst, u) do { if constexpr (GATHER) { _Pragma("unroll") for (int h = 0; h < 2; ++h) _Pragma("unroll") for (int i = 0; i < 2; ++i) { \
        const int rec_ = (u).rows[2 * (h * HALF + Rr[i])]; const int row_ = rec_ < 0 ? 0 : (rec_ & 0xffff); dst[h][i] = (unsigned)(row_ * g.lda + Cc[i]) * 2u; } \
        asm volatile("" : "+v"(dst[0][0]), "+v"(dst[0][1]), "+v"(dst[1][0]), "+v"(dst[1][1])); } } while (0)
    Unit cur, nxt; int ui = 0;
    if (!S.next(0, cur)) return;
    unsigned cvo[2][2], nvo[2][2];
    if constexpr (GATHER) { PG8_AOFFS(cvo, cur); }
    else {
#pragma unroll
        for (int i = 0; i < 2; ++i) { cvo[0][i] = (unsigned)(Rr[i] * g.lda + Cc[i]) * 2u; cvo[1][i] = cvo[0][i] + hoffA; nvo[0][i] = cvo[0][i]; nvo[1][i] = cvo[1][i]; } }
    f32x4 acc[2][2][4][2];
#pragma unroll
    for (int a = 0; a < 2; ++a)
#pragma unroll
        for (int b = 0; b < 2; ++b)
#pragma unroll
            for (int m = 0; m < 4; ++m)
#pragma unroll
                for (int n = 0; n < 2; ++n) acc[a][b][m][n] = (f32x4){0.f, 0.f, 0.f, 0.f};
    bf16x8 At[4][2], B0[2][2], B1[2][2];
    const char* cA = cur.A; const char* cB = cur.B;
    PG8_STAGEB(PG8_SB(0, 0), cB); PG8_STAGEB(PG8_SB(0, 1), cB + hstepB); PG8_STAGE(PG8_SA(0, 0), cA, cvo[0][0], cvo[0][1]); PG8_STAGE(PG8_SA(0, 1), cA, cvo[1][0], cvo[1][1]);
    if (wr == 1) PG8_BAR;
    PG8_WAIT_V(2); PG8_BAR;
    PG8_STAGEB(PG8_SB(1, 0), cB + kstep); PG8_STAGE(PG8_SA(1, 0), cA + kstep, cvo[0][0], cvo[0][1]); PG8_STAGEB(PG8_SB(1, 1), cB + hstepB + kstep);
    PG8_WAIT_V(6); PG8_BAR;
    for (;;) {
        const bool has_next = S.next(ui + 1, nxt);
        const char* nA = has_next ? nxt.A : cA; const char* nB = has_next ? nxt.B : cB;
        if constexpr (GATHER) { if (has_next) { PG8_AOFFS(nvo, nxt); } else {
#pragma unroll
            for (int h = 0; h < 2; ++h)
#pragma unroll
                for (int i = 0; i < 2; ++i) nvo[h][i] = cvo[h][i]; } }
#pragma nounroll
        for (int t = 0; t < nt; t += 2) {
            const bool last = (t == nt - 2);
            const char* a1 = cA + (size_t)(t + 1) * kstep;
            const char* a2 = last ? nA : cA + (size_t)(t + 2) * kstep; const char* b2 = last ? nB : cB + (size_t)(t + 2) * kstep;
            const char* a3 = a2 + kstep; const char* b3 = b2 + kstep;
            const unsigned o00 = (GATHER && last) ? nvo[0][0] : cvo[0][0], o01 = (GATHER && last) ? nvo[0][1] : cvo[0][1], o10 = (GATHER && last) ? nvo[1][0] : cvo[1][0], o11 = (GATHER && last) ? nvo[1][1] : cvo[1][1];
            PG8_LDB(B0, 0, 0); PG8_LDB(B1, 0, 1); PG8_SCHED; PG8_LDA(At, 0, 0); PG8_STAGE(PG8_SA(1, 1), a1, cvo[1][0], cvo[1][1]);
            PG8_WAIT_V(8); PG8_WAIT_L(0); PG8_BAR; PG8_MMA(0, 0, At, B0); PG8_MMA(0, 1, At, B1); PG8_BAR; PG8_SCHED;
            PG8_LDA(At, 0, 1); PG8_STAGEB(PG8_SB(0, 0), b2); PG8_STAGEB(PG8_SB(0, 1), b2 + hstepB); PG8_STAGE(PG8_SA(0, 0), a2, o00, o01);
            PG8_WAIT_V(8); PG8_WAIT_L(0); PG8_BAR; PG8_MMA(1, 0, At, B0); PG8_MMA(1, 1, At, B1); PG8_BAR; PG8_SCHED;
            PG8_LDB(B0, 1, 0); PG8_LDB(B1, 1, 1); PG8_SCHED; PG8_LDA(At, 1, 0); PG8_STAGE(PG8_SA(0, 1), a2, o10, o11);
            PG8_WAIT_V(8); PG8_WAIT_L(0); PG8_BAR; PG8_MMA(0, 0, At, B0); PG8_MMA(0, 1, At, B1); PG8_BAR; PG8_SCHED;
            PG8_LDA(At, 1, 1); PG8_STAGEB(PG8_SB(1, 0), b3); PG8_STAGEB(PG8_SB(1, 1), b3 + hstepB); PG8_STAGE(PG8_SA(1, 0), a3, o00, o01);
            PG8_WAIT_V(8); PG8_WAIT_L(0); PG8_BAR; PG8_MMA(1, 0, At, B0); PG8_MMA(1, 1, At, B1); PG8_BAR; PG8_SCHED;
        }
        if constexpr (ALIGN_EPI) { if (wr == 0) PG8_BAR; }
        E(acc, cur, wr, wc, fr, fq);
        if (!has_next) break;
#pragma unroll
        for (int a = 0; a < 2; ++a)
#pragma unroll
            for (int b = 0; b < 2; ++b)
#pragma unroll
                for (int m = 0; m < 4; ++m)
#pragma unroll
                    for (int n = 0; n < 2; ++n) acc[a][b][m][n] = (f32x4){0.f, 0.f, 0.f, 0.f};
        cur = nxt; cA = nA; cB = nB; ++ui;
        if constexpr (GATHER) {
#pragma unroll
        for (int h = 0; h < 2; ++h)
#pragma unroll
            for (int i = 0; i < 2; ++i) cvo[h][i] = nvo[h][i]; }
        if constexpr (ALIGN_EPI) { if (wr == 1) PG8_BAR; }
    }
    PG8_WAIT_V(0);
    if constexpr (!ALIGN_EPI) { if (wr == 0) PG8_BAR; }
    PG8_BAR;
#undef PG8_SA
#undef PG8_SB
#undef PG8_STAGE
#undef PG8_STAGEB
#undef PG8_LDA
#undef PG8_LDB
#undef PG8_MMA
#undef PG8_WAIT_V
#undef PG8_WAIT_L
#undef PG8_BAR
#undef PG8_SCHED
#undef PG8_AOFFS
}
}
using pg8::Unit;

struct Args { const float* in[31]; float* out; unsigned char* ws; int ph_lo, ph_hi; };
struct Frame {
    LAS unsigned char* lds; int tid, lane, wave, blk, G, vcu;
    const float *x, *c, *w_ada, *b_ada, *g_mix, *w_in, *conv_w, *conv_b, *g_conv, *lam_re, *lam_im, *log_dt, *b_re, *b_im, *c_re, *c_im,
        *d_skip, *w_glu, *b_glu, *g_ssm, *w_out, *g_ffn, *w_router, *router_bias, *w1, *w3, *w2, *ws1, *ws3, *ws2, *g_final;
    float* out; unsigned char* ws; XcdBarrier bar;
};
#define WSP(T_, off) ((T_*)(F.ws + (off)))
#define LDS_WAIT() asm volatile("s_waitcnt lgkmcnt(0)" ::: "memory")
#define VM_WAIT() asm volatile("s_waitcnt vmcnt(0)" ::: "memory")

struct TileOrder {
    int nM, nN, nwg, G, c;
    __device__ __forceinline__ void init(int nM_, int nN_, int G_, int c_) { nM = nM_; nN = nN_; nwg = nM * nN; G = G_; c = c_; }
    __device__ __forceinline__ bool tile(int i, int& pm, int& pn) const {
        const long L = (long)i * G + c; if (L >= nwg) return false;
        int wgid = (int)L; { const int q = nwg / 8, r = nwg % 8, xcd = wgid % 8, off = wgid / 8; wgid = (xcd < r ? xcd * (q + 1) : r * (q + 1) + (xcd - r) * q) + off; }
        const int nig = 8 * nN, gid = wgid / nig, fm = gid * 8, gsz = (nM - fm) < 8 ? (nM - fm) : 8;
        pm = fm + ((wgid % nig) % gsz); pn = (wgid % nig) / gsz; return true;
    }
};

__device__ __forceinline__ int down_perm_row(int c) { const int cl = c & 255; return (c & ~255) + ((cl >> 3) & 1) * 128 + (cl >> 6) * 32 + ((cl >> 4) & 3) * 8 + (cl & 7); }
template <int PMODE = 0>
__device__ __forceinline__ void transpose_item(const float* W, int ldw, int k0, int n0, bf16_t* WT, int ldt, int drow0, LAS float* scr, int lane) {
    float tv[32];
#pragma unroll
    for (int i = 0; i < 32; ++i) { const int kk = 2 * i + (lane >> 5); tv[i] = W[(size_t)(k0 + kk) * ldw + n0 + (lane & 31)]; }
#pragma unroll
    for (int i = 0; i < 32; ++i) { const int kk = 2 * i + (lane >> 5); scr[kk * 33 + (lane & 31)] = tv[i]; }
    LDS_WAIT(); asm volatile("" ::: "memory");
    const int c = lane & 7;
#pragma unroll
    for (int j = 0; j < 4; ++j) { const int n = (lane >> 3) + 8 * j; const LAS float* s = scr + (8 * c) * 33 + n;
        u32x4 o; o.x = pk2(s[0 * 33], s[1 * 33]); o.y = pk2(s[2 * 33], s[3 * 33]); o.z = pk2(s[4 * 33], s[5 * 33]); o.w = pk2(s[6 * 33], s[7 * 33]);
        const int drow = PMODE ? down_perm_row(drow0 + n) : (drow0 + n);
        *(u32x4*)(WT + (size_t)drow * ldt + k0 + 8 * c) = o; }
    LDS_WAIT(); asm volatile("" ::: "memory");
}

__device__ __forceinline__ void p0_mod(Frame& F) {
    LAS float* sil = (LAS float*)F.lds;
    LAS float* red = (LAS float*)(F.lds + 65536);
    for (int i = F.tid; i < NB * D; i += 512) { const float v = F.c[i]; sil[i] = v / (1.0f + __expf(-v)); }
    __syncthreads();
    const int col = F.tid & 31, ks = F.tid >> 5, n0 = F.blk * 32;
    float acc[16];
#pragma unroll
    for (int b = 0; b < 16; ++b) acc[b] = 0.f;
#pragma nounroll
    for (int k0 = 0; k0 < 64; k0 += 16) { float wv[16];
#pragma unroll
        for (int kk = 0; kk < 16; ++kk) wv[kk] = F.w_ada[(size_t)(ks * 64 + k0 + kk) * 6144 + n0 + col];
#pragma unroll
        for (int kk = 0; kk < 16; ++kk) { const int k = ks * 64 + k0 + kk;
#pragma unroll
            for (int b = 0; b < 16; ++b) acc[b] += sil[b * 1024 + k] * wv[kk]; } }
#pragma unroll
    for (int b = 0; b < 16; ++b) red[(ks * 16 + b) * 32 + col] = acc[b];
    __syncthreads();
    { const int b = F.tid >> 5; float s = 0.f;
#pragma unroll
      for (int k2 = 0; k2 < 16; ++k2) s += red[(k2 * 16 + b) * 32 + col];
      WSP(float, WS_MOD)[b * 6144 + n0 + col] = s + F.b_ada[n0 + col]; }
    __syncthreads();
}

__device__ __forceinline__ void p0_s5_tables(Frame& F, int g, int part) {
    LAS f32x2* pw = (LAS f32x2*)F.lds;
    LAS f32x2* Bb = (LAS f32x2*)(F.lds + 20480);
    LAS f32x2* Cc = (LAS f32x2*)(F.lds + 28672);
    LAS float* Kn = (LAS float*)(F.lds + 36864);
    const float dt = expf(F.log_dt[g]);
    for (int i = F.tid; i < 33 * 64; i += 512) { const int tau = i >> 6, p = i & 63; const float lr = F.lam_re[g * 64 + p], li = F.lam_im[g * 64 + p];
        const float mag = expf(lr * dt * (float)tau), ang = li * dt * (float)tau; float sn, cs; sincosf(ang, &sn, &cs); pw[i] = (f32x2){mag * cs, mag * sn}; }
    for (int i = F.tid; i < 1024; i += 512) { const int p = i >> 4, hi = i & 15; const float lr = F.lam_re[g * 64 + p], li = F.lam_im[g * 64 + p];
        const float mag = expf(lr * dt), ang = li * dt; float sn, cs; sincosf(ang, &sn, &cs);
        const float nr = mag * cs - 1.0f, ni = mag * sn, den = lr * lr + li * li, qr = (nr * lr + ni * li) / den, qi = (ni * lr - nr * li) / den;
        const float br = F.b_re[(g * 64 + p) * 16 + hi], bi = F.b_im[(g * 64 + p) * 16 + hi];
        Bb[i] = (f32x2){qr * br - qi * bi, qr * bi + qi * br};
        Cc[i] = (f32x2){F.c_re[g * 1024 + i], F.c_im[g * 1024 + i]}; }
    __syncthreads();
    { const int tau = F.tid >> 4, ho = F.tid & 15;
      if (tau <= 4 * part + 3) { float kacc[16];
#pragma unroll
        for (int hi = 0; hi < 16; ++hi) kacc[hi] = 0.f;
        for (int p = 0; p < 64; ++p) { const f32x2 c = Cc[ho * 64 + p], a = pw[tau * 64 + p];
            const float wr_ = c.x * a.x - c.y * a.y, wi_ = c.x * a.y + c.y * a.x;
#pragma unroll
            for (int hi = 0; hi < 16; ++hi) { const f32x2 b = Bb[p * 16 + hi]; kacc[hi] += wr_ * b.x - wi_ * b.y; } }
#pragma unroll
        for (int hi = 0; hi < 16; ++hi) Kn[F.tid * 16 + hi] = kacc[hi]; } }
    __syncthreads();
    bf16_t* T2 = WSP(bf16_t, WS_T2); bf16_t* T1 = WSP(bf16_t, WS_T1);
    for (int i = F.tid; i < 64 * 320; i += 512) { const int n = 64 * part + i / 320, k = 2 * (i % 320), tl = n >> 4, ho = n & 15; float v0, v1;
        if (k < KU) { const int sl = k >> 4, hi = k & 15;
            if (sl <= tl) { v0 = Kn[((tl - sl) * 16 + ho) * 16 + hi]; v1 = Kn[((tl - sl) * 16 + ho) * 16 + hi + 1];
                if (sl == tl) { const float dsk = F.d_skip[g * 16 + ho]; if (hi == ho) v0 += dsk; if (hi + 1 == ho) v1 += dsk; } }
            else { v0 = 0.f; v1 = 0.f; } }
        else { const int p = (k - KU) >> 1; const f32x2 c = Cc[ho * 64 + p], a = pw[(tl + 1) * 64 + p]; v0 = c.x * a.x - c.y * a.y; v1 = -(c.x * a.y + c.y * a.x); }
        *(unsigned*)(T2 + ((size_t)(g * 512 + n) * KA2 + k)) = pk2(v0, v1); }
    for (int i = F.tid; i < 16 * 256; i += 512) { const int n1 = 16 * part + (i >> 8), k = 2 * (i & 255), p = n1 >> 1, ri = n1 & 1, sl = k >> 4, hi = k & 15;
        const f32x2 a = pw[(31 - sl) * 64 + p], b0 = Bb[p * 16 + hi], b1 = Bb[p * 16 + hi + 1];
        const float v0 = ri ? (a.x * b0.y + a.y * b0.x) : (a.x * b0.x - a.y * b0.y), v1 = ri ? (a.x * b1.y + a.y * b1.x) : (a.x * b1.x - a.y * b1.y);
        *(unsigned*)(T1 + ((size_t)(g * 256 + n1) * KU + k)) = pk2(v0, v1);
        *(unsigned*)(T1 + ((size_t)(g * 256 + 128 + n1) * KU + k)) = 0u; }
    if (part == 0 && F.tid < 64) { const f32x2 a = pw[32 * 64 + F.tid]; WSP(f32x2, WS_AB32)[g * 64 + F.tid] = a; }
    __syncthreads();
}

__device__ __forceinline__ void p0_prologue(Frame& F) {
    { const int it = 255 - F.blk; if (it < 128) p0_s5_tables(F, it >> 3, 7 - (it & 7)); }
    __syncthreads();
    { u32x4* z = (u32x4*)(WSP(bf16_t, WS_WSR_T) + (size_t)576 * 1024); const int nz = 192 * 1024 * 2 / 16;
      for (int i = F.blk * 512 + F.tid; i < nz; i += F.G * 512) z[i] = (u32x4){0u, 0u, 0u, 0u}; }
    LAS float* scr = (LAS float*)(F.lds + F.wave * 16384);
    const int gw = F.vcu * 8 + F.wave, NGW = F.G * 8;
    constexpr int I0 = 1280, I1 = 512, I2 = 32, I3 = 128, I4 = 128, I5 = 32, I6 = 128, I7 = 8192, I8 = 8192, I9 = 8192;
    constexpr int NITEMS = I0 + I1 + I2 + I3 + I4 + I5 + I6 + I7 + I8 + I9;
    for (int it = gw; it < NITEMS; it += NGW) {
        int r = it;
        if (r < I0) { const int kb = r / 80, nb = r % 80; transpose_item(F.w_in, DIN, 64 * kb, 32 * nb, WSP(bf16_t, WS_WIN_T), 1024, 32 * nb, scr, F.lane); continue; } r -= I0;
        if (r < I1) { const int kb = r / 32, nb = r % 32; transpose_item(F.w_out, 1024, 64 * kb, 32 * nb, WSP(bf16_t, WS_WOUT_T), 1024, 32 * nb, scr, F.lane); continue; } r -= I1;
        if (r < I2) { const int kb = r / 8, nb = r % 8; transpose_item(F.w_glu, 256, 64 * kb, 32 * nb, WSP(bf16_t, WS_WGLU_T), 256, 32 * nb, scr, F.lane); continue; } r -= I2;
        if (r < I3) { const int kb = r / 8, nb = r % 8, n0 = 32 * nb; transpose_item(F.ws1, 256, 64 * kb, n0, WSP(bf16_t, WS_WSR_T), 1024, (n0 >> 7) * 256 + (n0 & 127), scr, F.lane); continue; } r -= I3;
        if (r < I4) { const int kb = r / 8, nb = r % 8, n0 = 32 * nb; transpose_item(F.ws3, 256, 64 * kb, n0, WSP(bf16_t, WS_WSR_T), 1024, (n0 >> 7) * 256 + 128 + (n0 & 127), scr, F.lane); continue; } r -= I4;
        if (r < I5) { const int kb = r / 2, nb = r % 2; transpose_item(F.w_router, 64, 64 * kb, 32 * nb, WSP(bf16_t, WS_WSR_T), 1024, 512 + 32 * nb, scr, F.lane); continue; } r -= I5;
        if (r < I6) { const int kb = r / 32, nb = r % 32; transpose_item<1>(F.ws2, 1024, 64 * kb, 32 * nb, WSP(bf16_t, WS_WS2_T), 256, 32 * nb, scr, F.lane); continue; } r -= I6;
        if (r < I7) { const int e = r >> 7, q = r & 127, kb = q / 8, nb = q % 8, n0 = 32 * nb;
            transpose_item(F.w1 + (size_t)e * 1024 * 256, 256, 64 * kb, n0, WSP(bf16_t, WS_W13T) + (size_t)e * 512 * 1024, 1024, (n0 >> 7) * 256 + (n0 & 127), scr, F.lane); continue; } r -= I7;
        if (r < I8) { const int e = r >> 7, q = r & 127, kb = q / 8, nb = q % 8, n0 = 32 * nb;
            transpose_item(F.w3 + (size_t)e * 1024 * 256, 256, 64 * kb, n0, WSP(bf16_t, WS_W13T) + (size_t)e * 512 * 1024, 1024, (n0 >> 7) * 256 + 128 + (n0 & 127), scr, F.lane); continue; } r -= I8;
        { const int e = r >> 7, q = r & 127, kb = q / 32, nb = q % 32;
            transpose_item<1>(F.w2 + (size_t)e * 256 * 1024, 1024, 64 * kb, 32 * nb, WSP(bf16_t, WS_W2T) + (size_t)e * 1024 * 256, 256, 32 * nb, scr, F.lane); }
    }
}

__device__ __forceinline__ void p1_h(Frame& F) {
    const float* mod = WSP(float, WS_MOD); bf16_t* H = WSP(bf16_t, WS_H);
    const int NGW = F.G * 8;
    for (int t0 = F.blk * 8 + F.wave; t0 < T; t0 += 4 * NGW) {
        f32x4 v[4][4]; float ss[4];
#pragma unroll
        for (int q = 0; q < 4; ++q) { const int t = t0 + q * NGW; const f32x4* xr = (const f32x4*)(F.x + (size_t)t * D) + F.lane;
#pragma unroll
            for (int j = 0; j < 4; ++j) v[q][j] = xr[64 * j]; }
#pragma unroll
        for (int q = 0; q < 4; ++q) { float a = 0.f;
#pragma unroll
            for (int j = 0; j < 4; ++j) a += (v[q][j].x * v[q][j].x + v[q][j].y * v[q][j].y) + (v[q][j].z * v[q][j].z + v[q][j].w * v[q][j].w);
            ss[q] = a; }
#pragma unroll
        for (int o = 1; o < 64; o <<= 1) {
#pragma unroll
            for (int q = 0; q < 4; ++q) ss[q] += __shfl_xor(ss[q], o); }
#pragma unroll
        for (int q = 0; q < 4; ++q) { const int t = t0 + q * NGW; const int b = t >> 12; const float rstd = rsqrtf(ss[q] * (1.0f / D) + RMS_EPS);
#pragma unroll
            for (int j = 0; j < 4; ++j) { const int c0 = 4 * F.lane + 256 * j;
                const f32x4 gm = *(const f32x4*)(F.g_mix + c0), sh = *(const f32x4*)(mod + b * 6144 + c0), sc = *(const f32x4*)(mod + b * 6144 + 1024 + c0);
                const f32x4 h = v[q][j] * rstd * gm * (sc + 1.0f) + sh;
                *(u32x2*)(H + (size_t)t * D + c0) = (u32x2){pk2(h.x, h.y), pk2(h.z, h.w)}; } }
    }
}

__device__ __forceinline__ u32x4 pack8(const f32x4 a, const f32x4 b) { return (u32x4){pk2(a.x, a.y), pk2(a.z, a.w), pk2(b.x, b.y), pk2(b.z, b.w)}; }
#define EPI_FOR_ROWS _Pragma("unroll") for (int ai = 0; ai < 2; ++ai) _Pragma("unroll") for (int m = 0; m < 4; ++m)
#define EPI_ROWL (ai * 128 + wr * 64 + m * 16 + fr)

struct SchedG1 { TileOrder o; const char* A; const char* B;
    __device__ __forceinline__ bool next(int i, Unit& u) const { int pm, pn; if (!o.tile(i, pm, pn)) return false; u.pm = pm; u.pn = pn; u.aux = 0; u.rows = nullptr;
        u.A = A + (size_t)pm * 256 * 1024 * 2; u.B = B + (size_t)pn * 256 * 1024 * 2; return true; } };
struct EpiG1 { static constexpr bool PERM = true; bf16_t* projc; bf16_t* A2;
    __device__ __forceinline__ void operator()(const f32x4 (&acc)[2][2][4][2], const Unit& u_in, int wr, int wc, int fr_in, int fq_in) const {
        Unit u = u_in; asm volatile("" : "+s"(u.pm), "+s"(u.pn), "+s"(u.aux)); int fr = fr_in, fq = fq_in; asm volatile("" : "+v"(fr), "+v"(fq));
        EPI_FOR_ROWS { const int row = u.pm * 256 + EPI_ROWL;
#pragma unroll
            for (int bj = 0; bj < 2; ++bj) { const int col = bj * 128 + wc * 32 + 8 * fq; const u32x4 w = pack8(acc[ai][bj][m][0], acc[ai][bj][m][1]);
                if (u.pn < 9) *(u32x4*)(projc + (size_t)row * 2304 + u.pn * 256 + col) = w;
                else { const int g = col >> 4, hi0 = col & 15, chunk = row >> 5, sl = row & 31; *(u32x4*)(A2 + ((size_t)(g * NCHUNK + chunk) * KA2 + sl * 16 + hi0)) = w; } } }
    } };

struct SchedS5a { int G, c; const char* A2; const char* T1;
    __device__ __forceinline__ bool next(int i, Unit& u) const { const int L = i * G + c; if (L >= 128) return false; const int g = L >> 3, pm = L & 7; u.pm = pm; u.pn = 0; u.aux = g; u.rows = nullptr;
        u.A = A2 + (size_t)(g * NCHUNK + pm * 256) * KA2 * 2; u.B = T1 + (size_t)g * 256 * KU * 2; return true; } };
struct EpiS5a { static constexpr bool PERM = false; float* S;
    __device__ __forceinline__ void operator()(const f32x4 (&acc)[2][2][4][2], const Unit& u_in, int wr, int wc, int fr_in, int fq_in) const {
        Unit u = u_in; asm volatile("" : "+s"(u.pm), "+s"(u.pn), "+s"(u.aux)); int fr = fr_in, fq = fq_in; asm volatile("" : "+v"(fr), "+v"(fq));
        EPI_FOR_ROWS { const int row = u.pm * 256 + EPI_ROWL;
#pragma unroll
            for (int n = 0; n < 2; ++n) { const int col = wc * 32 + 16 * n + 4 * fq; *(f32x4*)(S + ((size_t)(u.aux * NCHUNK + row) * 128 + col)) = acc[ai][0][m][n]; } }
    } };

struct SchedS5b { int G, c; const char* A2; const char* T2;
    __device__ __forceinline__ bool next(int i, Unit& u) const { const int L = i * G + c; if (L >= 256) return false; const int g = L >> 4, pm = (L >> 1) & 7, pn = L & 1; u.pm = pm; u.pn = pn; u.aux = g; u.rows = nullptr;
        u.A = A2 + (size_t)(g * NCHUNK + pm * 256) * KA2 * 2; u.B = T2 + (size_t)(g * 512 + pn * 256) * KA2 * 2; return true; } };
struct EpiS5b { static constexpr bool PERM = true; bf16_t* ys;
    __device__ __forceinline__ void operator()(const f32x4 (&acc)[2][2][4][2], const Unit& u_in, int wr, int wc, int fr_in, int fq_in) const {
        Unit u = u_in; asm volatile("" : "+s"(u.pm), "+s"(u.pn), "+s"(u.aux)); int fr = fr_in, fq = fq_in; asm volatile("" : "+v"(fr), "+v"(fq));
        EPI_FOR_ROWS { const int chunk = u.pm * 256 + EPI_ROWL;
#pragma unroll
            for (int bj = 0; bj < 2; ++bj) { const int n = u.pn * 256 + bj * 128 + wc * 32 + 8 * fq, tl = n >> 4, ho0 = n & 15; const size_t t = (size_t)chunk * LCH + tl;
                f32x4 a = acc[ai][bj][m][0], b = acc[ai][bj][m][1];
#pragma unroll
                for (int j = 0; j < 4; ++j) { a[j] = gelu_tanh(a[j]); b[j] = gelu_tanh(b[j]); }
                *(u32x4*)(ys + t * 256 + u.aux * 16 + ho0) = pack8(a, b); } }
    } };

struct SchedGlu { int G, c; const char* ys; const char* W;
    __device__ __forceinline__ bool next(int i, Unit& u) const { const int L = i * G + c; if (L >= 256) return false; u.pm = L; u.pn = 0; u.aux = 0; u.rows = nullptr;
        u.A = ys + (size_t)L * 256 * 256 * 2; u.B = W; return true; } };
struct EpiGlu { static constexpr bool PERM = true; const bf16_t* ys; const float* b_glu; const float* g_ssm; bf16_t* ycat; LAS float* scr;
    __device__ __forceinline__ void operator()(f32x4 (&acc)[2][2][4][2], const Unit& u_in, int wr, int wc, int fr_in, int fq_in) const {
        Unit u = u_in; asm volatile("" : "+s"(u.pm), "+s"(u.pn), "+s"(u.aux)); int fr = fr_in, fq = fq_in; asm volatile("" : "+v"(fr), "+v"(fq));
        f32x4 bg[2][2];
#pragma unroll
        for (int bj = 0; bj < 2; ++bj) { const int col = bj * 128 + wc * 32 + 8 * fq; bg[bj][0] = *(const f32x4*)(b_glu + col); bg[bj][1] = *(const f32x4*)(b_glu + col + 4); }
#pragma unroll
        for (int ai = 0; ai < 2; ++ai) {
            u32x4 yw[4][2];
#pragma unroll
            for (int m = 0; m < 4; ++m)
#pragma unroll
                for (int bj = 0; bj < 2; ++bj) yw[m][bj] = *(const u32x4*)(ys + ((size_t)u.pm * 256 + EPI_ROWL) * 256 + bj * 128 + wc * 32 + 8 * fq);
#pragma unroll
            for (int m = 0; m < 4; ++m) { const int rl = EPI_ROWL; float ss = 0.f;
#pragma unroll
                for (int bj = 0; bj < 2; ++bj) { const u32x4 w = yw[m][bj];
                    const f32x4 y0 = (f32x4){bflo(w.x), bfhi(w.x), bflo(w.y), bfhi(w.y)}, y1 = (f32x4){bflo(w.z), bfhi(w.z), bflo(w.w), bfhi(w.w)};
#pragma unroll
                    for (int j = 0; j < 4; ++j) { const float o0 = y0[j] * sigmoidf_(acc[ai][bj][m][0][j] + bg[bj][0][j]), o1 = y1[j] * sigmoidf_(acc[ai][bj][m][1][j] + bg[bj][1][j]);
                        acc[ai][bj][m][0][j] = o0; acc[ai][bj][m][1][j] = o1; ss += o0 * o0 + o1 * o1; } }
                ss += __shfl_xor(ss, 16); ss += __shfl_xor(ss, 32);
                if (fq == 0) scr[rl * 4 + wc] = ss; }
            asm volatile("" ::: "memory"); }
        LDS_WAIT(); __builtin_amdgcn_s_barrier(); asm volatile("" ::: "memory");
        f32x4 gs[2][2];
#pragma unroll
        for (int bj = 0; bj < 2; ++bj) { const int col = bj * 128 + wc * 32 + 8 * fq; gs[bj][0] = *(const f32x4*)(g_ssm + col); gs[bj][1] = *(const f32x4*)(g_ssm + col + 4); }
        EPI_FOR_ROWS { const int rl = EPI_ROWL; const size_t row = (size_t)u.pm * 256 + rl; const f32x4 p = *(const LAS f32x4*)(scr + rl * 4);
            const float rstd = rsqrtf(((p.x + p.y) + (p.z + p.w)) * (1.0f / 256.0f) + RMS_EPS);
#pragma unroll
            for (int bj = 0; bj < 2; ++bj) { const int col = bj * 128 + wc * 32 + 8 * fq;
                *(u32x4*)(ycat + row * 1024 + 768 + col) = pack8(acc[ai][bj][m][0] * rstd * gs[bj][0], acc[ai][bj][m][1] * rstd * gs[bj][1]); } }
        LDS_WAIT(); __builtin_amdgcn_s_barrier(); asm volatile("" ::: "memory");
    } };

struct SchedG2 { int c; const char* A; const char* B;
    __device__ __forceinline__ bool next(int i, Unit& u) const { if (i >= 4 || c >= 256) return false; u.pm = c; u.pn = i; u.aux = 0; u.rows = nullptr;
        u.A = A + (size_t)c * 256 * 1024 * 2; u.B = B + (size_t)i * 256 * 1024 * 2; return true; } };
struct EpiG2 { static constexpr bool PERM = true; const float* x; const float* mod; bf16_t* x1; LAS float* scr;
    __device__ __forceinline__ void operator()(const f32x4 (&acc)[2][2][4][2], const Unit& u_in, int wr, int wc, int fr_in, int fq_in) const {
        Unit u = u_in; asm volatile("" : "+s"(u.pm), "+s"(u.pn), "+s"(u.aux)); int fr = fr_in, fq = fq_in; asm volatile("" : "+v"(fr), "+v"(fq));
        const int b = u.pm >> 4;
        const char* xb = (const char*)(x + (size_t)u.pm * 256 * 1024 + u.pn * 256);
        char* ob = (char*)(x1 + (size_t)u.pm * 256 * 1024 + u.pn * 256);
        const char* gb = (const char*)(mod + b * 6144 + 2048 + u.pn * 256);
        const unsigned lcol = (unsigned)(wc * 32 + 8 * fq);
#pragma unroll
        for (int ai = 0; ai < 2; ++ai) {
            f32x4 xv[4][2][2], gt[2][2];
#pragma unroll
            for (int m = 0; m < 4; ++m)
#pragma unroll
                for (int bj = 0; bj < 2; ++bj) { const unsigned off = ((unsigned)EPI_ROWL * 1024u + bj * 128u + lcol) * 4u; xv[m][bj][0] = *(const f32x4*)(xb + off); xv[m][bj][1] = *(const f32x4*)(xb + off + 16); }
#pragma unroll
            for (int bj = 0; bj < 2; ++bj) { const unsigned off = (bj * 128u + lcol) * 4u; gt[bj][0] = *(const f32x4*)(gb + off); gt[bj][1] = *(const f32x4*)(gb + off + 16); }
#pragma unroll
            for (int m = 0; m < 4; ++m) { const int rl = EPI_ROWL; float ss = 0.f;
#pragma unroll
                for (int bj = 0; bj < 2; ++bj) { const unsigned off = ((unsigned)rl * 1024u + bj * 128u + lcol) * 2u;
                    const f32x4 o0 = xv[m][bj][0] + gt[bj][0] * acc[ai][bj][m][0], o1 = xv[m][bj][1] + gt[bj][1] * acc[ai][bj][m][1];
                    ss += (o0.x * o0.x + o0.y * o0.y) + (o0.z * o0.z + o0.w * o0.w) + (o1.x * o1.x + o1.y * o1.y) + (o1.z * o1.z + o1.w * o1.w);
                    *(u32x4*)(ob + off) = pack8(o0, o1); }
                ss += __shfl_xor(ss, 16); ss += __shfl_xor(ss, 32);
                if (fq == 0) scr[rl * 16 + u.pn * 4 + wc] = ss; }
            asm volatile("" ::: "memory"); }
    } };

struct SchedRS { TileOrder o; const char* A; const char* B;
    __device__ __forceinline__ bool next(int i, Unit& u) const { int pm, pn; if (!o.tile(i, pm, pn)) return false; u.pm = pm; u.pn = pn; u.aux = 0; u.rows = nullptr;
        u.A = A + (size_t)pm * 256 * 1024 * 2; u.B = B + (size_t)pn * 256 * 1024 * 2; return true; } };
struct EpiRS { static constexpr bool PERM = true; bf16_t* acts; float* logits;
    __device__ __forceinline__ void operator()(const f32x4 (&acc)[2][2][4][2], const Unit& u_in, int wr, int wc, int fr_in, int fq_in) const {
        Unit u = u_in; asm volatile("" : "+s"(u.pm), "+s"(u.pn), "+s"(u.aux)); int fr = fr_in, fq = fq_in; asm volatile("" : "+v"(fr), "+v"(fq));
        EPI_FOR_ROWS { const size_t row = (size_t)u.pm * 256 + EPI_ROWL;
            if (u.pn < 2) { f32x4 o0, o1;
#pragma unroll
                for (int j = 0; j < 4; ++j) { o0[j] = siluf_(acc[ai][0][m][0][j]) * acc[ai][1][m][0][j]; o1[j] = siluf_(acc[ai][0][m][1][j]) * acc[ai][1][m][1][j]; }
                *(u32x4*)(acts + row * 256 + u.pn * 128 + wc * 32 + 8 * fq) = pack8(o0, o1); }
            else if (wc < 2) { const int col = wc * 32 + 8 * fq; *(f32x4*)(logits + row * 64 + col) = acc[ai][0][m][0]; *(f32x4*)(logits + row * 64 + col + 4) = acc[ai][0][m][1]; } }
    } };

struct SchedUp { int G, c, nblk; const int* blk_e; const int* tok; const char* H2; const char* W13;
    __device__ __forceinline__ bool next(int i, Unit& u) const { const int L = i * G + c; if (L >= 2 * nblk) return false; const int j = L >> 1, h = L & 1;
        const int e = __builtin_amdgcn_readfirstlane(ld_i32_agent(blk_e + j)); u.pm = j; u.pn = h; u.aux = e; u.rows = tok + 2 * j * 256; u.A = H2; u.B = W13 + (size_t)(e * 2 + h) * 256 * 1024 * 2; return true; } };
struct EpiUp { static constexpr bool PERM = true; bf16_t* act;
    __device__ __forceinline__ void operator()(const f32x4 (&acc)[2][2][4][2], const Unit& u_in, int wr, int wc, int fr_in, int fq_in) const {
        Unit u = u_in; asm volatile("" : "+s"(u.pm), "+s"(u.pn), "+s"(u.aux)); int fr = fr_in, fq = fq_in; asm volatile("" : "+v"(fr), "+v"(fq));
        EPI_FOR_ROWS { const size_t row = (size_t)u.pm * 256 + EPI_ROWL; f32x4 o0, o1;
#pragma unroll
            for (int j = 0; j < 4; ++j) { o0[j] = siluf_(acc[ai][0][m][0][j]) * acc[ai][1][m][0][j]; o1[j] = siluf_(acc[ai][0][m][1][j]) * acc[ai][1][m][1][j]; }
            *(u32x4*)(act + row * 256 + u.pn * 128 + wc * 32 + 8 * fq) = pack8(o0, o1); }
    } };

struct SchedDown { int G, c, nblk; const int* blk_e; const char* act; const char* acts; const char* W2; const char* WS2;
    __device__ __forceinline__ bool next(int i, Unit& u) const { const int L = i * G + c; u.rows = nullptr;
        if (L < 4 * nblk) { const int j = L >> 2, pn = L & 3; const int e = __builtin_amdgcn_readfirstlane(ld_i32_agent(blk_e + j)); u.pm = j; u.pn = pn; u.aux = 0;
            u.A = act + (size_t)j * 256 * 256 * 2; u.B = W2 + (size_t)(e * 1024 + pn * 256) * 256 * 2; return true; }
        const int L2 = L - 4 * nblk; if (L2 >= 1024) return false; u.pm = L2 >> 2; u.pn = L2 & 3; u.aux = 1;
        u.A = acts + (size_t)u.pm * 256 * 256 * 2; u.B = WS2 + (size_t)u.pn * 256 * 256 * 2; return true; } };
struct EpiDown { static constexpr bool PERM = true; const u32x2* rec; unsigned char* Y8; bf16_t* x1; const float* mod;
    __device__ __forceinline__ void operator()(const f32x4 (&acc)[2][2][4][2], const Unit& u_in, int wr, int wc, int fr_in, int fq_in) const {
        Unit u = u_in; asm volatile("" : "+s"(u.pm), "+s"(u.pn), "+s"(u.aux)); int fr = fr_in, fq = fq_in; asm volatile("" : "+v"(fr), "+v"(fq));
        const int col0 = u.pn * 256 + wc * 64 + fq * 16;
        if (u.aux == 0) {
            int dd[2][4]; float ww[2][4]; unsigned du[2][4], wu[2][4];
            EPI_FOR_ROWS { const unsigned* rp = (const unsigned*)rec + 2 * (u.pm * 256 + EPI_ROWL); du[ai][m] = rp[0]; wu[ai][m] = rp[1]; }
            EPI_FOR_ROWS { asm volatile("" : "+v"(du[ai][m]), "+v"(wu[ai][m])); dd[ai][m] = (int)du[ai][m]; ww[ai][m] = __builtin_bit_cast(float, wu[ai][m]) * 16.0f; }
            EPI_FOR_ROWS { const int d = dd[ai][m]; const float wt = ww[ai][m];
                if (d >= 0) { const int tok = d & 0xffff, k = d >> 16; u32x4 w;
#pragma unroll
                    for (int q = 0; q < 4; ++q) { const f32x4 v = acc[ai][q >> 1][m][q & 1] * wt; int pk = 0;
                        pk = __builtin_amdgcn_cvt_pk_fp8_f32(v.x, v.y, pk, false); pk = __builtin_amdgcn_cvt_pk_fp8_f32(v.z, v.w, pk, true); w[q] = (unsigned)pk; }
                    *(u32x4*)(Y8 + ((size_t)tok * 6 + k) * 1024 + col0) = w; } }
        } else {
            const int b = u.pm >> 4;
            f32x4 gt[2][2];
#pragma unroll
            for (int bj = 0; bj < 2; ++bj) { gt[bj][0] = *(const f32x4*)(mod + b * 6144 + 5120 + col0 + 8 * bj); gt[bj][1] = *(const f32x4*)(mod + b * 6144 + 5120 + col0 + 8 * bj + 4); }
#pragma unroll
            for (int ai = 0; ai < 2; ++ai) {
                u32x4 xw[4][2];
#pragma unroll
                for (int m = 0; m < 4; ++m)
#pragma unroll
                    for (int bj = 0; bj < 2; ++bj) xw[m][bj] = *(const u32x4*)(x1 + ((size_t)u.pm * 256 + EPI_ROWL) * 1024 + col0 + 8 * bj);
#pragma unroll
                for (int m = 0; m < 4; ++m) { const size_t row = (size_t)u.pm * 256 + EPI_ROWL;
#pragma unroll
                    for (int bj = 0; bj < 2; ++bj) { const u32x4 w = xw[m][bj];
                        const f32x4 x0 = (f32x4){bflo(w.x), bfhi(w.x), bflo(w.y), bfhi(w.y)}, x1v = (f32x4){bflo(w.z), bfhi(w.z), bflo(w.w), bfhi(w.w)};
                        *(u32x4*)(x1 + row * 1024 + col0 + 8 * bj) = pack8(x0 + gt[bj][0] * acc[ai][bj][m][0], x1v + gt[bj][1] * acc[ai][bj][m][1]); } }
                asm volatile("" ::: "memory"); }
        }
    } };

__device__ __forceinline__ void p3_conv(Frame& F) {
    const bf16_t* P = WSP(bf16_t, WS_PROJC); bf16_t* Y = WSP(bf16_t, WS_YCAT);
    for (int chunk = F.blk * 8 + F.wave; chunk < NCHUNK; chunk += F.G * 8) {
        const int t0 = chunk * LCH;
        f32x4 w0[3], w1[3], w2[3], cb[3], gc[3], z1[3], z2[3];
#pragma unroll
        for (int j = 0; j < 3; ++j) { const int c0 = 4 * F.lane + 256 * j;
            w0[j] = *(const f32x4*)(F.conv_w + c0); w1[j] = *(const f32x4*)(F.conv_w + DCONV + c0); w2[j] = *(const f32x4*)(F.conv_w + 2 * DCONV + c0);
            cb[j] = *(const f32x4*)(F.conv_b + c0); gc[j] = *(const f32x4*)(F.g_conv + c0); z1[j] = (f32x4){0.f, 0.f, 0.f, 0.f}; z2[j] = z1[j]; }
        if ((t0 & (SEQ - 1)) != 0) {
#pragma unroll
            for (int j = 0; j < 3; ++j) { const int c0 = 4 * F.lane + 256 * j;
                const u32x2 ca = *(const u32x2*)(P + (size_t)(t0 - 2) * 2304 + 768 + c0), va = *(const u32x2*)(P + (size_t)(t0 - 2) * 2304 + 1536 + c0);
                const u32x2 cb_ = *(const u32x2*)(P + (size_t)(t0 - 1) * 2304 + 768 + c0), vb = *(const u32x2*)(P + (size_t)(t0 - 1) * 2304 + 1536 + c0);
                z2[j] = (f32x4){bflo(ca.x) * bflo(va.x), bfhi(ca.x) * bfhi(va.x), bflo(ca.y) * bflo(va.y), bfhi(ca.y) * bfhi(va.y)};
                z1[j] = (f32x4){bflo(cb_.x) * bflo(vb.x), bfhi(cb_.x) * bfhi(vb.x), bflo(cb_.y) * bflo(vb.y), bfhi(cb_.y) * bfhi(vb.y)}; }
        }
        for (int tt = 0; tt < LCH; tt += 4) {
            u32x2 bw[4][3], cw[4][3], vw[4][3];
#pragma unroll
            for (int q = 0; q < 4; ++q) { const size_t t = (size_t)t0 + tt + q;
#pragma unroll
                for (int j = 0; j < 3; ++j) { const int c0 = 4 * F.lane + 256 * j;
                    bw[q][j] = *(const u32x2*)(P + t * 2304 + c0); cw[q][j] = *(const u32x2*)(P + t * 2304 + 768 + c0); vw[q][j] = *(const u32x2*)(P + t * 2304 + 1536 + c0); } }
            f32x4 val[4][3]; float ss[4];
#pragma unroll
            for (int q = 0; q < 4; ++q) { float a = 0.f;
#pragma unroll
                for (int j = 0; j < 3; ++j) {
                    const f32x4 bg = (f32x4){bflo(bw[q][j].x), bfhi(bw[q][j].x), bflo(bw[q][j].y), bfhi(bw[q][j].y)};
                    const f32x4 z = (f32x4){bflo(cw[q][j].x) * bflo(vw[q][j].x), bfhi(cw[q][j].x) * bfhi(vw[q][j].x), bflo(cw[q][j].y) * bflo(vw[q][j].y), bfhi(cw[q][j].y) * bfhi(vw[q][j].y)};
                    val[q][j] = bg * (w0[j] * z2[j] + w1[j] * z1[j] + w2[j] * z + cb[j]); z2[j] = z1[j]; z1[j] = z;
                    a += (val[q][j].x * val[q][j].x + val[q][j].y * val[q][j].y) + (val[q][j].z * val[q][j].z + val[q][j].w * val[q][j].w); }
                ss[q] = a; }
#pragma unroll
            for (int o = 1; o < 64; o <<= 1) {
#pragma unroll
                for (int q = 0; q < 4; ++q) ss[q] += __shfl_xor(ss[q], o); }
#pragma unroll
            for (int q = 0; q < 4; ++q) { const size_t t = (size_t)t0 + tt + q; const float rstd = rsqrtf(ss[q] * (1.0f / DCONV) + RMS_EPS);
#pragma unroll
                for (int j = 0; j < 3; ++j) { const int c0 = 4 * F.lane + 256 * j; const f32x4 o = val[q][j] * rstd * gc[j];
                    *(u32x2*)(Y + t * 1024 + c0) = (u32x2){pk2(o.x, o.y), pk2(o.z, o.w)}; } }
        }
    }
}

__device__ __forceinline__ void p4_scan(Frame& F) {
    if (F.wave != 0) return;
    const float* S = WSP(float, WS_S); bf16_t* A2 = WSP(bf16_t, WS_A2);
    for (int bg = F.blk; bg < NB * NG; bg += F.G) { const int b = bg >> 4, g = bg & 15, p = F.lane;
        const f32x2 a = WSP(f32x2, WS_AB32)[g * 64 + p]; float xr = 0.f, xi = 0.f;
#pragma unroll 8
        for (int c = 0; c < 128; ++c) { const size_t chunk = (size_t)g * NCHUNK + b * 128 + c;
            *(unsigned*)(A2 + chunk * KA2 + KU + 2 * p) = pk2(xr, xi);
            const f32x2 s = *(const f32x2*)(S + chunk * 128 + 2 * p);
            const float nr = a.x * xr - a.y * xi + s.x, ni = a.x * xi + a.y * xr + s.y; xr = nr; xi = ni; }
    }
}

__device__ __forceinline__ void p7_post(Frame& F) {
    const float* mod = WSP(float, WS_MOD); const bf16_t* X1 = WSP(bf16_t, WS_X1); bf16_t* H2 = WSP(bf16_t, WS_H2);
    LAS float* scr = (LAS float*)(F.lds + EPI_OFF);
    VM_WAIT(); LDS_WAIT(); __syncthreads();
    if (F.blk >= 256) return;
    const int b = F.blk >> 4;
    f32x4 gf[4], sh[4], sc[4];
#pragma unroll
    for (int j = 0; j < 4; ++j) { const int c0 = 4 * F.lane + 256 * j; gf[j] = *(const f32x4*)(F.g_ffn + c0); sh[j] = *(const f32x4*)(mod + b * 6144 + 3072 + c0); sc[j] = *(const f32x4*)(mod + b * 6144 + 4096 + c0) + 1.0f; gf[j] = gf[j] * sc[j]; }
    for (int i = 0; i < 32; i += 4) {
        u32x2 xw[4][4]; float rstd[4];
#pragma unroll
        for (int q = 0; q < 4; ++q) { const int rl = F.wave * 32 + i + q; const size_t row = (size_t)F.blk * 256 + rl;
#pragma unroll
            for (int j = 0; j < 4; ++j) xw[q][j] = *(const u32x2*)(X1 + row * 1024 + 4 * F.lane + 256 * j);
            float tot = 0.f;
#pragma unroll
            for (int p = 0; p < 4; ++p) { const f32x4 pq = *(const LAS f32x4*)(scr + rl * 16 + 4 * p); tot += (pq.x + pq.y) + (pq.z + pq.w); }
            rstd[q] = rsqrtf(tot * (1.0f / D) + RMS_EPS); }
#pragma unroll
        for (int q = 0; q < 4; ++q) { const size_t row = (size_t)F.blk * 256 + F.wave * 32 + i + q;
#pragma unroll
            for (int j = 0; j < 4; ++j) { const int c0 = 4 * F.lane + 256 * j;
                const f32x4 xv = (f32x4){bflo(xw[q][j].x), bfhi(xw[q][j].x), bflo(xw[q][j].y), bfhi(xw[q][j].y)};
                const f32x4 h = xv * rstd[q] * gf[j] + sh[j];
                *(u32x2*)(H2 + row * 1024 + c0) = (u32x2){pk2(h.x, h.y), pk2(h.z, h.w)}; } }
    }
}

__device__ __forceinline__ void p9_topk(Frame& F) {
    const float* LG = WSP(float, WS_LOGITS); unsigned char* R = F.ws + WS_ROUTE;
    int* sele = (int*)(R + RT_SELE); float* selw = (float*)(R + RT_SELW); int* cntw = (int*)(R + RT_CNTW); int* cntb = (int*)(R + RT_CNTB);
    u32x2* rec = (u32x2*)(R + RT_REC);
    LAS int* lcnt = (LAS int*)F.lds;
    const float NEG = -INFINITY;
    for (int blk = F.blk; blk < 256; blk += F.G) {
        for (int i = F.tid; i < MAXBLK; i += 512) rec[blk * MAXBLK + i] = (u32x2){0xffffffffu, 0u};
        if (F.wave < 4) {
            const int tok = blk * 256 + F.tid;
            float s[64], bb[64];
#pragma unroll
            for (int q = 0; q < 16; ++q) { const f32x4 lg = *(const f32x4*)(LG + (size_t)tok * 64 + 4 * q);
#pragma unroll
                for (int j = 0; j < 4; ++j) { s[4 * q + j] = sigmoidf_(lg[j]); bb[4 * q + j] = s[4 * q + j] + F.router_bias[4 * q + j]; } }
            float gs[8];
#pragma unroll
            for (int g = 0; g < 8; ++g) { float m1 = NEG, m2 = NEG;
#pragma unroll
                for (int j = 0; j < 8; ++j) { const float v = bb[8 * g + j]; if (v > m1) { m2 = m1; m1 = v; } else if (v > m2) { m2 = v; } }
                gs[g] = m1 + m2; }
            unsigned gsel = 0u;
#pragma unroll
            for (int g = 0; g < 8; ++g) { int rk = 0;
#pragma unroll
                for (int g2 = 0; g2 < 8; ++g2) rk += (gs[g2] > gs[g] || (gs[g2] == gs[g] && g2 < g)) ? 1 : 0;
                gsel |= (rk < 4) ? (1u << g) : 0u; }
#pragma unroll
            for (int e = 0; e < 64; ++e) bb[e] = ((gsel >> (e >> 3)) & 1u) ? bb[e] : NEG;
            int ek[6]; float sk[6]; unsigned long long taken = 0ull; float ssum = 0.f;
#pragma unroll
            for (int k = 0; k < 6; ++k) { float best = NEG, bs = 0.f; int bi = 0;
#pragma unroll
                for (int e = 0; e < 64; ++e) { const bool c = (((taken >> e) & 1ull) == 0ull) && (bb[e] > best); best = c ? bb[e] : best; bs = c ? s[e] : bs; bi = c ? e : bi; }
                ek[k] = bi; sk[k] = bs; taken |= 1ull << bi; ssum += bs; }
            int rk[6] = {0, 0, 0, 0, 0, 0}; int mycnt = 0;
#pragma unroll
            for (int e = 0; e < 64; ++e) { const bool hit = ((taken >> e) & 1ull) != 0ull; const unsigned long long m = __ballot(hit);
                const int pre = __builtin_amdgcn_mbcnt_hi((unsigned)(m >> 32), __builtin_amdgcn_mbcnt_lo((unsigned)m, 0u));
#pragma unroll
                for (int k = 0; k < 6; ++k) rk[k] = (ek[k] == e) ? pre : rk[k];
                mycnt = (F.lane == e) ? __popcll(m) : mycnt; }
            const float inv = 2.5f / ssum;
#pragma unroll
            for (int k = 0; k < 6; ++k) { sele[(size_t)tok * 6 + k] = ek[k] | (rk[k] << 8); selw[(size_t)tok * 6 + k] = sk[k] * inv; }
            cntw[(blk * 4 + F.wave) * 64 + F.lane] = mycnt; lcnt[F.wave * 64 + F.lane] = mycnt;
        }
        __syncthreads();
        if (F.tid < 64) cntb[blk * 64 + F.tid] = (lcnt[F.tid] + lcnt[64 + F.tid]) + (lcnt[128 + F.tid] + lcnt[192 + F.tid]);
        __syncthreads();
    }
}

__device__ __forceinline__ void p10_scatter(Frame& F) {
    unsigned char* R = F.ws + WS_ROUTE;
    const int* sele = (const int*)(R + RT_SELE); const float* selw = (const float*)(R + RT_SELW); const int* cntw = (const int*)(R + RT_CNTW); const int* cntb = (const int*)(R + RT_CNTB);
    u32x2* rec = (u32x2*)(R + RT_REC);
    LAS int* ptot = (LAS int*)F.lds; LAS int* ppre = ptot + 512; LAS int* pst = ppre + 512; LAS int* pad = pst + 64; LAS int* base = pad + 64;
    for (int blk = F.blk; blk < 256; blk += F.G) {
        { const int p8 = F.tid >> 6, e = F.tid & 63; int tot = 0, pre = 0;
          for (int b2 = 32 * p8; b2 < 32 * p8 + 32; ++b2) { const int c = cntb[b2 * 64 + e]; tot += c; pre += (b2 < blk) ? c : 0; }
          ptot[p8 * 64 + e] = tot; ppre[p8 * 64 + e] = pre; }
        __syncthreads();
        if (F.tid < 64) { const int e = F.tid; int total = 0, bb = 0;
#pragma unroll
            for (int q = 0; q < 8; ++q) { total += ptot[q * 64 + e]; bb += ppre[q * 64 + e]; }
            const int padded = (total + 255) & ~255; int v = padded;
#pragma unroll
            for (int o = 1; o < 64; o <<= 1) { const int tv = __shfl_up(v, o); if (e >= o) v += tv; }
            const int pstart = v - padded; pst[e] = pstart; pad[e] = padded;
            int run = pstart + bb;
#pragma unroll
            for (int w = 0; w < 4; ++w) { base[w * 64 + e] = run; run += cntw[(blk * 4 + w) * 64 + e]; }
            if (blk == 0 && e == 63) { const int nblk = (pstart + padded) >> 8; __hip_atomic_store(WSP(int, WS_CTL) + CW_NBLK, nblk, __ATOMIC_RELAXED, __HIP_MEMORY_SCOPE_AGENT); } }
        __syncthreads();
        for (int a = F.tid; a < 256 * TOPK; a += 512) { const int tl = a / 6, k = a - tl * 6, tok = blk * 256 + tl, w = tl >> 6;
            const int se = sele[(size_t)tok * 6 + k]; const int e = se & 255, r = se >> 8; const int dest = base[w * 64 + e] + r;
            rec[dest] = (u32x2){(unsigned)(tok | (k << 16)), __builtin_bit_cast(unsigned, selw[(size_t)tok * 6 + k])}; }
        { const int nblk = (pst[63] + pad[63]) >> 8; int* blke = WSP(int, WS_BLKE);
            if (F.tid < 8) { const int j = blk * 8 + F.tid; if (j < nblk) { const int r0 = j * 256; int e = 0;
                for (int q = 0; q < 64; ++q) if (pad[q] > 0 && pst[q] <= r0 && r0 < pst[q] + pad[q]) e = q;
                blke[j] = e; } } }
        __syncthreads();
    }
}

__device__ __forceinline__ void p13_final(Frame& F) {
    const float* mod = WSP(float, WS_MOD); const bf16_t* X1 = WSP(bf16_t, WS_X1); const unsigned char* Y8 = F.ws + WS_Y4;
    const int NGW = F.G * 8, c0 = 16 * F.lane;
    for (int t0 = F.blk * 8 + F.wave; t0 < T; t0 += 2 * NGW) {
        u32x4 yw[2][6], xw[2][2];
#pragma unroll
        for (int q = 0; q < 2; ++q) { const size_t t = (size_t)t0 + (size_t)q * NGW;
#pragma unroll
            for (int k = 0; k < 6; ++k) yw[q][k] = *(const u32x4*)(Y8 + (t * 6 + k) * 1024 + c0);
            xw[q][0] = *(const u32x4*)(X1 + t * 1024 + c0); xw[q][1] = *(const u32x4*)(X1 + t * 1024 + c0 + 8); }
        f32x4 v[2][4]; float ss[2];
#pragma unroll
        for (int q = 0; q < 2; ++q) { const int b = (t0 + q * NGW) >> 12; float a = 0.f;
#pragma unroll
            for (int j = 0; j < 4; ++j) { f32x4 ys = (f32x4){0.f, 0.f, 0.f, 0.f};
#pragma unroll
                for (int k = 0; k < 6; ++k) { const f32x2 lo = __builtin_amdgcn_cvt_pk_f32_fp8((int)yw[q][k][j], false), hi = __builtin_amdgcn_cvt_pk_f32_fp8((int)yw[q][k][j], true);
                    ys += (f32x4){lo.x, lo.y, hi.x, hi.y}; }
                const f32x4 g2 = *(const f32x4*)(mod + b * 6144 + 5120 + c0 + 4 * j) * 0.0625f;
                const unsigned w0 = xw[q][j >> 1][(j & 1) * 2], w1 = xw[q][j >> 1][(j & 1) * 2 + 1];
                v[q][j] = (f32x4){bflo(w0), bfhi(w0), bflo(w1), bfhi(w1)} + g2 * ys;
                a += (v[q][j].x * v[q][j].x + v[q][j].y * v[q][j].y) + (v[q][j].z * v[q][j].z + v[q][j].w * v[q][j].w); }
            ss[q] = a; }
#pragma unroll
        for (int o = 1; o < 64; o <<= 1) { ss[0] += __shfl_xor(ss[0], o); ss[1] += __shfl_xor(ss[1], o); }
#pragma unroll
        for (int q = 0; q < 2; ++q) { const size_t t = (size_t)t0 + (size_t)q * NGW; const float rstd = rsqrtf(ss[q] * (1.0f / D) + RMS_EPS);
#pragma unroll
            for (int j = 0; j < 4; ++j) { const f32x4 gf = *(const f32x4*)(F.g_final + c0 + 4 * j);
                *(f32x4*)(F.out + t * 1024 + c0 + 4 * j) = v[q][j] * rstd * gf; } }
    }
}

#ifndef STAGGER
#define STAGGER 0
#endif
__device__ __forceinline__ void phase_stagger(Frame& F, int unit_ticks) {
#if STAGGER
    const unsigned long long t0 = __builtin_amdgcn_s_memrealtime(); const unsigned long long wait = (unsigned long long)(((F.blk >> 3) & 3) * unit_ticks / 4);
    while (__builtin_amdgcn_s_memrealtime() - t0 < wait) __builtin_amdgcn_s_sleep(16);
#endif
}
constexpr int N_PHASES = 14;
template <int K> __device__ __forceinline__ void run_phase(Frame& F) {
    LAS unsigned char* ring = F.lds; LAS float* escr = (LAS float*)(F.lds + EPI_OFF);
    if constexpr (K == 0) { if (F.blk < 192) p0_mod(F); }
    if constexpr (K == 1) { p0_prologue(F); p1_h(F); }
    if constexpr (K == 2) {
        SchedG1 S; S.o.init(256, 10, F.G, F.blk); S.A = (const char*)WSP(bf16_t, WS_H); S.B = (const char*)WSP(bf16_t, WS_WIN_T);
        EpiG1 E{WSP(bf16_t, WS_PROJC), WSP(bf16_t, WS_A2)};
        phase_stagger(F, 2800);
        pg8::gemm_phase<EpiG1, SchedG1, false, false>(ring, pg8::Desc{1024, 1024, 1024}, S, E);
    }
    if constexpr (K == 3) {
        p3_conv(F); __syncthreads();
        SchedS5a S{F.G, F.blk, (const char*)WSP(bf16_t, WS_A2), (const char*)WSP(bf16_t, WS_T1)}; EpiS5a E{WSP(float, WS_S)};
        pg8::gemm_phase<EpiS5a, SchedS5a, false, false>(ring, pg8::Desc{KA2, KU, KU}, S, E);
    }
    if constexpr (K == 4) { p4_scan(F); }
    if constexpr (K == 5) {
        SchedS5b S{F.G, F.blk, (const char*)WSP(bf16_t, WS_A2), (const char*)WSP(bf16_t, WS_T2)}; EpiS5b E{WSP(bf16_t, WS_YS)};
        pg8::gemm_phase<EpiS5b, SchedS5b, false, false>(ring, pg8::Desc{KA2, KA2, KA2}, S, E);
    }
    if constexpr (K == 6) {
        SchedGlu S{F.G, F.blk, (const char*)WSP(bf16_t, WS_YS), (const char*)WSP(bf16_t, WS_WGLU_T)};
        EpiGlu E{WSP(bf16_t, WS_YS), F.b_glu, F.g_ssm, WSP(bf16_t, WS_YCAT), escr};
        pg8::gemm_phase<EpiGlu, SchedGlu, false, true>(ring, pg8::Desc{256, 256, 256}, S, E);
    }
    if constexpr (K == 7) {
        SchedG2 S{F.blk, (const char*)WSP(bf16_t, WS_YCAT), (const char*)WSP(bf16_t, WS_WOUT_T)};
        EpiG2 E{F.x, WSP(float, WS_MOD), WSP(bf16_t, WS_X1), escr};
        pg8::gemm_phase<EpiG2, SchedG2, false, false>(ring, pg8::Desc{1024, 1024, 1024}, S, E);
        p7_post(F);
    }
    if constexpr (K == 8) {
        SchedRS S; S.o.init(256, 3, F.G, F.blk); S.A = (const char*)WSP(bf16_t, WS_H2); S.B = (const char*)WSP(bf16_t, WS_WSR_T);
        EpiRS E{WSP(bf16_t, WS_ACTS), WSP(float, WS_LOGITS)};
        pg8::gemm_phase<EpiRS, SchedRS, false, false>(ring, pg8::Desc{1024, 1024, 1024}, S, E);
    }
    if constexpr (K == 9) { p9_topk(F); }
    if constexpr (K == 10) { p10_scatter(F); }
    if constexpr (K == 11) {
        const int nblk = __builtin_amdgcn_readfirstlane(ld_i32_agent(WSP(int, WS_CTL) + CW_NBLK));
        SchedUp S{F.G, F.vcu, nblk, WSP(int, WS_BLKE), (const int*)(F.ws + WS_ROUTE + RT_REC), (const char*)WSP(bf16_t, WS_H2), (const char*)WSP(bf16_t, WS_W13T)};
        EpiUp E{WSP(bf16_t, WS_ACT)};
        phase_stagger(F, 2800);
        pg8::gemm_phase<EpiUp, SchedUp, true, false>(ring, pg8::Desc{1024, 1024, 1024}, S, E);
    }
    if constexpr (K == 12) {
        const int nblk = __builtin_amdgcn_readfirstlane(ld_i32_agent(WSP(int, WS_CTL) + CW_NBLK));
        SchedDown S{F.G, F.vcu, nblk, WSP(int, WS_BLKE), (const char*)WSP(bf16_t, WS_ACT), (const char*)WSP(bf16_t, WS_ACTS), (const char*)WSP(bf16_t, WS_W2T), (const char*)WSP(bf16_t, WS_WS2_T)};
        EpiDown E{(const u32x2*)(F.ws + WS_ROUTE + RT_REC), F.ws + WS_Y4, WSP(bf16_t, WS_X1), WSP(float, WS_MOD)};
        phase_stagger(F, 900);
        pg8::gemm_phase<EpiDown, SchedDown, false, false>(ring, pg8::Desc{256, 256, 256}, S, E);
    }
    if constexpr (K == 13) { p13_final(F); }
}
#ifndef REP_PHASE
#define REP_PHASE -1
#endif
#ifndef PH_MASK
#define PH_MASK 0xFFFF
#endif
#ifndef USE_CG_FIRST
#define USE_CG_FIRST 0
#endif
template <int K> __device__ __forceinline__ void grid_sync(Frame& F) {
#if MK_N_LAUNCHES == 1
    if constexpr (K == 0 && USE_CG_FIRST) cg::this_grid().sync(); else xcd_barrier(F.bar);
#endif
}
template <int K> __device__ __forceinline__ void phase_and_seam(Frame& F, int lo, int hi) {
    if (((PH_MASK >> K) & 1) && lo <= K && K < hi) {
        run_phase<K>(F);
        if constexpr (K == REP_PHASE) { grid_sync<K>(F); run_phase<K>(F); }
        if (K + 1 < hi) grid_sync<K>(F);
    }
}
__global__ void __launch_bounds__(512, 2) mk_fwd(Args args) {
    extern __shared__ __attribute__((aligned(16))) unsigned char lds_raw[];
    Frame F;
    F.lds = (LAS unsigned char*)lds_raw; F.tid = threadIdx.x; F.lane = F.tid & 63; F.wave = __builtin_amdgcn_readfirstlane(F.tid >> 6);
    F.blk = blockIdx.x; F.G = gridDim.x; F.vcu = (F.G % 8 == 0) ? (F.blk % 8) * (F.G / 8) + F.blk / 8 : F.blk;
    { const float* const* in = args.in;
      F.x = in[0]; F.c = in[1]; F.w_ada = in[2]; F.b_ada = in[3]; F.g_mix = in[4]; F.w_in = in[5]; F.conv_w = in[6]; F.conv_b = in[7]; F.g_conv = in[8];
      F.lam_re = in[9]; F.lam_im = in[10]; F.log_dt = in[11]; F.b_re = in[12]; F.b_im = in[13]; F.c_re = in[14]; F.c_im = in[15]; F.d_skip = in[16];
      F.w_glu = in[17]; F.b_glu = in[18]; F.g_ssm = in[19]; F.w_out = in[20]; F.g_ffn = in[21]; F.w_router = in[22]; F.router_bias = in[23];
      F.w1 = in[24]; F.w3 = in[25]; F.w2 = in[26]; F.ws1 = in[27]; F.ws3 = in[28]; F.ws2 = in[29]; F.g_final = in[30]; }
    F.out = args.out; F.ws = args.ws;
    const int lo = args.ph_lo, hi = args.ph_hi;
    if (F.tid < 64) ((LAS unsigned*)(F.lds + MISC_OFF))[F.tid] = 0u;
    __syncthreads();
    F.bar = xcd_barrier_post((unsigned*)(F.ws + WS_CTL) + CW_BAR, (volatile LAS unsigned*)(F.lds + MISC_OFF) + 8);
    phase_and_seam<0>(F, lo, hi); phase_and_seam<1>(F, lo, hi); phase_and_seam<2>(F, lo, hi); phase_and_seam<3>(F, lo, hi);
    phase_and_seam<4>(F, lo, hi); phase_and_seam<5>(F, lo, hi); phase_and_seam<6>(F, lo, hi); phase_and_seam<7>(F, lo, hi);
    phase_and_seam<8>(F, lo, hi); phase_and_seam<9>(F, lo, hi); phase_and_seam<10>(F, lo, hi); phase_and_seam<11>(F, lo, hi);
    phase_and_seam<12>(F, lo, hi); phase_and_seam<13>(F, lo, hi);
}

extern "C" void kernel_launch(void* const* d_in, const int* in_sizes, int n_in, void* d_out, int out_size, void* d_ws, size_t ws_size, hipStream_t stream) {
    static int grid = 0;
    if (grid == 0) {
        if (n_in != 31 || in_sizes[0] != T * D || out_size != T * D || ws_size < WS_END) { fprintf(stderr, "kernel_launch: unexpected shapes (n_in %d, in0 %d, out %d, ws %zu)\n", n_in, n_in > 0 ? in_sizes[0] : -1, out_size, ws_size); grid = -1; return; }
        int dev = 0, cus = 0, per_cu = 0;
        if (hipGetDevice(&dev) != hipSuccess || hipDeviceGetAttribute(&cus, hipDeviceAttributeMultiprocessorCount, dev) != hipSuccess) { grid = -1; return; }
        if (hipFuncSetAttribute((const void*)mk_fwd, hipFuncAttributeMaxDynamicSharedMemorySize, LDS_BYTES) != hipSuccess) { fprintf(stderr, "kernel_launch: hipFuncSetAttribute failed\n"); grid = -1; return; }
        if (hipOccupancyMaxActiveBlocksPerMultiprocessor(&per_cu, (const void*)mk_fwd, 512, LDS_BYTES) != hipSuccess || per_cu < 1) { fprintf(stderr, "kernel_launch: occupancy query gives %d\n", per_cu); per_cu = 1; }
        (void)hipGetLastError();
        grid = cus;
        if (grid > 256) grid = 256;
    }
    if (grid < 0) return;
    (void)hipMemsetAsync((char*)d_ws + WS_CTL, 0, CTL_ZERO_BYTES, stream);
    Args a{};
    for (int i = 0; i < 31; ++i) a.in[i] = (const float*)d_in[i];
    a.out = (float*)d_out; a.ws = (unsigned char*)d_ws;
#if MK_N_LAUNCHES == 1
    a.ph_lo = 0; a.ph_hi = N_PHASES;
    void* kargs[] = {&a};
    hipError_t e = hipLaunchCooperativeKernel((const void*)mk_fwd, dim3(grid), dim3(512), kargs, LDS_BYTES, stream);
    if (e != hipSuccess) fprintf(stderr, "kernel_launch: cooperative launch failed: %s (grid %d)\n", hipGetErrorString(e), grid);
#else
    for (int p = 0; p < N_PHASES; ++p) { a.ph_lo = p; a.ph_hi = p + 1; hipLaunchKernelGGL(mk_fwd, dim3(grid), dim3(512), LDS_BYTES, stream, a); }
#endif
}
```

```cpp
#include <hip/hip_runtime.h>
#include <hip/hip_cooperative_groups.h>
#include <cstdio>
#include <cstdint>
namespace cg = cooperative_groups;

#ifndef MK_N_LAUNCHES
#define MK_N_LAUNCHES 1
#endif

#define LAS __attribute__((address_space(3)))
typedef unsigned short bf16_t;
typedef short bf16x8 __attribute__((ext_vector_type(8)));
typedef float f32x4 __attribute__((ext_vector_type(4)));
typedef float f32x2 __attribute__((ext_vector_type(2)));
typedef unsigned u32x4 __attribute__((ext_vector_type(4)));
typedef unsigned u32x2 __attribute__((ext_vector_type(2)));

constexpr int NB = 16, SEQ = 4096, D = 1024, T = NB * SEQ;
constexpr int DCONV = 768, DSSM = 256, DIN = 2560, NG = 16, GC = 16, NP = 64;
constexpr int NE = 64, TOPK = 6, DE = 256, NSLOT = 7;
constexpr int LCH = 32;
constexpr int NCHUNK = T / LCH;
constexpr int KU = LCH * GC;
constexpr int KA2 = KU + 2 * NP;
constexpr int MAXBLK = 1600;
constexpr float RMS_EPS = 1e-6f;

constexpr size_t MiB = 1u << 20, KiB = 1u << 10;
constexpr size_t WS_CTL = 0;
constexpr size_t WS_MOD = 64 * KiB;
constexpr size_t WS_AB32 = 448 * KiB;
constexpr size_t WS_BLKE = 512 * KiB;
constexpr size_t WS_WIN_T = 1 * MiB;
constexpr size_t WS_WOUT_T = 6 * MiB;
constexpr size_t WS_WGLU_T = 8 * MiB;
constexpr size_t WS_WS2_T = 8 * MiB + 512 * KiB;
constexpr size_t WS_WSR_T = 9 * MiB;
constexpr size_t WS_T1 = 11 * MiB;
constexpr size_t WS_T2 = 15 * MiB;
constexpr size_t WS_W13T = 25 * MiB;
constexpr size_t WS_W2T = 89 * MiB;
constexpr size_t WS_H = 128 * MiB;
constexpr size_t WS_X1 = 128 * MiB;
constexpr size_t WS_PROJC = 256 * MiB;
constexpr size_t WS_ACT = 256 * MiB;
constexpr size_t WS_ACTS = 456 * MiB;
constexpr size_t WS_ROUTE = 488 * MiB;
constexpr size_t WS_H2 = 512 * MiB;
constexpr size_t WS_Y4 = 512 * MiB;
constexpr size_t WS_YCAT = 640 * MiB;
constexpr size_t WS_LOGITS = 640 * MiB;
constexpr size_t WS_A2 = 768 * MiB;
constexpr size_t WS_S = 808 * MiB;
constexpr size_t WS_YS = 824 * MiB;
constexpr size_t WS_END = 1024 * MiB;
constexpr size_t RT_SELE = 0;
constexpr size_t RT_SELW = 2 * MiB;
constexpr size_t RT_CNTW = 4 * MiB;
constexpr size_t RT_CNTB = 5 * MiB;
constexpr size_t RT_REC = 6 * MiB;
constexpr int CW_NBLK = 16;
constexpr int CW_BAR = 1024;
constexpr size_t CTL_ZERO_BYTES = 32 * KiB;

constexpr int RING_BYTES = 131072;
constexpr int EPI_OFF = RING_BYTES;
constexpr int MISC_OFF = EPI_OFF + 16384;
constexpr int LDS_BYTES = 148480;

__device__ __forceinline__ unsigned f2bf(float f) { unsigned u = __builtin_bit_cast(unsigned, f); return (u + 0x7fffu + ((u >> 16) & 1u)) >> 16; }
typedef __bf16 bf16x2_t __attribute__((ext_vector_type(2)));
__device__ __forceinline__ unsigned pk2(float lo, float hi) { const f32x2 v = {lo, hi}; const bf16x2_t b = __builtin_convertvector(v, bf16x2_t); return __builtin_bit_cast(unsigned, b); }
__device__ __forceinline__ float bflo(unsigned w) { return __builtin_bit_cast(float, w << 16); }
__device__ __forceinline__ float bfhi(unsigned w) { return __builtin_bit_cast(float, w & 0xffff0000u); }
__device__ __forceinline__ float bf2f(bf16_t b) { return __builtin_bit_cast(float, (unsigned)b << 16); }
__device__ __forceinline__ float sigmoidf_(float v) { return 1.0f / (1.0f + __expf(-v)); }
__device__ __forceinline__ float siluf_(float v) { return v / (1.0f + __expf(-v)); }
__device__ __forceinline__ float gelu_tanh(float v) {
    const float z = 0.7978845608028654f * (v + 0.044715f * v * v * v);
    const float e = __expf(2.0f * z);
    const float th = 1.0f - 2.0f / (e + 1.0f);
    return 0.5f * v * (1.0f + th);
}
__device__ __forceinline__ float wave_sum(float v) {
#pragma unroll
    for (int o = 1; o < 64; o <<= 1) v += __shfl_xor(v, o);
    return v;
}
__device__ __forceinline__ int ld_i32_agent(const int* p) { return __hip_atomic_load(p, __ATOMIC_RELAXED, __HIP_MEMORY_SCOPE_AGENT); }


#define XB_TMO      128
#define XB_XCNT(j)  (256  + 64 * (j))
#define XB_XSUB(j)  (1280 + 64 * (j))
#define XB_XGEN(j)  (2304 + 64 * (j))
#define XB_TOP      3328
#define XB_TOPGEN   3392
#define XCD_BAR_WORDS 3456
#define XB_SPIN_CAP (1u << 22)
__device__ __forceinline__ unsigned xb_ld(unsigned* p)              { return __hip_atomic_load(p, __ATOMIC_RELAXED, __HIP_MEMORY_SCOPE_AGENT); }
__device__ __forceinline__ unsigned xb_add(unsigned* p, unsigned v) { return __hip_atomic_fetch_add(p, v, __ATOMIC_RELAXED, __HIP_MEMORY_SCOPE_AGENT); }
__device__ __forceinline__ unsigned xb_xcc_id() { return (unsigned)__builtin_amdgcn_s_getreg((3 << 11) | 20) & 0xFu; }
#define XB_SPIN(cond, bar) do { unsigned _sp = 0; while (cond) { __builtin_amdgcn_s_sleep(1); \
    if ((++_sp & 255u) == 0u) { if (xb_ld(&(bar)[XB_TMO])) break; if (_sp > XB_SPIN_CAP) { atomicAdd(&(bar)[XB_TMO], 1u); break; } } } } while (0)
struct XcdBarrier { unsigned* bar; unsigned x; volatile LAS unsigned* st; };
__device__ __forceinline__ XcdBarrier xcd_barrier_post(unsigned* bar, volatile LAS unsigned* st) {
    XcdBarrier b; b.bar = bar; b.x = xb_xcc_id(); b.st = st;
    if (threadIdx.x == 0) (void)xb_add(&bar[XB_XCNT(b.x)], 1u);
    return b;
}
__device__ __forceinline__ void xcd_barrier_complete(unsigned* bar, unsigned x, unsigned& nloc, unsigned& nx) {
    const unsigned G = gridDim.x * gridDim.y * gridDim.z;
    unsigned sum, cnt, mine, sp = 0u;
    for (;;) {
        sum = 0u; cnt = 0u; mine = 0u;
#pragma unroll
        for (unsigned j = 0; j < 16; ++j) { const unsigned c = xb_ld(&bar[XB_XCNT(j)]); sum += c; cnt += (c > 0u) ? 1u : 0u; mine = (j == x) ? c : mine; }
        if (sum == G) break;
        __builtin_amdgcn_s_sleep(1);
        if ((++sp & 255u) == 0u) { if (xb_ld(&bar[XB_TMO])) break; if (sp > XB_SPIN_CAP) { atomicAdd(&bar[XB_TMO], 1u); break; } }
    }
    nloc = mine > 0u ? mine : 1u; nx = cnt > 0u ? cnt : 1u;
}
__device__ __forceinline__ void xcd_barrier(const XcdBarrier& b) {
    asm volatile("s_waitcnt vmcnt(0)" ::: "memory");
    __syncthreads();
    if (threadIdx.x == 0) {
        unsigned* bar = b.bar;
        __builtin_amdgcn_s_waitcnt(0);
        unsigned nloc = b.st[0], nx = b.st[1];
        if (nloc == 0u) { xcd_barrier_complete(bar, b.x, nloc, nx); b.st[0] = nloc; b.st[1] = nx; }
        const unsigned old = xb_add(&bar[XB_XSUB(b.x)], 1u);
        const unsigned gen = old / nloc;
        if (old + 1u == (gen + 1u) * nloc) {
            __builtin_amdgcn_fence(__ATOMIC_RELEASE, "agent");
            asm volatile("s_waitcnt vmcnt(0)" ::: "memory");
            const unsigned og = xb_add(&bar[XB_TOP], 1u);
            const unsigned tg = og / nx;
            if (og + 1u == (tg + 1u) * nx) xb_add(&bar[XB_TOPGEN], 1u);
            else XB_SPIN(xb_ld(&bar[XB_TOPGEN]) == tg, bar);
            __builtin_amdgcn_fence(__ATOMIC_ACQUIRE, "agent");
            xb_add(&bar[XB_XGEN(b.x)], 1u);
            asm volatile("s_waitcnt vmcnt(0)" ::: "memory");
        } else {
            XB_SPIN(xb_ld(&bar[XB_XGEN(b.x)]) == gen, bar);
            __builtin_amdgcn_fence(__ATOMIC_ACQUIRE, "agent");
            asm volatile("s_waitcnt vmcnt(0)" ::: "memory");
        }
    }
    __syncthreads();
}

namespace pg8 {
constexpr int BM = 256, BK = 64, HALF = 128, HTB = HALF * BK * 2, STAGE_BYTES = 8 * HTB;
__device__ __forceinline__ int lds_byte(int r, int c) { const int st = (r >> 4) * 2 + (c >> 5), rr = r & 15, cc = c & 31, ob = rr * 64 + cc * 2; return st * 1024 + (ob ^ (((ob >> 9) & 1) << 5)); }
__device__ __forceinline__ void stage_rc(int b, int& R, int& C) { const int st = b / 1024, sb = b % 1024, swz = sb ^ (((sb >> 9) & 1) << 5); R = (st >> 1) * 16 + swz / 64; C = (st & 1) * 32 + (swz % 64) / 2; }
__device__ __forceinline__ int perm32(int rho) { const int n = rho >> 4, i = rho & 15; return 8 * (i >> 2) + 4 * n + (i & 3); }

struct Unit { const char* A; const char* B; const int* rows; int pm, pn, aux; };
struct Desc { int lda, ldb, K; };

template <class Epi, class Sched, bool GATHER, bool ALIGN_EPI>
__device__ __forceinline__ void gemm_phase(LAS unsigned char* lds, const Desc g, const Sched& S, const Epi& E) {
    const int tid = threadIdx.x, wid = __builtin_amdgcn_readfirstlane(tid >> 6), lane = tid & 63, wr = wid >> 2, wc = wid & 3, fr = lane & 15, fq = lane >> 4;
    const int K = g.K, nt = K / BK;
    int Rr[2], Cc[2]; unsigned voffB[2];
#pragma unroll
    for (int i = 0; i < 2; ++i) { int R, C; stage_rc(tid * 16 + i * 8192, R, C); const int Rb = Epi::PERM ? ((R & ~31) + perm32(R & 31)) : R;
        Rr[i] = R; Cc[i] = C; voffB[i] = (unsigned)(Rb * g.ldb + C) * 2u; }
    const size_t kstep = (size_t)(BK * 2);
    const size_t hstepB = (size_t)HALF * g.ldb * 2;
    const unsigned ldsw = (unsigned)wid * 1024u;
    const int aoff = lds_byte(wr * 64 + fr, fq * 8), boff = lds_byte(wc * 32 + fr, fq * 8);
#define PG8_SA(b, h) (((b) * 2 + (h)) * HTB)
#define PG8_SB(b, h) ((4 + (b) * 2 + (h)) * HTB)
#define PG8_STAGE(bufoff, gbase, v0, v1) do { \
        __builtin_amdgcn_global_load_lds((const unsigned*)((const char*)(gbase) + (v0)), (LAS unsigned*)(lds + (bufoff) + ldsw), 16, 0, 0); \
        __builtin_amdgcn_global_load_lds((const unsigned*)((const char*)(gbase) + (v1)), (LAS unsigned*)(lds + (bufoff) + ldsw + 8192), 16, 0, 0); } while (0)
#define PG8_STAGEB(bufoff, gbase) PG8_STAGE(bufoff, gbase, voffB[0], voffB[1])
#define PG8_LDA(dst, b, h) do { _Pragma("unroll") for (int m = 0; m < 4; ++m) _Pragma("unroll") for (int k = 0; k < 2; ++k) dst[m][k] = *(const LAS bf16x8*)(lds + PG8_SA(b, h) + aoff + m * 2048 + k * 1024); } while (0)
#define PG8_LDB(dst, b, h) do { _Pragma("unroll") for (int n = 0; n < 2; ++n) _Pragma("unroll") for (int k = 0; k < 2; ++k) dst[n][k] = *(const LAS bf16x8*)(lds + PG8_SB(b, h) + boff + n * 2048 + k * 1024); } while (0)
#define PG8_MMA(ai, bj, At, Bt) do { __builtin_amdgcn_s_setprio(1); _Pragma("unroll") for (int m = 0; m < 4; ++m) _Pragma("unroll") for (int n = 0; n < 2; ++n) _Pragma("unroll") for (int k = 0; k < 2; ++k) \
        acc[ai][bj][m][n] = __builtin_amdgcn_mfma_f32_16x16x32_bf16(Bt[n][k], At[m][k], acc[ai][bj][m][n], 0, 0, 0); __builtin_amdgcn_s_setprio(0); } while (0)
#define PG8_WAIT_V(n) asm volatile("s_waitcnt vmcnt(" #n ")" ::: "memory")
#define PG8_WAIT_L(n) asm volatile("s_waitcnt lgkmcnt(" #n ")" ::: "memory")
#define PG8_BAR __builtin_amdgcn_s_barrier()
#define PG8_SCHED __builtin_amdgcn_sched_barrier(0)
    const unsigned hoffA = GATHER ? 0u : (unsigned)(HALF * g.lda) * 2u;
#define PG8_AOFFS(dst, u) do { if constexpr (GATHER) { _Pragma("unroll") for (int h = 0; h < 2; ++h) _Pragma("unroll") for (int i = 0; i < 2; ++i) { \
        const int rec_ = (u).rows[2 * (h * HALF + Rr[i])]; const int row_ = rec_ < 0 ? 0 : (rec_ & 0xffff); dst[h][i] = (unsigned)(row_ * g.lda + Cc[i]) * 2u; } \
        asm volatile("" : "+v"(dst[0][0]), "+v"(dst[0][1]), "+v"(dst[1][0]), "+v"(dst[1][1])); } } while (0)
    Unit cur, nxt; int ui = 0;
    if (!S.next(0, cur)) return;
    unsigned cvo[2][2], nvo[2][2];
    if constexpr (GATHER) { PG8_AOFFS(cvo, cur); }
    else {
#pragma unroll
        for (int i = 0; i < 2; ++i) { cvo[0][i] = (unsigned)(Rr[i] * g.lda + Cc[i]) * 2u; cvo[1][i] = cvo[0][i] + hoffA; nvo[0][i] = cvo[0][i]; nvo[1][i] = cvo[1][i]; } }
    f32x4 acc[2][2][4][2];
#pragma unroll
    for (int a = 0; a < 2; ++a)
#pragma unroll
        for (int b = 0; b < 2; ++b)
#pragma unroll
            for (int m = 0; m < 4; ++m)
#pragma unroll
                for (int n = 0; n < 2; ++n) acc[a][b][m][n] = (f32x4){0.f, 0.f, 0.f, 0.f};
    bf16x8 At[4][2], B0[2][2], B1[2][2];
    const char* cA = cur.A; const char* cB = cur.B;
    PG8_STAGEB(PG8_SB(0, 0), cB); PG8_STAGEB(PG8_SB(0, 1), cB + hstepB); PG8_STAGE(PG8_SA(0, 0), cA, cvo[0][0], cvo[0][1]); PG8_STAGE(PG8_SA(0, 1), cA, cvo[1][0], cvo[1][1]);
    if (wr == 1) PG8_BAR;
    PG8_WAIT_V(2); PG8_BAR;
    PG8_STAGEB(PG8_SB(1, 0), cB + kstep); PG8_STAGE(PG8_SA(1, 0), cA + kstep, cvo[0][0], cvo[0][1]); PG8_STAGEB(PG8_SB(1, 1), cB + hstepB + kstep);
    PG8_WAIT_V(6); PG8_BAR;
    for (;;) {
        const bool has_next = S.next(ui + 1, nxt);
        const char* nA = has_next ? nxt.A : cA; const char* nB = has_next ? nxt.B : cB;
        if constexpr (GATHER) { if (has_next) { PG8_AOFFS(nvo, nxt); } else {
#pragma unroll
            for (int h = 0; h < 2; ++h)
#pragma unroll
                for (int i = 0; i < 2; ++i) nvo[h][i] = cvo[h][i]; } }
#pragma nounroll
        for (int t = 0; t < nt; t += 2) {
            const bool last = (t == nt - 2);
            const char* a1 = cA + (size_t)(t + 1) * kstep;
            const char* a2 = last ? nA : cA + (size_t)(t + 2) * kstep; const char* b2 = last ? nB : cB + (size_t)(t + 2) * kstep;
            const char* a3 = a2 + kstep; const char* b3 = b2 + kstep;
            const unsigned o00 = (GATHER && last) ? nvo[0][0] : cvo[0][0], o01 = (GATHER && last) ? nvo[0][1] : cvo[0][1], o10 = (GATHER && last) ? nvo[1][0] : cvo[1][0], o11 = (GATHER && last) ? nvo[1][1] : cvo[1][1];
            PG8_LDB(B0, 0, 0); PG8_LDB(B1, 0, 1); PG8_SCHED; PG8_LDA(At, 0, 0); PG8_STAGE(PG8_SA(1, 1), a1, cvo[1][0], cvo[1][1]);
            PG8_WAIT_V(8); PG8_WAIT_L(0); PG8_BAR; PG8_MMA(0, 0, At, B0); PG8_MMA(0, 1, At, B1); PG8_BAR; PG8_SCHED;
            PG8_LDA(At, 0, 1); PG8_STAGEB(PG8_SB(0, 0), b2); PG8_STAGEB(PG8_SB(0, 1), b2 + hstepB); PG8_STAGE(PG8_SA(0, 0), a2, o00, o01);
            PG8_WAIT_V(8); PG8_WAIT_L(0); PG8_BAR; PG8_MMA(1, 0, At, B0); PG8_MMA(1, 1, At, B1); PG8_BAR; PG8_SCHED;
            PG8_LDB(B0, 1, 0); PG8_LDB(B1, 1, 1); PG8_SCHED; PG8_LDA(At, 1, 0); PG8_STAGE(PG8_SA(0, 1), a2, o10, o11);
            PG8_WAIT_V(8); PG8_WAIT_L(0); PG8_BAR; PG8_MMA(0, 0, At, B0); PG8_MMA(0, 1, At, B1); PG8_BAR; PG8_SCHED;
            PG8_LDA(At, 1, 1); PG8_STAGEB(PG8_SB(1, 0), b3); PG8_STAGEB(PG8_SB(1, 1), b3 + hstepB); PG8_STAGE(PG8_SA(1, 0), a3, o00, o01);
            PG8_WAIT_V(8); PG8_WAIT_L(0); PG8_BAR; PG8_MMA(1, 0, At, B0); PG8_MMA(1, 1, At, B1); PG8_BAR; PG8_SCHED;
        }
        if constexpr (ALIGN_EPI) { if (wr == 0) PG8_BAR; }
        E(acc, cur, wr, wc, fr, fq);
        if (!has_next) break;
#pragma unroll
        for (int a = 0; a < 2; ++a)
#pragma unroll
            for (int b = 0; b < 2; ++b)
#pragma unroll
                for (int m = 0; m < 4; ++m)
#pragma unroll
                    for (int n = 0; n < 2; ++n) acc[a][b][m][n] = (f32x4){0.f, 0.f, 0.f, 0.f};
        cur = nxt; cA = nA; cB = nB; ++ui;
        if constexpr (GATHER) {
#pragma unroll
        for (int h = 0; h < 2; ++h)
#pragma unroll
            for (int i = 0; i < 2; ++i) cvo[h][i] = nvo[h][i]; }
        if constexpr (ALIGN_EPI) { if (wr == 1) PG8_BAR; }
    }
    PG8_WAIT_V(0);
    if constexpr (!ALIGN_EPI) { if (wr == 0) PG8_BAR; }
    PG8_BAR;
#undef PG8_SA
#undef PG8_SB
#undef PG8_STAGE
#undef PG8_STAGEB
#undef PG8_LDA
#undef PG8_LDB
#undef PG8_MMA
#undef PG8_WAIT_V
#undef PG8_WAIT_L
#undef PG8_BAR
#undef PG8_SCHED
#undef PG8_AOFFS
}
}
using pg8::Unit;

struct Args { const float* in[31]; float* out; unsigned char* ws; int ph_lo, ph_hi; };
struct Frame {
    LAS unsigned char* lds; int tid, lane, wave, blk, G, vcu;
    const float *x, *c, *w_ada, *b_ada, *g_mix, *w_in, *conv_w, *conv_b, *g_conv, *lam_re, *lam_im, *log_dt, *b_re, *b_im, *c_re, *c_im,
        *d_skip, *w_glu, *b_glu, *g_ssm, *w_out, *g_ffn, *w_router, *router_bias, *w1, *w3, *w2, *ws1, *ws3, *ws2, *g_final;
    float* out; unsigned char* ws; XcdBarrier bar;
};
#define WSP(T_, off) ((T_*)(F.ws + (off)))
#define LDS_WAIT() asm volatile("s_waitcnt lgkmcnt(0)" ::: "memory")
#define VM_WAIT() asm volatile("s_waitcnt vmcnt(0)" ::: "memory")

struct TileOrder {
    int nM, nN, nwg, G, c;
    __device__ __forceinline__ void init(int nM_, int nN_, int G_, int c_) { nM = nM_; nN = nN_; nwg = nM * nN; G = G_; c = c_; }
    __device__ __forceinline__ bool tile(int i, int& pm, int& pn) const {
        const long L = (long)i * G + c; if (L >= nwg) return false;
        int wgid = (int)L; { const int q = nwg / 8, r = nwg % 8, xcd = wgid % 8, off = wgid / 8; wgid = (xcd < r ? xcd * (q + 1) : r * (q + 1) + (xcd - r) * q) + off; }
        const int nig = 8 * nN, gid = wgid / nig, fm = gid * 8, gsz = (nM - fm) < 8 ? (nM - fm) : 8;
        pm = fm + ((wgid % nig) % gsz); pn = (wgid % nig) / gsz; return true;
    }
};

__device__ __forceinline__ int down_perm_row(int c) { const int cl = c & 255; return (c & ~255) + ((cl >> 3) & 1) * 128 + (cl >> 6) * 32 + ((cl >> 4) & 3) * 8 + (cl & 7); }
template <int PMODE = 0>
__device__ __forceinline__ void transpose_item(const float* W, int ldw, int k0, int n0, bf16_t* WT, int ldt, int drow0, LAS float* scr, int lane) {
    float tv[32];
#pragma unroll
    for (int i = 0; i < 32; ++i) { const int kk = 2 * i + (lane >> 5); tv[i] = W[(size_t)(k0 + kk) * ldw + n0 + (lane & 31)]; }
#pragma unroll
    for (int i = 0; i < 32; ++i) { const int kk = 2 * i + (lane >> 5); scr[kk * 33 + (lane & 31)] = tv[i]; }
    LDS_WAIT(); asm volatile("" ::: "memory");
    const int c = lane & 7;
#pragma unroll
    for (int j = 0; j < 4; ++j) { const int n = (lane >> 3) + 8 * j; const LAS float* s = scr + (8 * c) * 33 + n;
        u32x4 o; o.x = pk2(s[0 * 33], s[1 * 33]); o.y = pk2(s[2 * 33], s[3 * 33]); o.z = pk2(s[4 * 33], s[5 * 33]); o.w = pk2(s[6 * 33], s[7 * 33]);
        const int drow = PMODE ? down_perm_row(drow0 + n) : (drow0 + n);
        *(u32x4*)(WT + (size_t)drow * ldt + k0 + 8 * c) = o; }
    LDS_WAIT(); asm volatile("" ::: "memory");
}

__device__ __forceinline__ void p0_mod(Frame& F) {
    LAS float* sil = (LAS float*)F.lds;
    LAS float* red = (LAS float*)(F.lds + 65536);
    for (int i = F.tid; i < NB * D; i += 512) { const float v = F.c[i]; sil[i] = v / (1.0f + __expf(-v)); }
    __syncthreads();
    const int col = F.tid & 31, ks = F.tid >> 5, n0 = F.blk * 32;
    float acc[16];
#pragma unroll
    for (int b = 0; b < 16; ++b) acc[b] = 0.f;
#pragma nounroll
    for (int k0 = 0; k0 < 64; k0 += 16) { float wv[16];
#pragma unroll
        for (int kk = 0; kk < 16; ++kk) wv[kk] = F.w_ada[(size_t)(ks * 64 + k0 + kk) * 6144 + n0 + col];
#pragma unroll
        for (int kk = 0; kk < 16; ++kk) { const int k = ks * 64 + k0 + kk;
#pragma unroll
            for (int b = 0; b < 16; ++b) acc[b] += sil[b * 1024 + k] * wv[kk]; } }
#pragma unroll
    for (int b = 0; b < 16; ++b) red[(ks * 16 + b) * 32 + col] = acc[b];
    __syncthreads();
    { const int b = F.tid >> 5; float s = 0.f;
#pragma unroll
      for (int k2 = 0; k2 < 16; ++k2) s += red[(k2 * 16 + b) * 32 + col];
      WSP(float, WS_MOD)[b * 6144 + n0 + col] = s + F.b_ada[n0 + col]; }
    __syncthreads();
}

__device__ __forceinline__ void p0_s5_tables(Frame& F, int g, int part) {
    LAS f32x2* pw = (LAS f32x2*)F.lds;
    LAS f32x2* Bb = (LAS f32x2*)(F.lds + 20480);
    LAS f32x2* Cc = (LAS f32x2*)(F.lds + 28672);
    LAS float* Kn = (LAS float*)(F.lds + 36864);
    const float dt = expf(F.log_dt[g]);
    for (int i = F.tid; i < 33 * 64; i += 512) { const int tau = i >> 6, p = i & 63; const float lr = F.lam_re[g * 64 + p], li = F.lam_im[g * 64 + p];
        const float mag = expf(lr * dt * (float)tau), ang = li * dt * (float)tau; float sn, cs; sincosf(ang, &sn, &cs); pw[i] = (f32x2){mag * cs, mag * sn}; }
    for (int i = F.tid; i < 1024; i += 512) { const int p = i >> 4, hi = i & 15; const float lr = F.lam_re[g * 64 + p], li = F.lam_im[g * 64 + p];
        const float mag = expf(lr * dt), ang = li * dt; float sn, cs; sincosf(ang, &sn, &cs);
        const float nr = mag * cs - 1.0f, ni = mag * sn, den = lr * lr + li * li, qr = (nr * lr + ni * li) / den, qi = (ni * lr - nr * li) / den;
        const float br = F.b_re[(g * 64 + p) * 16 + hi], bi = F.b_im[(g * 64 + p) * 16 + hi];
        Bb[i] = (f32x2){qr * br - qi * bi, qr * bi + qi * br};
        Cc[i] = (f32x2){F.c_re[g * 1024 + i], F.c_im[g * 1024 + i]}; }
    __syncthreads();
    { const int tau = F.tid >> 4, ho = F.tid & 15;
      if (tau <= 4 * part + 3) { float kacc[16];
#pragma unroll
        for (int hi = 0; hi < 16; ++hi) kacc[hi] = 0.f;
        for (int p = 0; p < 64; ++p) { const f32x2 c = Cc[ho * 64 + p], a = pw[tau * 64 + p];
            const float wr_ = c.x * a.x - c.y * a.y, wi_ = c.x * a.y + c.y * a.x;
#pragma unroll
            for (int hi = 0; hi < 16; ++hi) { const f32x2 b = Bb[p * 16 + hi]; kacc[hi] += wr_ * b.x - wi_ * b.y; } }
#pragma unroll
        for (int hi = 0; hi < 16; ++hi) Kn[F.tid * 16 + hi] = kacc[hi]; } }
    __syncthreads();
    bf16_t* T2 = WSP(bf16_t, WS_T2); bf16_t* T1 = WSP(bf16_t, WS_T1);
    for (int i = F.tid; i < 64 * 320; i += 512) { const int n = 64 * part + i / 320, k = 2 * (i % 320), tl = n >> 4, ho = n & 15; float v0, v1;
        if (k < KU) { const int sl = k >> 4, hi = k & 15;
            if (sl <= tl) { v0 = Kn[((tl - sl) * 16 + ho) * 16 + hi]; v1 = Kn[((tl - sl) * 16 + ho) * 16 + hi + 1];
                if (sl == tl) { const float dsk = F.d_skip[g * 16 + ho]; if (hi == ho) v0 += dsk; if (hi + 1 == ho) v1 += dsk; } }
            else { v0 = 0.f; v1 = 0.f; } }
        else { const int p = (k - KU) >> 1; const f32x2 c = Cc[ho * 64 + p], a = pw[(tl + 1) * 64 + p]; v0 = c.x * a.x - c.y * a.y; v1 = -(c.x * a.y + c.y * a.x); }
        *(unsigned*)(T2 + ((size_t)(g * 512 + n) * KA2 + k)) = pk2(v0, v1); }
    for (int i = F.tid; i < 16 * 256; i += 512) { const int n1 = 16 * part + (i >> 8), k = 2 * (i & 255), p = n1 >> 1, ri = n1 & 1, sl = k >> 4, hi = k & 15;
        const f32x2 a = pw[(31 - sl) * 64 + p], b0 = Bb[p * 16 + hi], b1 = Bb[p * 16 + hi + 1];
        const float v0 = ri ? (a.x * b0.y + a.y * b0.x) : (a.x * b0.x - a.y * b0.y), v1 = ri ? (a.x * b1.y + a.y * b1.x) : (a.x * b1.x - a.y * b1.y);
        *(unsigned*)(T1 + ((size_t)(g * 256 + n1) * KU + k)) = pk2(v0, v1);
        *(unsigned*)(T1 + ((size_t)(g * 256 + 128 + n1) * KU + k)) = 0u; }
    if (part == 0 && F.tid < 64) { const f32x2 a = pw[32 * 64 + F.tid]; WSP(f32x2, WS_AB32)[g * 64 + F.tid] = a; }
    __syncthreads();
}

__device__ __forceinline__ void p0_prologue(Frame& F) {
    { const int it = 255 - F.blk; if (it < 128) p0_s5_tables(F, it >> 3, 7 - (it & 7)); }
    __syncthreads();
    { u32x4* z = (u32x4*)(WSP(bf16_t, WS_WSR_T) + (size_t)576 * 1024); const int nz = 192 * 1024 * 2 / 16;
      for (int i = F.blk * 512 + F.tid; i < nz; i += F.G * 512) z[i] = (u32x4){0u, 0u, 0u, 0u}; }
    LAS float* scr = (LAS float*)(F.lds + F.wave * 16384);
    const int gw = F.vcu * 8 + F.wave, NGW = F.G * 8;
    constexpr int I0 = 1280, I1 = 512, I2 = 32, I3 = 128, I4 = 128, I5 = 32, I6 = 128;
    constexpr int NITEMS = I0 + I1 + I2 + I3 + I4 + I5 + I6;
    for (int it = gw; it < NITEMS; it += NGW) {
        int r = it;
        if (r < I0) { const int kb = r / 80, nb = r % 80, n0 = 32 * nb;
            const int drow = (n0 < 768 || n0 >= 2304) ? n0 : (n0 < 1536 ? 768 + ((n0 - 768) >> 7) * 256 + ((n0 - 768) & 127) : 768 + ((n0 - 1536) >> 7) * 256 + 128 + ((n0 - 1536) & 127));
            transpose_item(F.w_in, DIN, 64 * kb, n0, WSP(bf16_t, WS_WIN_T), 1024, drow, scr, F.lane); continue; } r -= I0;
        if (r < I1) { const int kb = r / 32, nb = r % 32; transpose_item(F.w_out, 1024, 64 * kb, 32 * nb, WSP(bf16_t, WS_WOUT_T), 1024, 32 * nb, scr, F.lane); continue; } r -= I1;
        if (r < I2) { const int kb = r / 8, nb = r % 8; transpose_item(F.w_glu, 256, 64 * kb, 32 * nb, WSP(bf16_t, WS_WGLU_T), 256, 32 * nb, scr, F.lane); continue; } r -= I2;
        if (r < I3) { const int kb = r / 8, nb = r % 8, n0 = 32 * nb; transpose_item(F.ws1, 256, 64 * kb, n0, WSP(bf16_t, WS_WSR_T), 1024, (n0 >> 7) * 256 + (n0 & 127), scr, F.lane); continue; } r -= I3;
        if (r < I4) { const int kb = r / 8, nb = r % 8, n0 = 32 * nb; transpose_item(F.ws3, 256, 64 * kb, n0, WSP(bf16_t, WS_WSR_T), 1024, (n0 >> 7) * 256 + 128 + (n0 & 127), scr, F.lane); continue; } r -= I4;
        if (r < I5) { const int kb = r / 2, nb = r % 2; transpose_item(F.w_router, 64, 64 * kb, 32 * nb, WSP(bf16_t, WS_WSR_T), 1024, 512 + 32 * nb, scr, F.lane); continue; } r -= I5;
        { const int kb = r / 32, nb = r % 32; transpose_item<1>(F.ws2, 1024, 64 * kb, 32 * nb, WSP(bf16_t, WS_WS2_T), 256, 32 * nb, scr, F.lane); }
    }
}
__device__ __forceinline__ void tr_w2(Frame& F, int ws, int nws) {
    LAS float* scr = (LAS float*)(F.lds + F.wave * 16384);
    for (int r = ws; r < 8192; r += nws) { const int e = r >> 7, q = r & 127, kb = q / 32, nb = q % 32;
        transpose_item<1>(F.w2 + (size_t)e * 256 * 1024, 1024, 64 * kb, 32 * nb, WSP(bf16_t, WS_W2T) + (size_t)e * 1024 * 256, 256, 32 * nb, scr, F.lane); }
}
__device__ __forceinline__ void tr_w13(Frame& F, int ws, int nws) {
    LAS float* scr = (LAS float*)(F.lds + F.wave * 16384);
    for (int r = ws; r < 16384; r += nws) { const int which = r >> 13, rr = r & 8191, e = rr >> 7, q = rr & 127, kb = q / 8, nb = q % 8, n0 = 32 * nb;
        transpose_item((which ? F.w3 : F.w1) + (size_t)e * 1024 * 256, 256, 64 * kb, n0, WSP(bf16_t, WS_W13T) + (size_t)e * 512 * 1024, 1024, (n0 >> 7) * 256 + which * 128 + (n0 & 127), scr, F.lane); }
}

__device__ __forceinline__ void p1_h(Frame& F) {
    const float* mod = WSP(float, WS_MOD); bf16_t* H = WSP(bf16_t, WS_H);
    const int NGW = F.G * 8;
    for (int t0 = F.blk * 8 + F.wave; t0 < T; t0 += 4 * NGW) {
        f32x4 v[4][4]; float ss[4];
#pragma unroll
        for (int q = 0; q < 4; ++q) { const int t = t0 + q * NGW; const f32x4* xr = (const f32x4*)(F.x + (size_t)t * D) + F.lane;
#pragma unroll
            for (int j = 0; j < 4; ++j) v[q][j] = xr[64 * j]; }
#pragma unroll
        for (int q = 0; q < 4; ++q) { float a = 0.f;
#pragma unroll
            for (int j = 0; j < 4; ++j) a += (v[q][j].x * v[q][j].x + v[q][j].y * v[q][j].y) + (v[q][j].z * v[q][j].z + v[q][j].w * v[q][j].w);
            ss[q] = a; }
#pragma unroll
        for (int o = 1; o < 64; o <<= 1) {
#pragma unroll
            for (int q = 0; q < 4; ++q) ss[q] += __shfl_xor(ss[q], o); }
#pragma unroll
        for (int q = 0; q < 4; ++q) { const int t = t0 + q * NGW; const int b = t >> 12; const float rstd = rsqrtf(ss[q] * (1.0f / D) + RMS_EPS);
#pragma unroll
            for (int j = 0; j < 4; ++j) { const int c0 = 4 * F.lane + 256 * j;
                const f32x4 gm = *(const f32x4*)(F.g_mix + c0), sh = *(const f32x4*)(mod + b * 6144 + c0), sc = *(const f32x4*)(mod + b * 6144 + 1024 + c0);
                const f32x4 h = v[q][j] * rstd * gm * (sc + 1.0f) + sh;
                *(u32x2*)(H + (size_t)t * D + c0) = (u32x2){pk2(h.x, h.y), pk2(h.z, h.w)}; } }
    }
}

__device__ __forceinline__ u32x4 pack8(const f32x4 a, const f32x4 b) { return (u32x4){pk2(a.x, a.y), pk2(a.z, a.w), pk2(b.x, b.y), pk2(b.z, b.w)}; }
#define EPI_FOR_ROWS _Pragma("unroll") for (int ai = 0; ai < 2; ++ai) _Pragma("unroll") for (int m = 0; m < 4; ++m)
#define EPI_ROWL (ai * 128 + wr * 64 + m * 16 + fr)

struct SchedG1 { TileOrder o; const char* A; const char* B;
    __device__ __forceinline__ bool next(int i, Unit& u) const { int pm, pn; if (!o.tile(i, pm, pn)) return false; u.pm = pm; u.pn = pn; u.aux = 0; u.rows = nullptr;
        u.A = A + (size_t)pm * 256 * 1024 * 2; u.B = B + (size_t)pn * 256 * 1024 * 2; return true; } };
struct EpiG1 { static constexpr bool PERM = true; bf16_t* projc; bf16_t* A2;
    __device__ __forceinline__ void operator()(const f32x4 (&acc)[2][2][4][2], const Unit& u_in, int wr, int wc, int fr_in, int fq_in) const {
        Unit u = u_in; asm volatile("" : "+s"(u.pm), "+s"(u.pn), "+s"(u.aux)); int fr = fr_in, fq = fq_in; asm volatile("" : "+v"(fr), "+v"(fq));
        EPI_FOR_ROWS { const int row = u.pm * 256 + EPI_ROWL;
            if (u.pn >= 3 && u.pn < 9) { *(u32x4*)(projc + (size_t)row * 1536 + 768 + (u.pn - 3) * 128 + wc * 32 + 8 * fq) = pack8(acc[ai][0][m][0] * acc[ai][1][m][0], acc[ai][0][m][1] * acc[ai][1][m][1]); }
            else {
#pragma unroll
                for (int bj = 0; bj < 2; ++bj) { const int col = bj * 128 + wc * 32 + 8 * fq; const u32x4 w = pack8(acc[ai][bj][m][0], acc[ai][bj][m][1]);
                    if (u.pn < 3) *(u32x4*)(projc + (size_t)row * 1536 + u.pn * 256 + col) = w;
                    else { const int g = col >> 4, hi0 = col & 15, chunk = row >> 5, sl = row & 31; *(u32x4*)(A2 + ((size_t)(g * NCHUNK + chunk) * KA2 + sl * 16 + hi0)) = w; } } } }
    } };

struct SchedS5a { int G, c; const char* A2; const char* T1;
    __device__ __forceinline__ bool next(int i, Unit& u) const { const int L = i * G + c; if (L >= 128) return false; const int g = L >> 3, pm = L & 7; u.pm = pm; u.pn = 0; u.aux = g; u.rows = nullptr;
        u.A = A2 + (size_t)(g * NCHUNK + pm * 256) * KA2 * 2; u.B = T1 + (size_t)g * 256 * KU * 2; return true; } };
struct EpiS5a { static constexpr bool PERM = false; float* S;
    __device__ __forceinline__ void operator()(const f32x4 (&acc)[2][2][4][2], const Unit& u_in, int wr, int wc, int fr_in, int fq_in) const {
        Unit u = u_in; asm volatile("" : "+s"(u.pm), "+s"(u.pn), "+s"(u.aux)); int fr = fr_in, fq = fq_in; asm volatile("" : "+v"(fr), "+v"(fq));
        EPI_FOR_ROWS { const int row = u.pm * 256 + EPI_ROWL;
#pragma unroll
            for (int n = 0; n < 2; ++n) { const int col = wc * 32 + 16 * n + 4 * fq; *(f32x4*)(S + ((size_t)(u.aux * NCHUNK + row) * 128 + col)) = acc[ai][0][m][n]; } }
    } };

struct SchedS5b { int G, c; const char* A2; const char* T2;
    __device__ __forceinline__ bool next(int i, Unit& u) const { const int L = i * G + c; if (L >= 256) return false; const int g = L >> 4, pm = (L >> 1) & 7, pn = L & 1; u.pm = pm; u.pn = pn; u.aux = g; u.rows = nullptr;
        u.A = A2 + (size_t)(g * NCHUNK + pm * 256) * KA2 * 2; u.B = T2 + (size_t)(g * 512 + pn * 256) * KA2 * 2; return true; } };
struct EpiS5b { static constexpr bool PERM = true; bf16_t* ys;
    __device__ __forceinline__ void operator()(const f32x4 (&acc)[2][2][4][2], const Unit& u_in, int wr, int wc, int fr_in, int fq_in) const {
        Unit u = u_in; asm volatile("" : "+s"(u.pm), "+s"(u.pn), "+s"(u.aux)); int fr = fr_in, fq = fq_in; asm volatile("" : "+v"(fr), "+v"(fq));
        EPI_FOR_ROWS { const int chunk = u.pm * 256 + EPI_ROWL;
#pragma unroll
            for (int bj = 0; bj < 2; ++bj) { const int n = u.pn * 256 + bj * 128 + wc * 32 + 8 * fq, tl = n >> 4, ho0 = n & 15; const size_t t = (size_t)chunk * LCH + tl;
                f32x4 a = acc[ai][bj][m][0], b = acc[ai][bj][m][1];
#pragma unroll
                for (int j = 0; j < 4; ++j) { a[j] = gelu_tanh(a[j]); b[j] = gelu_tanh(b[j]); }
                *(u32x4*)(ys + t * 256 + u.aux * 16 + ho0) = pack8(a, b); } }
    } };

struct SchedGlu { int G, c; const char* ys; const char* W;
    __device__ __forceinline__ bool next(int i, Unit& u) const { const int L = i * G + c; if (L >= 256) return false; u.pm = L; u.pn = 0; u.aux = 0; u.rows = nullptr;
        u.A = ys + (size_t)L * 256 * 256 * 2; u.B = W; return true; } };
struct EpiGlu { static constexpr bool PERM = true; const bf16_t* ys; const float* b_glu; const float* g_ssm; bf16_t* ycat; LAS float* scr;
    __device__ __forceinline__ void operator()(f32x4 (&acc)[2][2][4][2], const Unit& u_in, int wr, int wc, int fr_in, int fq_in) const {
        Unit u = u_in; asm volatile("" : "+s"(u.pm), "+s"(u.pn), "+s"(u.aux)); int fr = fr_in, fq = fq_in; asm volatile("" : "+v"(fr), "+v"(fq));
        f32x4 bg[2][2];
#pragma unroll
        for (int bj = 0; bj < 2; ++bj) { const int col = bj * 128 + wc * 32 + 8 * fq; bg[bj][0] = *(const f32x4*)(b_glu + col); bg[bj][1] = *(const f32x4*)(b_glu + col + 4); }
#pragma unroll
        for (int ai = 0; ai < 2; ++ai) {
            u32x4 yw[4][2];
#pragma unroll
            for (int m = 0; m < 4; ++m)
#pragma unroll
                for (int bj = 0; bj < 2; ++bj) yw[m][bj] = *(const u32x4*)(ys + ((size_t)u.pm * 256 + EPI_ROWL) * 256 + bj * 128 + wc * 32 + 8 * fq);
#pragma unroll
            for (int m = 0; m < 4; ++m) { const int rl = EPI_ROWL; float ss = 0.f;
#pragma unroll
                for (int bj = 0; bj < 2; ++bj) { const u32x4 w = yw[m][bj];
                    const f32x4 y0 = (f32x4){bflo(w.x), bfhi(w.x), bflo(w.y), bfhi(w.y)}, y1 = (f32x4){bflo(w.z), bfhi(w.z), bflo(w.w), bfhi(w.w)};
#pragma unroll
                    for (int j = 0; j < 4; ++j) { const float o0 = y0[j] * sigmoidf_(acc[ai][bj][m][0][j] + bg[bj][0][j]), o1 = y1[j] * sigmoidf_(acc[ai][bj][m][1][j] + bg[bj][1][j]);
                        acc[ai][bj][m][0][j] = o0; acc[ai][bj][m][1][j] = o1; ss += o0 * o0 + o1 * o1; } }
                ss += __shfl_xor(ss, 16); ss += __shfl_xor(ss, 32);
                if (fq == 0) scr[rl * 4 + wc] = ss; }
            asm volatile("" ::: "memory"); }
        LDS_WAIT(); __builtin_amdgcn_s_barrier(); asm volatile("" ::: "memory");
        f32x4 gs[2][2];
#pragma unroll
        for (int bj = 0; bj < 2; ++bj) { const int col = bj * 128 + wc * 32 + 8 * fq; gs[bj][0] = *(const f32x4*)(g_ssm + col); gs[bj][1] = *(const f32x4*)(g_ssm + col + 4); }
        EPI_FOR_ROWS { const int rl = EPI_ROWL; const size_t row = (size_t)u.pm * 256 + rl; const f32x4 p = *(const LAS f32x4*)(scr + rl * 4);
            const float rstd = rsqrtf(((p.x + p.y) + (p.z + p.w)) * (1.0f / 256.0f) + RMS_EPS);
#pragma unroll
            for (int bj = 0; bj < 2; ++bj) { const int col = bj * 128 + wc * 32 + 8 * fq;
                *(u32x4*)(ycat + row * 1024 + 768 + col) = pack8(acc[ai][bj][m][0] * rstd * gs[bj][0], acc[ai][bj][m][1] * rstd * gs[bj][1]); } }
        LDS_WAIT(); __builtin_amdgcn_s_barrier(); asm volatile("" ::: "memory");
    } };

struct SchedG2 { int c; const char* A; const char* B;
    __device__ __forceinline__ bool next(int i, Unit& u) const { if (i >= 4 || c >= 256) return false; u.pm = c; u.pn = i; u.aux = 0; u.rows = nullptr;
        u.A = A + (size_t)c * 256 * 1024 * 2; u.B = B + (size_t)i * 256 * 1024 * 2; return true; } };
struct EpiG2 { static constexpr bool PERM = true; const float* x; const float* mod; bf16_t* x1; LAS float* scr;
    __device__ __forceinline__ void operator()(const f32x4 (&acc)[2][2][4][2], const Unit& u_in, int wr, int wc, int fr_in, int fq_in) const {
        Unit u = u_in; asm volatile("" : "+s"(u.pm), "+s"(u.pn), "+s"(u.aux)); int fr = fr_in, fq = fq_in; asm volatile("" : "+v"(fr), "+v"(fq));
        const int b = u.pm >> 4;
        const char* xb = (const char*)(x + (size_t)u.pm * 256 * 1024 + u.pn * 256);
        char* ob = (char*)(x1 + (size_t)u.pm * 256 * 1024 + u.pn * 256);
        const char* gb = (const char*)(mod + b * 6144 + 2048 + u.pn * 256);
        const unsigned lcol = (unsigned)(wc * 32 + 8 * fq);
#pragma unroll
        for (int ai = 0; ai < 2; ++ai) {
            f32x4 xv[4][2][2], gt[2][2];
#pragma unroll
            for (int m = 0; m < 4; ++m)
#pragma unroll
                for (int bj = 0; bj < 2; ++bj) { const unsigned off = ((unsigned)EPI_ROWL * 1024u + bj * 128u + lcol) * 4u; xv[m][bj][0] = *(const f32x4*)(xb + off); xv[m][bj][1] = *(const f32x4*)(xb + off + 16); }
#pragma unroll
            for (int bj = 0; bj < 2; ++bj) { const unsigned off = (bj * 128u + lcol) * 4u; gt[bj][0] = *(const f32x4*)(gb + off); gt[bj][1] = *(const f32x4*)(gb + off + 16); }
#pragma unroll
            for (int m = 0; m < 4; ++m) { const int rl = EPI_ROWL; float ss = 0.f;
#pragma unroll
                for (int bj = 0; bj < 2; ++bj) { const unsigned off = ((unsigned)rl * 1024u + bj * 128u + lcol) * 2u;
                    const f32x4 o0 = xv[m][bj][0] + gt[bj][0] * acc[ai][bj][m][0], o1 = xv[m][bj][1] + gt[bj][1] * acc[ai][bj][m][1];
                    ss += (o0.x * o0.x + o0.y * o0.y) + (o0.z * o0.z + o0.w * o0.w) + (o1.x * o1.x + o1.y * o1.y) + (o1.z * o1.z + o1.w * o1.w);
                    *(u32x4*)(ob + off) = pack8(o0, o1); }
                ss += __shfl_xor(ss, 16); ss += __shfl_xor(ss, 32);
                if (fq == 0) scr[rl * 16 + u.pn * 4 + wc] = ss; }
            asm volatile("" ::: "memory"); }
    } };

struct SchedRS { TileOrder o; const char* A; const char* B;
    __device__ __forceinline__ bool next(int i, Unit& u) const { int pm, pn; if (!o.tile(i, pm, pn)) return false; u.pm = pm; u.pn = pn; u.aux = 0; u.rows = nullptr;
        u.A = A + (size_t)pm * 256 * 1024 * 2; u.B = B + (size_t)pn * 256 * 1024 * 2; return true; } };
struct EpiRS { static constexpr bool PERM = true; bf16_t* acts; float* logits;
    __device__ __forceinline__ void operator()(const f32x4 (&acc)[2][2][4][2], const Unit& u_in, int wr, int wc, int fr_in, int fq_in) const {
        Unit u = u_in; asm volatile("" : "+s"(u.pm), "+s"(u.pn), "+s"(u.aux)); int fr = fr_in, fq = fq_in; asm volatile("" : "+v"(fr), "+v"(fq));
        EPI_FOR_ROWS { const size_t row = (size_t)u.pm * 256 + EPI_ROWL;
            if (u.pn < 2) { f32x4 o0, o1;
#pragma unroll
                for (int j = 0; j < 4; ++j) { o0[j] = siluf_(acc[ai][0][m][0][j]) * acc[ai][1][m][0][j]; o1[j] = siluf_(acc[ai][0][m][1][j]) * acc[ai][1][m][1][j]; }
                *(u32x4*)(acts + row * 256 + u.pn * 128 + wc * 32 + 8 * fq) = pack8(o0, o1); }
            else if (wc < 2) { const int col = wc * 32 + 8 * fq; *(f32x4*)(logits + row * 64 + col) = acc[ai][0][m][0]; *(f32x4*)(logits + row * 64 + col + 4) = acc[ai][0][m][1]; } }
    } };

struct SchedUp { int G, c, nblk; const int* blk_e; const int* tok; const char* H2; const char* W13;
    __device__ __forceinline__ bool next(int i, Unit& u) const { const int L = i * G + c; if (L >= 2 * nblk) return false; const int j = L >> 1, h = L & 1;
        const int e = __builtin_amdgcn_readfirstlane(ld_i32_agent(blk_e + j)); u.pm = j; u.pn = h; u.aux = e; u.rows = tok + 2 * j * 256; u.A = H2; u.B = W13 + (size_t)(e * 2 + h) * 256 * 1024 * 2; return true; } };
struct EpiUp { static constexpr bool PERM = true; bf16_t* act;
    __device__ __forceinline__ void operator()(const f32x4 (&acc)[2][2][4][2], const Unit& u_in, int wr, int wc, int fr_in, int fq_in) const {
        Unit u = u_in; asm volatile("" : "+s"(u.pm), "+s"(u.pn), "+s"(u.aux)); int fr = fr_in, fq = fq_in; asm volatile("" : "+v"(fr), "+v"(fq));
        EPI_FOR_ROWS { const size_t row = (size_t)u.pm * 256 + EPI_ROWL; f32x4 o0, o1;
#pragma unroll
            for (int j = 0; j < 4; ++j) { o0[j] = siluf_(acc[ai][0][m][0][j]) * acc[ai][1][m][0][j]; o1[j] = siluf_(acc[ai][0][m][1][j]) * acc[ai][1][m][1][j]; }
            *(u32x4*)(act + row * 256 + u.pn * 128 + wc * 32 + 8 * fq) = pack8(o0, o1); }
    } };

struct SchedDown { int G, c, nblk; const int* blk_e; const char* act; const char* acts; const char* W2; const char* WS2;
    __device__ __forceinline__ bool next(int i, Unit& u) const { const int L = i * G + c; u.rows = nullptr;
        if (L < 4 * nblk) { const int j = L >> 2, pn = L & 3; const int e = __builtin_amdgcn_readfirstlane(ld_i32_agent(blk_e + j)); u.pm = j; u.pn = pn; u.aux = 0;
            u.A = act + (size_t)j * 256 * 256 * 2; u.B = W2 + (size_t)(e * 1024 + pn * 256) * 256 * 2; return true; }
        const int L2 = L - 4 * nblk; if (L2 >= 1024) return false; u.pm = L2 >> 2; u.pn = L2 & 3; u.aux = 1;
        u.A = acts + (size_t)u.pm * 256 * 256 * 2; u.B = WS2 + (size_t)u.pn * 256 * 256 * 2; return true; } };
struct EpiDown { static constexpr bool PERM = true; const u32x2* rec; unsigned char* Y8;
    __device__ __forceinline__ void operator()(const f32x4 (&acc)[2][2][4][2], const Unit& u_in, int wr, int wc, int fr_in, int fq_in) const {
        Unit u = u_in; asm volatile("" : "+s"(u.pm), "+s"(u.pn), "+s"(u.aux)); int fr = fr_in, fq = fq_in; asm volatile("" : "+v"(fr), "+v"(fq));
        const int col0 = u.pn * 256 + wc * 64 + fq * 16;
        if (u.aux == 0) {
            int dd[2][4]; float ww[2][4]; unsigned du[2][4], wu[2][4];
            EPI_FOR_ROWS { const unsigned* rp = (const unsigned*)rec + 2 * (u.pm * 256 + EPI_ROWL); du[ai][m] = rp[0]; wu[ai][m] = rp[1]; }
            EPI_FOR_ROWS { asm volatile("" : "+v"(du[ai][m]), "+v"(wu[ai][m])); dd[ai][m] = (int)du[ai][m]; ww[ai][m] = __builtin_bit_cast(float, wu[ai][m]) * 16.0f; }
            EPI_FOR_ROWS { const int d = dd[ai][m]; const float wt = ww[ai][m];
                if (d >= 0) { const int tok = d & 0xffff, k = d >> 16; u32x4 w;
#pragma unroll
                    for (int q = 0; q < 4; ++q) { const f32x4 v = acc[ai][q >> 1][m][q & 1] * wt; int pk = 0;
                        pk = __builtin_amdgcn_cvt_pk_fp8_f32(v.x, v.y, pk, false); pk = __builtin_amdgcn_cvt_pk_fp8_f32(v.z, v.w, pk, true); w[q] = (unsigned)pk; }
                    *(u32x4*)(Y8 + ((size_t)tok * NSLOT + k) * 1024 + col0) = w; } }
        } else {
            EPI_FOR_ROWS { const size_t row = (size_t)u.pm * 256 + EPI_ROWL; u32x4 w;
#pragma unroll
                for (int q = 0; q < 4; ++q) { const f32x4 v = acc[ai][q >> 1][m][q & 1] * 16.0f; int pk = 0;
                    pk = __builtin_amdgcn_cvt_pk_fp8_f32(v.x, v.y, pk, false); pk = __builtin_amdgcn_cvt_pk_fp8_f32(v.z, v.w, pk, true); w[q] = (unsigned)pk; }
                *(u32x4*)(Y8 + (row * NSLOT + 6) * 1024 + col0) = w; }
        }
    } };

__device__ __forceinline__ void p3_conv(Frame& F) {
    const bf16_t* P = WSP(bf16_t, WS_PROJC); bf16_t* Y = WSP(bf16_t, WS_YCAT);
    for (int chunk = F.blk * 8 + F.wave; chunk < NCHUNK; chunk += F.G * 8) {
        const int t0 = chunk * LCH;
        f32x4 w0[3], w1[3], w2[3], cb[3], gc[3], z1[3], z2[3];
#pragma unroll
        for (int j = 0; j < 3; ++j) { const int c0 = 4 * F.lane + 256 * j;
            w0[j] = *(const f32x4*)(F.conv_w + c0); w1[j] = *(const f32x4*)(F.conv_w + DCONV + c0); w2[j] = *(const f32x4*)(F.conv_w + 2 * DCONV + c0);
            cb[j] = *(const f32x4*)(F.conv_b + c0); gc[j] = *(const f32x4*)(F.g_conv + c0); z1[j] = (f32x4){0.f, 0.f, 0.f, 0.f}; z2[j] = z1[j]; }
        if ((t0 & (SEQ - 1)) != 0) {
#pragma unroll
            for (int j = 0; j < 3; ++j) { const int c0 = 4 * F.lane + 256 * j;
                const u32x2 za = *(const u32x2*)(P + (size_t)(t0 - 2) * 1536 + 768 + c0), zb = *(const u32x2*)(P + (size_t)(t0 - 1) * 1536 + 768 + c0);
                z2[j] = (f32x4){bflo(za.x), bfhi(za.x), bflo(za.y), bfhi(za.y)}; z1[j] = (f32x4){bflo(zb.x), bfhi(zb.x), bflo(zb.y), bfhi(zb.y)}; }
        }
        for (int tt = 0; tt < LCH; tt += 4) {
            u32x2 bw[4][3], zw[4][3];
#pragma unroll
            for (int q = 0; q < 4; ++q) { const size_t t = (size_t)t0 + tt + q;
#pragma unroll
                for (int j = 0; j < 3; ++j) { const int c0 = 4 * F.lane + 256 * j; bw[q][j] = *(const u32x2*)(P + t * 1536 + c0); zw[q][j] = *(const u32x2*)(P + t * 1536 + 768 + c0); } }
            f32x4 val[4][3]; float ss[4];
#pragma unroll
            for (int q = 0; q < 4; ++q) { float a = 0.f;
#pragma unroll
                for (int j = 0; j < 3; ++j) {
                    const f32x4 bg = (f32x4){bflo(bw[q][j].x), bfhi(bw[q][j].x), bflo(bw[q][j].y), bfhi(bw[q][j].y)};
                    const f32x4 z = (f32x4){bflo(zw[q][j].x), bfhi(zw[q][j].x), bflo(zw[q][j].y), bfhi(zw[q][j].y)};
                    val[q][j] = bg * (w0[j] * z2[j] + w1[j] * z1[j] + w2[j] * z + cb[j]); z2[j] = z1[j]; z1[j] = z;
                    a += (val[q][j].x * val[q][j].x + val[q][j].y * val[q][j].y) + (val[q][j].z * val[q][j].z + val[q][j].w * val[q][j].w); }
                ss[q] = a; }
#pragma unroll
            for (int o = 1; o < 64; o <<= 1) {
#pragma unroll
                for (int q = 0; q < 4; ++q) ss[q] += __shfl_xor(ss[q], o); }
#pragma unroll
            for (int q = 0; q < 4; ++q) { const size_t t = (size_t)t0 + tt + q; const float rstd = rsqrtf(ss[q] * (1.0f / DCONV) + RMS_EPS);
#pragma unroll
                for (int j = 0; j < 3; ++j) { const int c0 = 4 * F.lane + 256 * j; const f32x4 o = val[q][j] * rstd * gc[j];
                    *(u32x2*)(Y + t * 1024 + c0) = (u32x2){pk2(o.x, o.y), pk2(o.z, o.w)}; } }
        }
    }
}

__device__ __forceinline__ void p4_scan(Frame& F) {
    if (F.wave != 0) return;
    const float* S = WSP(float, WS_S); bf16_t* A2 = WSP(bf16_t, WS_A2);
    for (int bg = F.blk; bg < NB * NG; bg += F.G) { const int b = bg >> 4, g = bg & 15, p = F.lane;
        const f32x2 a = WSP(f32x2, WS_AB32)[g * 64 + p]; float xr = 0.f, xi = 0.f;
#pragma unroll 8
        for (int c = 0; c < 128; ++c) { const size_t chunk = (size_t)g * NCHUNK + b * 128 + c;
            *(unsigned*)(A2 + chunk * KA2 + KU + 2 * p) = pk2(xr, xi);
            const f32x2 s = *(const f32x2*)(S + chunk * 128 + 2 * p);
            const float nr = a.x * xr - a.y * xi + s.x, ni = a.x * xi + a.y * xr + s.y; xr = nr; xi = ni; }
    }
}

__device__ __forceinline__ void p7_post(Frame& F) {
    const float* mod = WSP(float, WS_MOD); const bf16_t* X1 = WSP(bf16_t, WS_X1); bf16_t* H2 = WSP(bf16_t, WS_H2);
    LAS float* scr = (LAS float*)(F.lds + EPI_OFF);
    VM_WAIT(); LDS_WAIT(); __syncthreads();
    if (F.blk >= 256) return;
    const int b = F.blk >> 4;
    f32x4 gf[4], sh[4], sc[4];
#pragma unroll
    for (int j = 0; j < 4; ++j) { const int c0 = 4 * F.lane + 256 * j; gf[j] = *(const f32x4*)(F.g_ffn + c0); sh[j] = *(const f32x4*)(mod + b * 6144 + 3072 + c0); sc[j] = *(const f32x4*)(mod + b * 6144 + 4096 + c0) + 1.0f; gf[j] = gf[j] * sc[j]; }
    for (int i = 0; i < 32; i += 4) {
        u32x2 xw[4][4]; float rstd[4];
#pragma unroll
        for (int q = 0; q < 4; ++q) { const int rl = F.wave * 32 + i + q; const size_t row = (size_t)F.blk * 256 + rl;
#pragma unroll
            for (int j = 0; j < 4; ++j) xw[q][j] = *(const u32x2*)(X1 + row * 1024 + 4 * F.lane + 256 * j);
            float tot = 0.f;
#pragma unroll
            for (int p = 0; p < 4; ++p) { const f32x4 pq = *(const LAS f32x4*)(scr + rl * 16 + 4 * p); tot += (pq.x + pq.y) + (pq.z + pq.w); }
            rstd[q] = rsqrtf(tot * (1.0f / D) + RMS_EPS); }
#pragma unroll
        for (int q = 0; q < 4; ++q) { const size_t row = (size_t)F.blk * 256 + F.wave * 32 + i + q;
#pragma unroll
            for (int j = 0; j < 4; ++j) { const int c0 = 4 * F.lane + 256 * j;
                const f32x4 xv = (f32x4){bflo(xw[q][j].x), bfhi(xw[q][j].x), bflo(xw[q][j].y), bfhi(xw[q][j].y)};
                const f32x4 h = xv * rstd[q] * gf[j] + sh[j];
                *(u32x2*)(H2 + row * 1024 + c0) = (u32x2){pk2(h.x, h.y), pk2(h.z, h.w)}; } }
    }
}

__device__ __forceinline__ void p9_topk(Frame& F) {
    const float* LG = WSP(float, WS_LOGITS); unsigned char* R = F.ws + WS_ROUTE;
    int* sele = (int*)(R + RT_SELE); float* selw = (float*)(R + RT_SELW); int* cntw = (int*)(R + RT_CNTW); int* cntb = (int*)(R + RT_CNTB);
    u32x2* rec = (u32x2*)(R + RT_REC);
    LAS int* lcnt = (LAS int*)F.lds;
    const float NEG = -INFINITY;
    for (int blk = F.blk; blk < 256; blk += F.G) {
        for (int i = F.tid; i < MAXBLK; i += 512) rec[blk * MAXBLK + i] = (u32x2){0xffffffffu, 0u};
        if (F.wave < 4) {
            const int tok = blk * 256 + F.tid;
            float s[64], bb[64];
#pragma unroll
            for (int q = 0; q < 16; ++q) { const f32x4 lg = *(const f32x4*)(LG + (size_t)tok * 64 + 4 * q);
#pragma unroll
                for (int j = 0; j < 4; ++j) { s[4 * q + j] = sigmoidf_(lg[j]); bb[4 * q + j] = s[4 * q + j] + F.router_bias[4 * q + j]; } }
            float gs[8];
#pragma unroll
            for (int g = 0; g < 8; ++g) { float m1 = NEG, m2 = NEG;
#pragma unroll
                for (int j = 0; j < 8; ++j) { const float v = bb[8 * g + j]; if (v > m1) { m2 = m1; m1 = v; } else if (v > m2) { m2 = v; } }
                gs[g] = m1 + m2; }
            unsigned gsel = 0u;
#pragma unroll
            for (int g = 0; g < 8; ++g) { int rk = 0;
#pragma unroll
                for (int g2 = 0; g2 < 8; ++g2) rk += (gs[g2] > gs[g] || (gs[g2] == gs[g] && g2 < g)) ? 1 : 0;
                gsel |= (rk < 4) ? (1u << g) : 0u; }
#pragma unroll
            for (int e = 0; e < 64; ++e) bb[e] = ((gsel >> (e >> 3)) & 1u) ? bb[e] : NEG;
            int ek[6]; float sk[6]; unsigned long long taken = 0ull; float ssum = 0.f;
#pragma unroll
            for (int k = 0; k < 6; ++k) { float best = NEG, bs = 0.f; int bi = 0;
#pragma unroll
                for (int e = 0; e < 64; ++e) { const bool c = (((taken >> e) & 1ull) == 0ull) && (bb[e] > best); best = c ? bb[e] : best; bs = c ? s[e] : bs; bi = c ? e : bi; }
                ek[k] = bi; sk[k] = bs; taken |= 1ull << bi; ssum += bs; }
            int rk[6] = {0, 0, 0, 0, 0, 0}; int mycnt = 0;
#pragma unroll
            for (int e = 0; e < 64; ++e) { const bool hit = ((taken >> e) & 1ull) != 0ull; const unsigned long long m = __ballot(hit);
                const int pre = __builtin_amdgcn_mbcnt_hi((unsigned)(m >> 32), __builtin_amdgcn_mbcnt_lo((unsigned)m, 0u));
#pragma unroll
                for (int k = 0; k < 6; ++k) rk[k] = (ek[k] == e) ? pre : rk[k];
                mycnt = (F.lane == e) ? __popcll(m) : mycnt; }
            const float inv = 2.5f / ssum;
#pragma unroll
            for (int k = 0; k < 6; ++k) { sele[(size_t)tok * 6 + k] = ek[k] | (rk[k] << 8); selw[(size_t)tok * 6 + k] = sk[k] * inv; }
            cntw[(blk * 4 + F.wave) * 64 + F.lane] = mycnt; lcnt[F.wave * 64 + F.lane] = mycnt;
        }
        else if (blk == F.blk) tr_w13(F, F.vcu * 4 + (F.wave - 4), F.G * 4);
        __syncthreads();
        if (F.tid < 64) cntb[blk * 64 + F.tid] = (lcnt[F.tid] + lcnt[64 + F.tid]) + (lcnt[128 + F.tid] + lcnt[192 + F.tid]);
        __syncthreads();
    }
}

__device__ __forceinline__ void p10_scatter(Frame& F) {
    unsigned char* R = F.ws + WS_ROUTE;
    const int* sele = (const int*)(R + RT_SELE); const float* selw = (const float*)(R + RT_SELW); const int* cntw = (const int*)(R + RT_CNTW); const int* cntb = (const int*)(R + RT_CNTB);
    u32x2* rec = (u32x2*)(R + RT_REC);
    LAS int* ptot = (LAS int*)F.lds; LAS int* ppre = ptot + 512; LAS int* pst = ppre + 512; LAS int* pad = pst + 64; LAS int* base = pad + 64;
    for (int blk = F.blk; blk < 256; blk += F.G) {
        { const int p8 = F.tid >> 6, e = F.tid & 63; int tot = 0, pre = 0;
          for (int b2 = 32 * p8; b2 < 32 * p8 + 32; ++b2) { const int c = cntb[b2 * 64 + e]; tot += c; pre += (b2 < blk) ? c : 0; }
          ptot[p8 * 64 + e] = tot; ppre[p8 * 64 + e] = pre; }
        __syncthreads();
        if (F.tid < 64) { const int e = F.tid; int total = 0, bb = 0;
#pragma unroll
            for (int q = 0; q < 8; ++q) { total += ptot[q * 64 + e]; bb += ppre[q * 64 + e]; }
            const int padded = (total + 255) & ~255; int v = padded;
#pragma unroll
            for (int o = 1; o < 64; o <<= 1) { const int tv = __shfl_up(v, o); if (e >= o) v += tv; }
            const int pstart = v - padded; pst[e] = pstart; pad[e] = padded;
            int run = pstart + bb;
#pragma unroll
            for (int w = 0; w < 4; ++w) { base[w * 64 + e] = run; run += cntw[(blk * 4 + w) * 64 + e]; }
            if (blk == 0 && e == 63) { const int nblk = (pstart + padded) >> 8; __hip_atomic_store(WSP(int, WS_CTL) + CW_NBLK, nblk, __ATOMIC_RELAXED, __HIP_MEMORY_SCOPE_AGENT); } }
        __syncthreads();
        for (int a = F.tid; a < 256 * TOPK; a += 512) { const int tl = a / 6, k = a - tl * 6, tok = blk * 256 + tl, w = tl >> 6;
            const int se = sele[(size_t)tok * 6 + k]; const int e = se & 255, r = se >> 8; const int dest = base[w * 64 + e] + r;
            rec[dest] = (u32x2){(unsigned)(tok | (k << 16)), __builtin_bit_cast(unsigned, selw[(size_t)tok * 6 + k])}; }
        { const int nblk = (pst[63] + pad[63]) >> 8; int* blke = WSP(int, WS_BLKE);
            if (F.tid < 8) { const int j = blk * 8 + F.tid; if (j < nblk) { const int r0 = j * 256; int e = 0;
                for (int q = 0; q < 64; ++q) if (pad[q] > 0 && pst[q] <= r0 && r0 < pst[q] + pad[q]) e = q;
                blke[j] = e; } } }
        __syncthreads();
    }
}

__device__ __forceinline__ void p13_final(Frame& F) {
    const float* mod = WSP(float, WS_MOD); const bf16_t* X1 = WSP(bf16_t, WS_X1); const unsigned char* Y8 = F.ws + WS_Y4;
    const int NGW = F.G * 8, c0 = 16 * F.lane;
    for (int t0 = F.blk * 8 + F.wave; t0 < T; t0 += 2 * NGW) {
        u32x4 yw[2][NSLOT], xw[2][2];
#pragma unroll
        for (int q = 0; q < 2; ++q) { const size_t t = (size_t)t0 + (size_t)q * NGW;
#pragma unroll
            for (int k = 0; k < NSLOT; ++k) yw[q][k] = *(const u32x4*)(Y8 + (t * NSLOT + k) * 1024 + c0);
            xw[q][0] = *(const u32x4*)(X1 + t * 1024 + c0); xw[q][1] = *(const u32x4*)(X1 + t * 1024 + c0 + 8); }
        f32x4 v[2][4]; float ss[2];
#pragma unroll
        for (int q = 0; q < 2; ++q) { const int b = (t0 + q * NGW) >> 12; float a = 0.f;
#pragma unroll
            for (int j = 0; j < 4; ++j) { f32x4 ys = (f32x4){0.f, 0.f, 0.f, 0.f};
#pragma unroll
                for (int k = 0; k < NSLOT; ++k) { const f32x2 lo = __builtin_amdgcn_cvt_pk_f32_fp8((int)yw[q][k][j], false), hi = __builtin_amdgcn_cvt_pk_f32_fp8((int)yw[q][k][j], true);
                    ys += (f32x4){lo.x, lo.y, hi.x, hi.y}; }
                const f32x4 g2 = *(const f32x4*)(mod + b * 6144 + 5120 + c0 + 4 * j) * 0.0625f;
                const unsigned w0 = xw[q][j >> 1][(j & 1) * 2], w1 = xw[q][j >> 1][(j & 1) * 2 + 1];
                v[q][j] = (f32x4){bflo(w0), bfhi(w0), bflo(w1), bfhi(w1)} + g2 * ys;
                a += (v[q][j].x * v[q][j].x + v[q][j].y * v[q][j].y) + (v[q][j].z * v[q][j].z + v[q][j].w * v[q][j].w); }
            ss[q] = a; }
#pragma unroll
        for (int o = 1; o < 64; o <<= 1) { ss[0] += __shfl_xor(ss[0], o); ss[1] += __shfl_xor(ss[1], o); }
#pragma unroll
        for (int q = 0; q < 2; ++q) { const size_t t = (size_t)t0 + (size_t)q * NGW; const float rstd = rsqrtf(ss[q] * (1.0f / D) + RMS_EPS);
#pragma unroll
            for (int j = 0; j < 4; ++j) { const f32x4 gf = *(const f32x4*)(F.g_final + c0 + 4 * j);
                *(f32x4*)(F.out + t * 1024 + c0 + 4 * j) = v[q][j] * rstd * gf; } }
    }
}

#ifndef STAGGER
#define STAGGER 0
#endif
__device__ __forceinline__ void phase_stagger(Frame& F, int unit_ticks) {
#if STAGGER
    const unsigned long long t0 = __builtin_amdgcn_s_memrealtime(); const unsigned long long wait = (unsigned long long)(((F.blk >> 3) & 3) * unit_ticks / 4);
    while (__builtin_amdgcn_s_memrealtime() - t0 < wait) __builtin_amdgcn_s_sleep(16);
#endif
}
constexpr int N_PHASES = 14;
template <int K> __device__ __forceinline__ void run_phase(Frame& F) {
    LAS unsigned char* ring = F.lds; LAS float* escr = (LAS float*)(F.lds + EPI_OFF);
    if constexpr (K == 0) { if (F.blk < 192) p0_mod(F); }
    if constexpr (K == 1) { p0_prologue(F); p1_h(F); }
    if constexpr (K == 2) {
        SchedG1 S; S.o.init(256, 10, F.G, F.blk); S.A = (const char*)WSP(bf16_t, WS_H); S.B = (const char*)WSP(bf16_t, WS_WIN_T);
        EpiG1 E{WSP(bf16_t, WS_PROJC), WSP(bf16_t, WS_A2)};
        phase_stagger(F, 2800);
        pg8::gemm_phase<EpiG1, SchedG1, false, false>(ring, pg8::Desc{1024, 1024, 1024}, S, E);
    }
    if constexpr (K == 3) {
        p3_conv(F); __syncthreads();
        SchedS5a S{F.G, F.blk, (const char*)WSP(bf16_t, WS_A2), (const char*)WSP(bf16_t, WS_T1)}; EpiS5a E{WSP(float, WS_S)};
        pg8::gemm_phase<EpiS5a, SchedS5a, false, false>(ring, pg8::Desc{KA2, KU, KU}, S, E);
    }
    if constexpr (K == 4) { if (F.wave == 0) p4_scan(F); else tr_w2(F, F.vcu * 7 + (F.wave - 1), F.G * 7); }
    if constexpr (K == 5) {
        SchedS5b S{F.G, F.blk, (const char*)WSP(bf16_t, WS_A2), (const char*)WSP(bf16_t, WS_T2)}; EpiS5b E{WSP(bf16_t, WS_YS)};
        pg8::gemm_phase<EpiS5b, SchedS5b, false, false>(ring, pg8::Desc{KA2, KA2, KA2}, S, E);
    }
    if constexpr (K == 6) {
        SchedGlu S{F.G, F.blk, (const char*)WSP(bf16_t, WS_YS), (const char*)WSP(bf16_t, WS_WGLU_T)};
        EpiGlu E{WSP(bf16_t, WS_YS), F.b_glu, F.g_ssm, WSP(bf16_t, WS_YCAT), escr};
        pg8::gemm_phase<EpiGlu, SchedGlu, false, true>(ring, pg8::Desc{256, 256, 256}, S, E);
    }
    if constexpr (K == 7) {
        SchedG2 S{F.blk, (const char*)WSP(bf16_t, WS_YCAT), (const char*)WSP(bf16_t, WS_WOUT_T)};
        EpiG2 E{F.x, WSP(float, WS_MOD), WSP(bf16_t, WS_X1), escr};
        pg8::gemm_phase<EpiG2, SchedG2, false, false>(ring, pg8::Desc{1024, 1024, 1024}, S, E);
        p7_post(F);
    }
    if constexpr (K == 8) {
        SchedRS S; S.o.init(256, 3, F.G, F.blk); S.A = (const char*)WSP(bf16_t, WS_H2); S.B = (const char*)WSP(bf16_t, WS_WSR_T);
        EpiRS E{WSP(bf16_t, WS_ACTS), WSP(float, WS_LOGITS)};
        pg8::gemm_phase<EpiRS, SchedRS, false, false>(ring, pg8::Desc{1024, 1024, 1024}, S, E);
    }
    if constexpr (K == 9) { p9_topk(F); }
    if constexpr (K == 10) { p10_scatter(F); }
    if constexpr (K == 11) {
        const int nblk = __builtin_amdgcn_readfirstlane(ld_i32_agent(WSP(int, WS_CTL) + CW_NBLK));
        SchedUp S{F.G, F.vcu, nblk, WSP(int, WS_BLKE), (const int*)(F.ws + WS_ROUTE + RT_REC), (const char*)WSP(bf16_t, WS_H2), (const char*)WSP(bf16_t, WS_W13T)};
        EpiUp E{WSP(bf16_t, WS_ACT)};
        phase_stagger(F, 2800);
        pg8::gemm_phase<EpiUp, SchedUp, true, false>(ring, pg8::Desc{1024, 1024, 1024}, S, E);
    }
    if constexpr (K == 12) {
        const int nblk = __builtin_amdgcn_readfirstlane(ld_i32_agent(WSP(int, WS_CTL) + CW_NBLK));
        SchedDown S{F.G, F.vcu, nblk, WSP(int, WS_BLKE), (const char*)WSP(bf16_t, WS_ACT), (const char*)WSP(bf16_t, WS_ACTS), (const char*)WSP(bf16_t, WS_W2T), (const char*)WSP(bf16_t, WS_WS2_T)};
        EpiDown E{(const u32x2*)(F.ws + WS_ROUTE + RT_REC), F.ws + WS_Y4};
        phase_stagger(F, 900);
        pg8::gemm_phase<EpiDown, SchedDown, false, false>(ring, pg8::Desc{256, 256, 256}, S, E);
    }
    if constexpr (K == 13) { p13_final(F); }
}
#ifndef REP_PHASE
#define REP_PHASE -1
#endif
#ifndef PH_MASK
#define PH_MASK 0xFFFF
#endif
#ifndef USE_CG_FIRST
#define USE_CG_FIRST 0
#endif
template <int K> __device__ __forceinline__ void grid_sync(Frame& F) {
#if MK_N_LAUNCHES == 1
    if constexpr (K == 0 && USE_CG_FIRST) cg::this_grid().sync(); else xcd_barrier(F.bar);
#endif
}
template <int K> __device__ __forceinline__ void phase_and_seam(Frame& F, int lo, int hi) {
    if (((PH_MASK >> K) & 1) && lo <= K && K < hi) {
        run_phase<K>(F);
        if constexpr (K == REP_PHASE) { grid_sync<K>(F); run_phase<K>(F); }
        if (K + 1 < hi) grid_sync<K>(F);
    }
}
__global__ void __launch_bounds__(512, 2) mk_fwd(Args args) {
    extern __shared__ __attribute__((aligned(16))) unsigned char lds_raw[];
    Frame F;
    F.lds = (LAS unsigned char*)lds_raw; F.tid = threadIdx.x; F.lane = F.tid & 63; F.wave = __builtin_amdgcn_readfirstlane(F.tid >> 6);
    F.blk = blockIdx.x; F.G = gridDim.x; F.vcu = (F.G % 8 == 0) ? (F.blk % 8) * (F.G / 8) + F.blk / 8 : F.blk;
    { const float* const* in = args.in;
      F.x = in[0]; F.c = in[1]; F.w_ada = in[2]; F.b_ada = in[3]; F.g_mix = in[4]; F.w_in = in[5]; F.conv_w = in[6]; F.conv_b = in[7]; F.g_conv = in[8];
      F.lam_re = in[9]; F.lam_im = in[10]; F.log_dt = in[11]; F.b_re = in[12]; F.b_im = in[13]; F.c_re = in[14]; F.c_im = in[15]; F.d_skip = in[16];
      F.w_glu = in[17]; F.b_glu = in[18]; F.g_ssm = in[19]; F.w_out = in[20]; F.g_ffn = in[21]; F.w_router = in[22]; F.router_bias = in[23];
      F.w1 = in[24]; F.w3 = in[25]; F.w2 = in[26]; F.ws1 = in[27]; F.ws3 = in[28]; F.ws2 = in[29]; F.g_final = in[30]; }
    F.out = args.out; F.ws = args.ws;
    const int lo = args.ph_lo, hi = args.ph_hi;
    if (F.tid < 64) ((LAS unsigned*)(F.lds + MISC_OFF))[F.tid] = 0u;
    __syncthreads();
    F.bar = xcd_barrier_post((unsigned*)(F.ws + WS_CTL) + CW_BAR, (volatile LAS unsigned*)(F.lds + MISC_OFF) + 8);
    phase_and_seam<0>(F, lo, hi); phase_and_seam<1>(F, lo, hi); phase_and_seam<2>(F, lo, hi); phase_and_seam<3>(F, lo, hi);
    phase_and_seam<4>(F, lo, hi); phase_and_seam<5>(F, lo, hi); phase_and_seam<6>(F, lo, hi); phase_and_seam<7>(F, lo, hi);
    phase_and_seam<8>(F, lo, hi); phase_and_seam<9>(F, lo, hi); phase_and_seam<10>(F, lo, hi); phase_and_seam<11>(F, lo, hi);
    phase_and_seam<12>(F, lo, hi); phase_and_seam<13>(F, lo, hi);
}

extern "C" void kernel_launch(void* const* d_in, const int* in_sizes, int n_in, void* d_out, int out_size, void* d_ws, size_t ws_size, hipStream_t stream) {
    static int grid = 0;
    if (grid == 0) {
        if (n_in != 31 || in_sizes[0] != T * D || out_size != T * D || ws_size < WS_END) { fprintf(stderr, "kernel_launch: unexpected shapes (n_in %d, in0 %d, out %d, ws %zu)\n", n_in, n_in > 0 ? in_sizes[0] : -1, out_size, ws_size); grid = -1; return; }
        int dev = 0, cus = 0, per_cu = 0;
        if (hipGetDevice(&dev) != hipSuccess || hipDeviceGetAttribute(&cus, hipDeviceAttributeMultiprocessorCount, dev) != hipSuccess) { grid = -1; return; }
        if (hipFuncSetAttribute((const void*)mk_fwd, hipFuncAttributeMaxDynamicSharedMemorySize, LDS_BYTES) != hipSuccess) { fprintf(stderr, "kernel_launch: hipFuncSetAttribute failed\n"); grid = -1; return; }
        if (hipOccupancyMaxActiveBlocksPerMultiprocessor(&per_cu, (const void*)mk_fwd, 512, LDS_BYTES) != hipSuccess || per_cu < 1) { fprintf(stderr, "kernel_launch: occupancy query gives %d\n", per_cu); per_cu = 1; }
        (void)hipGetLastError();
        grid = cus;
        if (grid > 256) grid = 256;
    }
    if (grid < 0) return;
    (void)hipMemsetAsync((char*)d_ws + WS_CTL, 0, CTL_ZERO_BYTES, stream);
    Args a{};
    for (int i = 0; i < 31; ++i) a.in[i] = (const float*)d_in[i];
    a.out = (float*)d_out; a.ws = (unsigned char*)d_ws;
#if MK_N_LAUNCHES == 1
    a.ph_lo = 0; a.ph_hi = N_PHASES;
    void* kargs[] = {&a};
    hipError_t e = hipLaunchCooperativeKernel((const void*)mk_fwd, dim3(grid), dim3(512), kargs, LDS_BYTES, stream);
    if (e != hipSuccess) fprintf(stderr, "kernel_launch: cooperative launch failed: %s (grid %d)\n", hipGetErrorString(e), grid);
#else
    for (int p = 0; p < N_PHASES; ++p) { a.ph_lo = p; a.ph_hi = p + 1; hipLaunchKernelGGL(mk_fwd, dim3(grid), dim3(512), LDS_BYTES, stream, a); }
#endif
}
```

```cpp
#include <hip/hip_runtime.h>
#include <hip/hip_cooperative_groups.h>
#include <cstdio>
#include <cstdint>
namespace cg = cooperative_groups;

#ifndef MK_N_LAUNCHES
#define MK_N_LAUNCHES 1
#endif

#define LAS __attribute__((address_space(3)))
typedef unsigned short bf16_t;
typedef short bf16x8 __attribute__((ext_vector_type(8)));
typedef float f32x4 __attribute__((ext_vector_type(4)));
typedef float f32x2 __attribute__((ext_vector_type(2)));
typedef unsigned u32x4 __attribute__((ext_vector_type(4)));
typedef unsigned u32x2 __attribute__((ext_vector_type(2)));

constexpr int NB = 16, SEQ = 4096, D = 1024, T = NB * SEQ;
constexpr int DCONV = 768, DSSM = 256, DIN = 2560, NG = 16, GC = 16, NP = 64;
constexpr int NE = 64, TOPK = 6, DE = 256, NSLOT = 7;
constexpr int LCH = 32;
constexpr int NCHUNK = T / LCH;
constexpr int KU = LCH * GC;
constexpr int KA2 = KU + 2 * NP;
constexpr int MAXBLK = 1600;
constexpr float RMS_EPS = 1e-6f;

constexpr size_t MiB = 1u << 20, KiB = 1u << 10;
constexpr size_t WS_CTL = 0;
constexpr size_t WS_MOD = 64 * KiB;
constexpr size_t WS_AB32 = 448 * KiB;
constexpr size_t WS_BLKE = 512 * KiB;
constexpr size_t WS_WIN_T = 1 * MiB;
constexpr size_t WS_WOUT_T = 6 * MiB;
constexpr size_t WS_WGLU_T = 8 * MiB;
constexpr size_t WS_WS2_T = 8 * MiB + 512 * KiB;
constexpr size_t WS_WSR_T = 9 * MiB;
constexpr size_t WS_T1 = 11 * MiB;
constexpr size_t WS_T2 = 15 * MiB;
constexpr size_t WS_W13T = 25 * MiB;
constexpr size_t WS_W2T = 89 * MiB;
constexpr size_t WS_H = 128 * MiB;
constexpr size_t WS_X1 = 128 * MiB;
constexpr size_t WS_PROJC = 256 * MiB;
constexpr size_t WS_ACT = 256 * MiB;
constexpr size_t WS_ACTS = 456 * MiB;
constexpr size_t WS_ROUTE = 488 * MiB;
constexpr size_t WS_H2 = 512 * MiB;
constexpr size_t WS_Y4 = 512 * MiB;
constexpr size_t WS_YS8 = 912 * MiB;
constexpr size_t WS_YCAT = 640 * MiB;
constexpr size_t WS_LOGITS = 640 * MiB;
constexpr size_t WS_A2 = 768 * MiB;
constexpr size_t WS_S = 808 * MiB;
constexpr size_t WS_YS = 824 * MiB;
constexpr size_t WS_END = 1024 * MiB;
constexpr size_t RT_SELE = 0;
constexpr size_t RT_SELW = 2 * MiB;
constexpr size_t RT_CNTW = 4 * MiB;
constexpr size_t RT_CNTB = 5 * MiB;
constexpr size_t RT_TDEST = 12 * MiB;
constexpr size_t RT_REC = 6 * MiB;
constexpr int CW_NBLK = 16;
constexpr int CW_BAR = 1024;
constexpr size_t CTL_ZERO_BYTES = 32 * KiB;

constexpr int RING_BYTES = 131072;
constexpr int EPI_OFF = RING_BYTES;
constexpr int MISC_OFF = EPI_OFF + 16384;
constexpr int LDS_BYTES = 148480;

__device__ __forceinline__ unsigned f2bf(float f) { unsigned u = __builtin_bit_cast(unsigned, f); return (u + 0x7fffu + ((u >> 16) & 1u)) >> 16; }
typedef __bf16 bf16x2_t __attribute__((ext_vector_type(2)));
__device__ __forceinline__ unsigned pk2(float lo, float hi) { const f32x2 v = {lo, hi}; const bf16x2_t b = __builtin_convertvector(v, bf16x2_t); return __builtin_bit_cast(unsigned, b); }
__device__ __forceinline__ float bflo(unsigned w) { return __builtin_bit_cast(float, w << 16); }
__device__ __forceinline__ float bfhi(unsigned w) { return __builtin_bit_cast(float, w & 0xffff0000u); }
__device__ __forceinline__ float bf2f(bf16_t b) { return __builtin_bit_cast(float, (unsigned)b << 16); }
__device__ __forceinline__ float fexp_(float v) { return __builtin_amdgcn_exp2f(v * 1.4426950408889634f); }
__device__ __forceinline__ float sigmoidf_(float v) { return __builtin_amdgcn_rcpf(1.0f + fexp_(-v)); }
__device__ __forceinline__ float siluf_(float v) { return v * __builtin_amdgcn_rcpf(1.0f + fexp_(-v)); }
__device__ __forceinline__ float gelu_tanh(float v) {
    const float z = 0.7978845608028654f * (v + 0.044715f * v * v * v);
    const float e = fexp_(2.0f * z);
    const float th = 1.0f - 2.0f * __builtin_amdgcn_rcpf(e + 1.0f);
    return 0.5f * v * (1.0f + th);
}
__device__ __forceinline__ float wave_sum(float v) {
#pragma unroll
    for (int o = 1; o < 64; o <<= 1) v += __shfl_xor(v, o);
    return v;
}
__device__ __forceinline__ int ld_i32_agent(const int* p) { return __hip_atomic_load(p, __ATOMIC_RELAXED, __HIP_MEMORY_SCOPE_AGENT); }


#define XB_TMO      128
#define XB_XCNT(j)  (256  + 64 * (j))
#define XB_XSUB(j)  (1280 + 64 * (j))
#define XB_XGEN(j)  (2304 + 64 * (j))
#define XB_TOP      3328
#define XB_TOPGEN   3392
#define XCD_BAR_WORDS 3456
#define XB_SPIN_CAP (1u << 22)
__device__ __forceinline__ unsigned xb_ld(unsigned* p)              { return __hip_atomic_load(p, __ATOMIC_RELAXED, __HIP_MEMORY_SCOPE_AGENT); }
__device__ __forceinline__ unsigned xb_add(unsigned* p, unsigned v) { return __hip_atomic_fetch_add(p, v, __ATOMIC_RELAXED, __HIP_MEMORY_SCOPE_AGENT); }
__device__ __forceinline__ unsigned xb_xcc_id() { return (unsigned)__builtin_amdgcn_s_getreg((3 << 11) | 20) & 0xFu; }
#define XB_SPIN(cond, bar) do { unsigned _sp = 0; while (cond) { __builtin_amdgcn_s_sleep(1); \
    if ((++_sp & 255u) == 0u) { if (xb_ld(&(bar)[XB_TMO])) break; if (_sp > XB_SPIN_CAP) { atomicAdd(&(bar)[XB_TMO], 1u); break; } } } } while (0)
struct XcdBarrier { unsigned* bar; unsigned x; volatile LAS unsigned* st; };
__device__ __forceinline__ XcdBarrier xcd_barrier_post(unsigned* bar, volatile LAS unsigned* st) {
    XcdBarrier b; b.bar = bar; b.x = xb_xcc_id(); b.st = st;
    if (threadIdx.x == 0) (void)xb_add(&bar[XB_XCNT(b.x)], 1u);
    return b;
}
__device__ __forceinline__ void xcd_barrier_complete(unsigned* bar, unsigned x, unsigned& nloc, unsigned& nx) {
    const unsigned G = gridDim.x * gridDim.y * gridDim.z;
    unsigned sum, cnt, mine, sp = 0u;
    for (;;) {
        sum = 0u; cnt = 0u; mine = 0u;
#pragma unroll
        for (unsigned j = 0; j < 16; ++j) { const unsigned c = xb_ld(&bar[XB_XCNT(j)]); sum += c; cnt += (c > 0u) ? 1u : 0u; mine = (j == x) ? c : mine; }
        if (sum == G) break;
        __builtin_amdgcn_s_sleep(1);
        if ((++sp & 255u) == 0u) { if (xb_ld(&bar[XB_TMO])) break; if (sp > XB_SPIN_CAP) { atomicAdd(&bar[XB_TMO], 1u); break; } }
    }
    nloc = mine > 0u ? mine : 1u; nx = cnt > 0u ? cnt : 1u;
}
__device__ __forceinline__ void xcd_barrier(const XcdBarrier& b) {
    asm volatile("s_waitcnt vmcnt(0)" ::: "memory");
    __syncthreads();
    if (threadIdx.x == 0) {
        unsigned* bar = b.bar;
        __builtin_amdgcn_s_waitcnt(0);
        unsigned nloc = b.st[0], nx = b.st[1];
        if (nloc == 0u) { xcd_barrier_complete(bar, b.x, nloc, nx); b.st[0] = nloc; b.st[1] = nx; }
        const unsigned old = xb_add(&bar[XB_XSUB(b.x)], 1u);
        const unsigned gen = old / nloc;
        if (old + 1u == (gen + 1u) * nloc) {
            __builtin_amdgcn_fence(__ATOMIC_RELEASE, "agent");
            asm volatile("s_waitcnt vmcnt(0)" ::: "memory");
            const unsigned og = xb_add(&bar[XB_TOP], 1u);
            const unsigned tg = og / nx;
            if (og + 1u == (tg + 1u) * nx) xb_add(&bar[XB_TOPGEN], 1u);
            else XB_SPIN(xb_ld(&bar[XB_TOPGEN]) == tg, bar);
            __builtin_amdgcn_fence(__ATOMIC_ACQUIRE, "agent");
            xb_add(&bar[XB_XGEN(b.x)], 1u);
            asm volatile("s_waitcnt vmcnt(0)" ::: "memory");
        } else {
            XB_SPIN(xb_ld(&bar[XB_XGEN(b.x)]) == gen, bar);
            __builtin_amdgcn_fence(__ATOMIC_ACQUIRE, "agent");
            asm volatile("s_waitcnt vmcnt(0)" ::: "memory");
        }
    }
    __syncthreads();
}

namespace pg8 {
constexpr int BM = 256, BK = 64, HALF = 128, HTB = HALF * BK * 2, STAGE_BYTES = 8 * HTB;
__device__ __forceinline__ int lds_byte(int r, int c) { const int st = (r >> 4) * 2 + (c >> 5), rr = r & 15, cc = c & 31, ob = rr * 64 + cc * 2; return st * 1024 + (ob ^ (((ob >> 9) & 1) << 5)); }
__device__ __forceinline__ void stage_rc(int b, int& R, int& C) { const int st = b / 1024, sb = b % 1024, swz = sb ^ (((sb >> 9) & 1) << 5); R = (st >> 1) * 16 + swz / 64; C = (st & 1) * 32 + (swz % 64) / 2; }
__device__ __forceinline__ int perm32(int rho) { const int n = rho >> 4, i = rho & 15; return 8 * (i >> 2) + 4 * n + (i & 3); }

struct Unit { const char* A; const char* B; const int* rows; int pm, pn, aux, par; };
struct Desc { int lda, ldb, K; int sbx = 0; };

template <class Epi, class Sched, bool GATHER, bool ALIGN_EPI>
__device__ __forceinline__ void gemm_phase(LAS unsigned char* lds, const Desc g, const Sched& S, const Epi& E) {
    const int tid = threadIdx.x, wid = __builtin_amdgcn_readfirstlane(tid >> 6), lane = tid & 63, wr = wid >> 2, wc = wid & 3, fr = lane & 15, fq = lane >> 4;
    const int K = g.K, nt = K / BK;
    int Rr[2], Cc[2]; unsigned voffB[2];
#pragma unroll
    for (int i = 0; i < 2; ++i) { int R, C; stage_rc(tid * 16 + i * 8192, R, C); const int Rb = Epi::PERM ? ((R & ~31) + perm32(R & 31)) : R;
        Rr[i] = R; Cc[i] = C; voffB[i] = (unsigned)(Rb * g.ldb + C) * 2u; }
    const size_t kstep = (size_t)(BK * 2);
    const size_t hstepB = (size_t)HALF * g.ldb * 2;
    const unsigned ldsw = (unsigned)wid * 1024u;
    const int aoff = lds_byte(wr * 64 + fr, fq * 8), boff = lds_byte(wc * 32 + fr, fq * 8);
#define PG8_SA(b, h) (((b) * 2 + (h)) * HTB)
#define PG8_SB(b, h) ((4 + (b) * 2 + (h)) * HTB)
#define PG8_STAGE(bufoff, gbase, v0, v1) do { \
        __builtin_amdgcn_global_load_lds((const unsigned*)((const char*)(gbase) + (v0)), (LAS unsigned*)(lds + (bufoff) + ldsw), 16, 0, 0); \
        __builtin_amdgcn_global_load_lds((const unsigned*)((const char*)(gbase) + (v1)), (LAS unsigned*)(lds + (bufoff) + ldsw + 8192), 16, 0, 0); } while (0)
#define PG8_STAGEB(bufoff, gbase) PG8_STAGE(bufoff, gbase, voffB[0], voffB[1])
#define PG8_LDA(dst, b, h) do { _Pragma("unroll") for (int m = 0; m < 4; ++m) _Pragma("unroll") for (int k = 0; k < 2; ++k) dst[m][k] = *(const LAS bf16x8*)(lds + PG8_SA(b, h) + aoff + m * 2048 + k * 1024); } while (0)
#define PG8_LDB(dst, b, h) do { _Pragma("unroll") for (int n = 0; n < 2; ++n) _Pragma("unroll") for (int k = 0; k < 2; ++k) dst[n][k] = *(const LAS bf16x8*)(lds + PG8_SB(b, h) + boff + n * 2048 + k * 1024); } while (0)
#define PG8_MMA(ai, bj, At, Bt) do { __builtin_amdgcn_s_setprio(1); _Pragma("unroll") for (int m = 0; m < 4; ++m) _Pragma("unroll") for (int n = 0; n < 2; ++n) _Pragma("unroll") for (int k = 0; k < 2; ++k) \
        acc[ai][bj][m][n] = __builtin_amdgcn_mfma_f32_16x16x32_bf16(Bt[n][k], At[m][k], acc[ai][bj][m][n], 0, 0, 0); __builtin_amdgcn_s_setprio(0); } while (0)
#define PG8_WAIT_V(n) asm volatile("s_waitcnt vmcnt(" #n ")" ::: "memory")
#define PG8_WAIT_L(n) asm volatile("s_waitcnt lgkmcnt(" #n ")" ::: "memory")
#define PG8_BAR __builtin_amdgcn_s_barrier()
#define PG8_SCHED __builtin_amdgcn_sched_barrier(0)
    const unsigned hoffA = GATHER ? 0u : (unsigned)(HALF * g.lda) * 2u;
#define PG8_AOFFS(dst, u) do { if constexpr (GATHER) { _Pragma("unroll") for (int h = 0; h < 2; ++h) _Pragma("unroll") for (int i = 0; i < 2; ++i) { \
        const int rec_ = (u).rows[2 * (h * HALF + Rr[i])]; const int row_ = rec_ < 0 ? 0 : (rec_ & 0xffff); dst[h][i] = (unsigned)(row_ * g.lda + Cc[i]) * 2u; } \
        asm volatile("" : "+v"(dst[0][0]), "+v"(dst[0][1]), "+v"(dst[1][0]), "+v"(dst[1][1])); } } while (0)
    Unit cur, nxt; int ui = 0;
    if (!S.next(0, cur)) return;
    unsigned cvo[2][2], nvo[2][2];
    if constexpr (Sched::PREFETCH) S.prefetch(cur, wid, lane, lds);
    if constexpr (GATHER) { PG8_AOFFS(cvo, cur); }
    else {
#pragma unroll
        for (int i = 0; i < 2; ++i) { cvo[0][i] = (unsigned)(Rr[i] * g.lda + Cc[i]) * 2u; cvo[1][i] = cvo[0][i] + hoffA; nvo[0][i] = cvo[0][i]; nvo[1][i] = cvo[1][i]; } }
    f32x4 acc[2][2][4][2];
#pragma unroll
    for (int a = 0; a < 2; ++a)
#pragma unroll
        for (int b = 0; b < 2; ++b)
#pragma unroll
            for (int m = 0; m < 4; ++m)
#pragma unroll
                for (int n = 0; n < 2; ++n) acc[a][b][m][n] = (f32x4){0.f, 0.f, 0.f, 0.f};
    bf16x8 At[4][2], B0[2][2], B1[2][2];
    const char* cA = cur.A; const char* cB = cur.B;
    PG8_STAGEB(PG8_SB(0, 0), cB); PG8_STAGEB(PG8_SB(0, 1), cB + hstepB); PG8_STAGE(PG8_SA(0, 0), cA, cvo[0][0], cvo[0][1]); PG8_STAGE(PG8_SA(0, 1), cA, cvo[1][0], cvo[1][1]);
    if (wr == 1) PG8_BAR;
    PG8_WAIT_V(2); PG8_BAR;
    PG8_STAGEB(PG8_SB(1, 0), cB + kstep); PG8_STAGE(PG8_SA(1, 0), cA + kstep, cvo[0][0], cvo[0][1]); PG8_STAGEB(PG8_SB(1, 1), cB + hstepB + kstep);
    PG8_WAIT_V(6); PG8_BAR;
    for (;;) {
        const bool has_next = S.next(ui + 1, nxt);
        if constexpr (Sched::PREFETCH) { if (has_next) S.prefetch(nxt, wid, lane, lds); }
        if (g.sbx & 1) { nxt.A = cur.A; nxt.B = cur.B; nxt.rows = cur.rows; }
        const char* nA = has_next ? nxt.A : cA; const char* nB = has_next ? nxt.B : cB;
        if constexpr (GATHER) { if (has_next) { PG8_AOFFS(nvo, nxt); } else {
#pragma unroll
            for (int h = 0; h < 2; ++h)
#pragma unroll
                for (int i = 0; i < 2; ++i) nvo[h][i] = cvo[h][i]; } }
#pragma nounroll
        for (int t = 0; t < nt; t += 2) {
            const bool last = (t == nt - 2);
            const char* a1 = cA + (size_t)(t + 1) * kstep;
            const char* a2 = last ? nA : cA + (size_t)(t + 2) * kstep; const char* b2 = last ? nB : cB + (size_t)(t + 2) * kstep;
            const char* a3 = a2 + kstep; const char* b3 = b2 + kstep;
            const unsigned o00 = (GATHER && last) ? nvo[0][0] : cvo[0][0], o01 = (GATHER && last) ? nvo[0][1] : cvo[0][1], o10 = (GATHER && last) ? nvo[1][0] : cvo[1][0], o11 = (GATHER && last) ? nvo[1][1] : cvo[1][1];
            PG8_LDB(B0, 0, 0); PG8_LDB(B1, 0, 1); PG8_SCHED; PG8_LDA(At, 0, 0); PG8_STAGE(PG8_SA(1, 1), a1, cvo[1][0], cvo[1][1]);
            PG8_WAIT_V(8); PG8_WAIT_L(0); PG8_BAR; PG8_MMA(0, 0, At, B0); PG8_MMA(0, 1, At, B1); PG8_BAR; PG8_SCHED;
            PG8_LDA(At, 0, 1); PG8_STAGEB(PG8_SB(0, 0), b2); PG8_STAGEB(PG8_SB(0, 1), b2 + hstepB); PG8_STAGE(PG8_SA(0, 0), a2, o00, o01);
            PG8_WAIT_V(8); PG8_WAIT_L(0); PG8_BAR; PG8_MMA(1, 0, At, B0); PG8_MMA(1, 1, At, B1); PG8_BAR; PG8_SCHED;
            PG8_LDB(B0, 1, 0); PG8_LDB(B1, 1, 1); PG8_SCHED; PG8_LDA(At, 1, 0); PG8_STAGE(PG8_SA(0, 1), a2, o10, o11);
            PG8_WAIT_V(8); PG8_WAIT_L(0); PG8_BAR; PG8_MMA(0, 0, At, B0); PG8_MMA(0, 1, At, B1); PG8_BAR; PG8_SCHED;
            PG8_LDA(At, 1, 1); PG8_STAGEB(PG8_SB(1, 0), b3); PG8_STAGEB(PG8_SB(1, 1), b3 + hstepB); PG8_STAGE(PG8_SA(1, 0), a3, o00, o01);
            PG8_WAIT_V(8); PG8_WAIT_L(0); PG8_BAR; PG8_MMA(1, 0, At, B0); PG8_MMA(1, 1, At, B1); PG8_BAR; PG8_SCHED;
        }
        if constexpr (ALIGN_EPI) { if (wr == 0) PG8_BAR; }
        if (g.sbx & 2) {
#pragma unroll
            for (int a = 0; a < 2; ++a)
#pragma unroll
                for (int b = 0; b < 2; ++b)
#pragma unroll
                    for (int m = 0; m < 4; ++m) asm volatile("" :: "v"(acc[a][b][m][0]), "v"(acc[a][b][m][1])); } else
        E(acc, cur, wr, wc, fr, fq);
#ifdef EPI_TWICE
        if constexpr (Epi::ID == EPI_TWICE) { asm volatile("" ::: "memory"); E(acc, cur, wr, wc, fr, fq); }
#endif
        if (!has_next) break;
#pragma unroll
        for (int a = 0; a < 2; ++a)
#pragma unroll
            for (int b = 0; b < 2; ++b)
#pragma unroll
                for (int m = 0; m < 4; ++m)
#pragma unroll
                    for (int n = 0; n < 2; ++n) acc[a][b][m][n] = (f32x4){0.f, 0.f, 0.f, 0.f};
        cur = nxt; cA = nA; cB = nB; ++ui;
        if constexpr (GATHER) {
#pragma unroll
        for (int h = 0; h < 2; ++h)
#pragma unroll
            for (int i = 0; i < 2; ++i) cvo[h][i] = nvo[h][i]; }
        if constexpr (ALIGN_EPI) { if (wr == 1) PG8_BAR; }
    }
    PG8_WAIT_V(0);
    if constexpr (!ALIGN_EPI) { if (wr == 0) PG8_BAR; }
    PG8_BAR;
#undef PG8_SA
#undef PG8_SB
#undef PG8_STAGE
#undef PG8_STAGEB
#undef PG8_LDA
#undef PG8_LDB
#undef PG8_MMA
#undef PG8_WAIT_V
#undef PG8_WAIT_L
#undef PG8_BAR
#undef PG8_SCHED
#undef PG8_AOFFS
}
}
using pg8::Unit;

struct Args { const float* in[31]; float* out; unsigned char* ws; int ph_lo, ph_hi; };
struct Frame {
    LAS unsigned char* lds; int tid, lane, wave, blk, G, vcu;
    const float *x, *c, *w_ada, *b_ada, *g_mix, *w_in, *conv_w, *conv_b, *g_conv, *lam_re, *lam_im, *log_dt, *b_re, *b_im, *c_re, *c_im,
        *d_skip, *w_glu, *b_glu, *g_ssm, *w_out, *g_ffn, *w_router, *router_bias, *w1, *w3, *w2, *ws1, *ws3, *ws2, *g_final;
    float* out; unsigned char* ws; XcdBarrier bar;
};
#define WSP(T_, off) ((T_*)(F.ws + (off)))
#define LDS_WAIT() asm volatile("s_waitcnt lgkmcnt(0)" ::: "memory")
#define VM_WAIT() asm volatile("s_waitcnt vmcnt(0)" ::: "memory")

struct TileOrder {
    int nM, nN, nwg, G, c;
    __device__ __forceinline__ void init(int nM_, int nN_, int G_, int c_) { nM = nM_; nN = nN_; nwg = nM * nN; G = G_; c = c_; }
    __device__ __forceinline__ bool tile(int i, int& pm, int& pn) const {
        const long L = (long)i * G + c; if (L >= nwg) return false;
        int wgid = (int)L; { const int q = nwg / 8, r = nwg % 8, xcd = wgid % 8, off = wgid / 8; wgid = (xcd < r ? xcd * (q + 1) : r * (q + 1) + (xcd - r) * q) + off; }
        const int nig = 8 * nN, gid = wgid / nig, fm = gid * 8, gsz = (nM - fm) < 8 ? (nM - fm) : 8;
        pm = fm + ((wgid % nig) % gsz); pn = (wgid % nig) / gsz; return true;
    }
};

__device__ __forceinline__ int down_perm_row(int c) { const int cl = c & 255; return (c & ~255) + ((cl >> 3) & 1) * 128 + (cl >> 6) * 32 + ((cl >> 4) & 3) * 8 + (cl & 7); }
template <int PMODE = 0>
__device__ __forceinline__ void transpose_item(const float* W, int ldw, int k0, int n0, bf16_t* WT, int ldt, int drow0, LAS float* scr, int lane) {
    float tv[32];
#pragma unroll
    for (int i = 0; i < 32; ++i) { const int kk = 2 * i + (lane >> 5); tv[i] = W[(size_t)(k0 + kk) * ldw + n0 + (lane & 31)]; }
#pragma unroll
    for (int i = 0; i < 32; ++i) { const int kk = 2 * i + (lane >> 5); scr[kk * 33 + (lane & 31)] = tv[i]; }
    LDS_WAIT(); asm volatile("" ::: "memory");
    const int c = lane & 7;
#pragma unroll
    for (int j = 0; j < 4; ++j) { const int n = (lane >> 3) + 8 * j; const LAS float* s = scr + (8 * c) * 33 + n;
        u32x4 o; o.x = pk2(s[0 * 33], s[1 * 33]); o.y = pk2(s[2 * 33], s[3 * 33]); o.z = pk2(s[4 * 33], s[5 * 33]); o.w = pk2(s[6 * 33], s[7 * 33]);
        const int drow = PMODE ? down_perm_row(drow0 + n) : (drow0 + n);
        *(u32x4*)(WT + (size_t)drow * ldt + k0 + 8 * c) = o; }
    LDS_WAIT(); asm volatile("" ::: "memory");
}

__device__ __forceinline__ void p0_mod(Frame& F) {
    LAS float* sil = (LAS float*)F.lds;
    LAS float* red = (LAS float*)(F.lds + 65536);
    for (int i = F.tid; i < NB * D; i += 512) { const float v = F.c[i]; sil[i] = v / (1.0f + __expf(-v)); }
    __syncthreads();
    const int col = F.tid & 31, ks = F.tid >> 5, n0 = F.blk * 32;
    float acc[16];
#pragma unroll
    for (int b = 0; b < 16; ++b) acc[b] = 0.f;
#pragma nounroll
    for (int k0 = 0; k0 < 64; k0 += 16) { float wv[16];
#pragma unroll
        for (int kk = 0; kk < 16; ++kk) wv[kk] = F.w_ada[(size_t)(ks * 64 + k0 + kk) * 6144 + n0 + col];
#pragma unroll
        for (int kk = 0; kk < 16; ++kk) { const int k = ks * 64 + k0 + kk;
#pragma unroll
            for (int b = 0; b < 16; ++b) acc[b] += sil[b * 1024 + k] * wv[kk]; } }
#pragma unroll
    for (int b = 0; b < 16; ++b) red[(ks * 16 + b) * 32 + col] = acc[b];
    __syncthreads();
    { const int b = F.tid >> 5; float s = 0.f;
#pragma unroll
      for (int k2 = 0; k2 < 16; ++k2) s += red[(k2 * 16 + b) * 32 + col];
      WSP(float, WS_MOD)[b * 6144 + n0 + col] = s + F.b_ada[n0 + col]; }
    __syncthreads();
}

__device__ __forceinline__ void p0_s5_tables(Frame& F, int g, int part) {
    LAS f32x2* pw = (LAS f32x2*)F.lds;
    LAS f32x2* Bb = (LAS f32x2*)(F.lds + 20480);
    LAS f32x2* Cc = (LAS f32x2*)(F.lds + 28672);
    LAS float* Kn = (LAS float*)(F.lds + 36864);
    const float dt = expf(F.log_dt[g]);
    for (int i = F.tid; i < 33 * 64; i += 512) { const int tau = i >> 6, p = i & 63; const float lr = F.lam_re[g * 64 + p], li = F.lam_im[g * 64 + p];
        const float mag = expf(lr * dt * (float)tau), ang = li * dt * (float)tau; float sn, cs; sincosf(ang, &sn, &cs); pw[i] = (f32x2){mag * cs, mag * sn}; }
    for (int i = F.tid; i < 1024; i += 512) { const int p = i >> 4, hi = i & 15; const float lr = F.lam_re[g * 64 + p], li = F.lam_im[g * 64 + p];
        const float mag = expf(lr * dt), ang = li * dt; float sn, cs; sincosf(ang, &sn, &cs);
        const float nr = mag * cs - 1.0f, ni = mag * sn, den = lr * lr + li * li, qr = (nr * lr + ni * li) / den, qi = (ni * lr - nr * li) / den;
        const float br = F.b_re[(g * 64 + p) * 16 + hi], bi = F.b_im[(g * 64 + p) * 16 + hi];
        Bb[i] = (f32x2){qr * br - qi * bi, qr * bi + qi * br};
        Cc[i] = (f32x2){F.c_re[g * 1024 + i], F.c_im[g * 1024 + i]}; }
    __syncthreads();
    { const int tau = F.tid >> 4, ho = F.tid & 15;
      if (tau <= 4 * part + 3) { float kacc[16];
#pragma unroll
        for (int hi = 0; hi < 16; ++hi) kacc[hi] = 0.f;
        for (int p = 0; p < 64; ++p) { const f32x2 c = Cc[ho * 64 + p], a = pw[tau * 64 + p];
            const float wr_ = c.x * a.x - c.y * a.y, wi_ = c.x * a.y + c.y * a.x;
#pragma unroll
            for (int hi = 0; hi < 16; ++hi) { const f32x2 b = Bb[p * 16 + hi]; kacc[hi] += wr_ * b.x - wi_ * b.y; } }
#pragma unroll
        for (int hi = 0; hi < 16; ++hi) Kn[F.tid * 16 + hi] = kacc[hi]; } }
    __syncthreads();
    bf16_t* T2 = WSP(bf16_t, WS_T2); bf16_t* T1 = WSP(bf16_t, WS_T1);
    for (int i = F.tid; i < 64 * 320; i += 512) { const int n = 64 * part + i / 320, k = 2 * (i % 320), tl = n >> 4, ho = n & 15; float v0, v1;
        if (k < KU) { const int sl = k >> 4, hi = k & 15;
            if (sl <= tl) { v0 = Kn[((tl - sl) * 16 + ho) * 16 + hi]; v1 = Kn[((tl - sl) * 16 + ho) * 16 + hi + 1];
                if (sl == tl) { const float dsk = F.d_skip[g * 16 + ho]; if (hi == ho) v0 += dsk; if (hi + 1 == ho) v1 += dsk; } }
            else { v0 = 0.f; v1 = 0.f; } }
        else { const int p = (k - KU) >> 1; const f32x2 c = Cc[ho * 64 + p], a = pw[(tl + 1) * 64 + p]; v0 = c.x * a.x - c.y * a.y; v1 = -(c.x * a.y + c.y * a.x); }
        *(unsigned*)(T2 + ((size_t)(g * 512 + n) * KA2 + k)) = pk2(v0, v1); }
    for (int i = F.tid; i < 16 * 256; i += 512) { const int n1 = 16 * part + (i >> 8), k = 2 * (i & 255), p = n1 >> 1, ri = n1 & 1, sl = k >> 4, hi = k & 15;
        const f32x2 a = pw[(31 - sl) * 64 + p], b0 = Bb[p * 16 + hi], b1 = Bb[p * 16 + hi + 1];
        const float v0 = ri ? (a.x * b0.y + a.y * b0.x) : (a.x * b0.x - a.y * b0.y), v1 = ri ? (a.x * b1.y + a.y * b1.x) : (a.x * b1.x - a.y * b1.y);
        *(unsigned*)(T1 + ((size_t)(g * 256 + n1) * KU + k)) = pk2(v0, v1);
        *(unsigned*)(T1 + ((size_t)(g * 256 + 128 + n1) * KU + k)) = 0u; }
    if (part == 0 && F.tid < 64) { const f32x2 a = pw[32 * 64 + F.tid]; WSP(f32x2, WS_AB32)[g * 64 + F.tid] = a; }
    __syncthreads();
}

__device__ __forceinline__ void p0_prologue(Frame& F) {
    { const int it = 255 - F.blk; if (it < 128) p0_s5_tables(F, it >> 3, 7 - (it & 7)); }
    __syncthreads();
    { u32x4* z = (u32x4*)(WSP(bf16_t, WS_WSR_T) + (size_t)576 * 1024); const int nz = 192 * 1024 * 2 / 16;
      for (int i = F.blk * 512 + F.tid; i < nz; i += F.G * 512) z[i] = (u32x4){0u, 0u, 0u, 0u}; }
    LAS float* scr = (LAS float*)(F.lds + F.wave * 16384);
    const int gw = F.vcu * 8 + F.wave, NGW = F.G * 8;
    constexpr int I0 = 1280, I1 = 512, I2 = 32, I3 = 128, I4 = 128, I5 = 32, I6 = 128;
    constexpr int NITEMS = I0 + I1 + I2 + I3 + I4 + I5 + I6;
    for (int it = gw; it < NITEMS; it += NGW) {
        int r = it;
        if (r < I0) { const int kb = r / 80, nb = r % 80, n0 = 32 * nb;
            const int drow = (n0 < 768 || n0 >= 2304) ? n0 : (n0 < 1536 ? 768 + ((n0 - 768) >> 7) * 256 + ((n0 - 768) & 127) : 768 + ((n0 - 1536) >> 7) * 256 + 128 + ((n0 - 1536) & 127));
            transpose_item(F.w_in, DIN, 64 * kb, n0, WSP(bf16_t, WS_WIN_T), 1024, drow, scr, F.lane); continue; } r -= I0;
        if (r < I1) { const int kb = r / 32, nb = r % 32; transpose_item(F.w_out, 1024, 64 * kb, 32 * nb, WSP(bf16_t, WS_WOUT_T), 1024, 32 * nb, scr, F.lane); continue; } r -= I1;
        if (r < I2) { const int kb = r / 8, nb = r % 8; transpose_item(F.w_glu, 256, 64 * kb, 32 * nb, WSP(bf16_t, WS_WGLU_T), 256, 32 * nb, scr, F.lane); continue; } r -= I2;
        if (r < I3) { const int kb = r / 8, nb = r % 8, n0 = 32 * nb; transpose_item(F.ws1, 256, 64 * kb, n0, WSP(bf16_t, WS_WSR_T), 1024, (n0 >> 7) * 256 + (n0 & 127), scr, F.lane); continue; } r -= I3;
        if (r < I4) { const int kb = r / 8, nb = r % 8, n0 = 32 * nb; transpose_item(F.ws3, 256, 64 * kb, n0, WSP(bf16_t, WS_WSR_T), 1024, (n0 >> 7) * 256 + 128 + (n0 & 127), scr, F.lane); continue; } r -= I4;
        if (r < I5) { const int kb = r / 2, nb = r % 2; transpose_item(F.w_router, 64, 64 * kb, 32 * nb, WSP(bf16_t, WS_WSR_T), 1024, 512 + 32 * nb, scr, F.lane); continue; } r -= I5;
        { const int kb = r / 32, nb = r % 32; transpose_item<1>(F.ws2, 1024, 64 * kb, 32 * nb, WSP(bf16_t, WS_WS2_T), 256, 32 * nb, scr, F.lane); }
    }
}
__device__ __forceinline__ void tr_w2(Frame& F, int ws, int nws) {
    LAS float* scr = (LAS float*)(F.lds + F.wave * 16384);
    for (int r = ws; r < 8192; r += nws) { const int e = r >> 7, q = r & 127, kb = q / 32, nb = q % 32;
        transpose_item<1>(F.w2 + (size_t)e * 256 * 1024, 1024, 64 * kb, 32 * nb, WSP(bf16_t, WS_W2T) + (size_t)e * 1024 * 256, 256, 32 * nb, scr, F.lane); }
}
__device__ __forceinline__ void tr_w13(Frame& F, int ws, int nws) {
    LAS float* scr = (LAS float*)(F.lds + F.wave * 16384);
    for (int r = ws; r < 16384; r += nws) { const int which = r >> 13, rr = r & 8191, e = rr >> 7, q = rr & 127, kb = q / 8, nb = q % 8, n0 = 32 * nb;
        transpose_item((which ? F.w3 : F.w1) + (size_t)e * 1024 * 256, 256, 64 * kb, n0, WSP(bf16_t, WS_W13T) + (size_t)e * 512 * 1024, 1024, (n0 >> 7) * 256 + which * 128 + (n0 & 127), scr, F.lane); }
}

__device__ __forceinline__ void p1_h(Frame& F) {
    const float* mod = WSP(float, WS_MOD); bf16_t* H = WSP(bf16_t, WS_H);
    const int NGW = F.G * 8;
    for (int t0 = F.blk * 8 + F.wave; t0 < T; t0 += 4 * NGW) {
        f32x4 v[4][4]; float ss[4];
#pragma unroll
        for (int q = 0; q < 4; ++q) { const int t = t0 + q * NGW; const f32x4* xr = (const f32x4*)(F.x + (size_t)t * D) + F.lane;
#pragma unroll
            for (int j = 0; j < 4; ++j) v[q][j] = xr[64 * j]; }
#pragma unroll
        for (int q = 0; q < 4; ++q) { float a = 0.f;
#pragma unroll
            for (int j = 0; j < 4; ++j) a += (v[q][j].x * v[q][j].x + v[q][j].y * v[q][j].y) + (v[q][j].z * v[q][j].z + v[q][j].w * v[q][j].w);
            ss[q] = a; }
#pragma unroll
        for (int o = 1; o < 64; o <<= 1) {
#pragma unroll
            for (int q = 0; q < 4; ++q) ss[q] += __shfl_xor(ss[q], o); }
#pragma unroll
        for (int q = 0; q < 4; ++q) { const int t = t0 + q * NGW; const int b = t >> 12; const float rstd = rsqrtf(ss[q] * (1.0f / D) + RMS_EPS);
#pragma unroll
            for (int j = 0; j < 4; ++j) { const int c0 = 4 * F.lane + 256 * j;
                const f32x4 gm = *(const f32x4*)(F.g_mix + c0), sh = *(const f32x4*)(mod + b * 6144 + c0), sc = *(const f32x4*)(mod + b * 6144 + 1024 + c0);
                const f32x4 h = v[q][j] * rstd * gm * (sc + 1.0f) + sh;
                *(u32x2*)(H + (size_t)t * D + c0) = (u32x2){pk2(h.x, h.y), pk2(h.z, h.w)}; } }
    }
}

__device__ __forceinline__ u32x4 pack8(const f32x4 a, const f32x4 b) { return (u32x4){pk2(a.x, a.y), pk2(a.z, a.w), pk2(b.x, b.y), pk2(b.z, b.w)}; }
#define EPI_FOR_ROWS _Pragma("unroll") for (int ai = 0; ai < 2; ++ai) _Pragma("unroll") for (int m = 0; m < 4; ++m)
#define EPI_ROWL (ai * 128 + wr * 64 + m * 16 + fr)

struct SchedG1 { static constexpr bool PREFETCH = false; TileOrder o; const char* A; const char* B;
    __device__ __forceinline__ bool next(int i, Unit& u) const { int pm, pn; if (!o.tile(i, pm, pn)) return false; u.pm = pm; u.pn = pn; u.aux = 0; u.rows = nullptr;
        u.A = A + (size_t)pm * 256 * 1024 * 2; u.B = B + (size_t)pn * 256 * 1024 * 2; return true; } };
struct EpiG1 { static constexpr int ID = 2; static constexpr bool PERM = true; bf16_t* projc; bf16_t* A2;
    __device__ __forceinline__ void operator()(const f32x4 (&acc)[2][2][4][2], const Unit& u_in, int wr, int wc, int fr_in, int fq_in) const {
        Unit u = u_in; asm volatile("" : "+s"(u.pm), "+s"(u.pn), "+s"(u.aux)); int fr = fr_in, fq = fq_in; asm volatile("" : "+v"(fr), "+v"(fq));
        EPI_FOR_ROWS { const int row = u.pm * 256 + EPI_ROWL;
            if (u.pn >= 3 && u.pn < 9) { *(u32x4*)(projc + (size_t)row * 1536 + 768 + (u.pn - 3) * 128 + wc * 32 + 8 * fq) = pack8(acc[ai][0][m][0] * acc[ai][1][m][0], acc[ai][0][m][1] * acc[ai][1][m][1]); }
            else {
#pragma unroll
                for (int bj = 0; bj < 2; ++bj) { const int col = bj * 128 + wc * 32 + 8 * fq; const u32x4 w = pack8(acc[ai][bj][m][0], acc[ai][bj][m][1]);
                    if (u.pn < 3) *(u32x4*)(projc + (size_t)row * 1536 + u.pn * 256 + col) = w;
                    else { const int g = col >> 4, hi0 = col & 15, chunk = row >> 5, sl = row & 31; *(u32x4*)(A2 + ((size_t)(g * NCHUNK + chunk) * KA2 + sl * 16 + hi0)) = w; } } } }
    } };

struct SchedS5a { static constexpr bool PREFETCH = false; int G, c; const char* A2; const char* T1;
    __device__ __forceinline__ bool next(int i, Unit& u) const { const int L = i * G + c; if (L >= 128) return false; const int g = L >> 3, pm = L & 7; u.pm = pm; u.pn = 0; u.aux = g; u.rows = nullptr;
        u.A = A2 + (size_t)(g * NCHUNK + pm * 256) * KA2 * 2; u.B = T1 + (size_t)g * 256 * KU * 2; return true; } };
struct EpiS5a { static constexpr int ID = 3; static constexpr bool PERM = false; float* S;
    __device__ __forceinline__ void operator()(const f32x4 (&acc)[2][2][4][2], const Unit& u_in, int wr, int wc, int fr_in, int fq_in) const {
        Unit u = u_in; asm volatile("" : "+s"(u.pm), "+s"(u.pn), "+s"(u.aux)); int fr = fr_in, fq = fq_in; asm volatile("" : "+v"(fr), "+v"(fq));
        EPI_FOR_ROWS { const int row = u.pm * 256 + EPI_ROWL;
#pragma unroll
            for (int n = 0; n < 2; ++n) { const int col = wc * 32 + 16 * n + 4 * fq; *(f32x4*)(S + ((size_t)(u.aux * NCHUNK + row) * 128 + col)) = acc[ai][0][m][n]; } }
    } };

struct SchedS5b { static constexpr bool PREFETCH = false; int G, c; const char* A2; const char* T2;
    __device__ __forceinline__ bool next(int i, Unit& u) const { const int L = i * G + c; if (L >= 256) return false; const int g = L >> 4, pm = (L >> 1) & 7, pn = L & 1; u.pm = pm; u.pn = pn; u.aux = g; u.rows = nullptr;
        u.A = A2 + (size_t)(g * NCHUNK + pm * 256) * KA2 * 2; u.B = T2 + (size_t)(g * 512 + pn * 256) * KA2 * 2; return true; } };
struct EpiS5b { static constexpr int ID = 5; static constexpr bool PERM = true; bf16_t* ys;
    __device__ __forceinline__ void operator()(const f32x4 (&acc)[2][2][4][2], const Unit& u_in, int wr, int wc, int fr_in, int fq_in) const {
        Unit u = u_in; asm volatile("" : "+s"(u.pm), "+s"(u.pn), "+s"(u.aux)); int fr = fr_in, fq = fq_in; asm volatile("" : "+v"(fr), "+v"(fq));
        EPI_FOR_ROWS { const int chunk = u.pm * 256 + EPI_ROWL;
#pragma unroll
            for (int bj = 0; bj < 2; ++bj) { const int n = u.pn * 256 + bj * 128 + wc * 32 + 8 * fq, tl = n >> 4, ho0 = n & 15; const size_t t = (size_t)chunk * LCH + tl;
                f32x4 a = acc[ai][bj][m][0], b = acc[ai][bj][m][1];
#pragma unroll
                for (int j = 0; j < 4; ++j) { a[j] = gelu_tanh(a[j]); b[j] = gelu_tanh(b[j]); }
                *(u32x4*)(ys + t * 256 + u.aux * 16 + ho0) = pack8(a, b); } }
    } };

struct SchedGlu { static constexpr bool PREFETCH = false; int G, c; const char* ys; const char* W;
    __device__ __forceinline__ bool next(int i, Unit& u) const { const int L = i * G + c; if (L >= 256) return false; u.pm = L; u.pn = 0; u.aux = 0; u.rows = nullptr;
        u.A = ys + (size_t)L * 256 * 256 * 2; u.B = W; return true; } };
struct EpiGlu { static constexpr int ID = 6; static constexpr bool PERM = true; const bf16_t* ys; const float* b_glu; const float* g_ssm; bf16_t* ycat; LAS float* scr;
    __device__ __forceinline__ void operator()(f32x4 (&acc)[2][2][4][2], const Unit& u_in, int wr, int wc, int fr_in, int fq_in) const {
        Unit u = u_in; asm volatile("" : "+s"(u.pm), "+s"(u.pn), "+s"(u.aux)); int fr = fr_in, fq = fq_in; asm volatile("" : "+v"(fr), "+v"(fq));
        f32x4 bg[2][2];
#pragma unroll
        for (int bj = 0; bj < 2; ++bj) { const int col = bj * 128 + wc * 32 + 8 * fq; bg[bj][0] = *(const f32x4*)(b_glu + col); bg[bj][1] = *(const f32x4*)(b_glu + col + 4); }
#pragma unroll
        for (int ai = 0; ai < 2; ++ai) {
            u32x4 yw[4][2];
#pragma unroll
            for (int m = 0; m < 4; ++m)
#pragma unroll
                for (int bj = 0; bj < 2; ++bj) yw[m][bj] = *(const u32x4*)(ys + ((size_t)u.pm * 256 + EPI_ROWL) * 256 + bj * 128 + wc * 32 + 8 * fq);
#pragma unroll
            for (int m = 0; m < 4; ++m) { const int rl = EPI_ROWL; float ss = 0.f;
#pragma unroll
                for (int bj = 0; bj < 2; ++bj) { const u32x4 w = yw[m][bj];
                    const f32x4 y0 = (f32x4){bflo(w.x), bfhi(w.x), bflo(w.y), bfhi(w.y)}, y1 = (f32x4){bflo(w.z), bfhi(w.z), bflo(w.w), bfhi(w.w)};
#pragma unroll
                    for (int j = 0; j < 4; ++j) { const float o0 = y0[j] * sigmoidf_(acc[ai][bj][m][0][j] + bg[bj][0][j]), o1 = y1[j] * sigmoidf_(acc[ai][bj][m][1][j] + bg[bj][1][j]);
                        acc[ai][bj][m][0][j] = o0; acc[ai][bj][m][1][j] = o1; ss += o0 * o0 + o1 * o1; } }
                ss += __shfl_xor(ss, 16); ss += __shfl_xor(ss, 32);
                if (fq == 0) scr[rl * 4 + wc] = ss; }
            asm volatile("" ::: "memory"); }
        LDS_WAIT(); __builtin_amdgcn_s_barrier(); asm volatile("" ::: "memory");
        f32x4 gs[2][2];
#pragma unroll
        for (int bj = 0; bj < 2; ++bj) { const int col = bj * 128 + wc * 32 + 8 * fq; gs[bj][0] = *(const f32x4*)(g_ssm + col); gs[bj][1] = *(const f32x4*)(g_ssm + col + 4); }
        EPI_FOR_ROWS { const int rl = EPI_ROWL; const size_t row = (size_t)u.pm * 256 + rl; const f32x4 p = *(const LAS f32x4*)(scr + rl * 4);
            const float rstd = rsqrtf(((p.x + p.y) + (p.z + p.w)) * (1.0f / 256.0f) + RMS_EPS);
#pragma unroll
            for (int bj = 0; bj < 2; ++bj) { const int col = bj * 128 + wc * 32 + 8 * fq;
                *(u32x4*)(ycat + row * 1024 + 768 + col) = pack8(acc[ai][bj][m][0] * rstd * gs[bj][0], acc[ai][bj][m][1] * rstd * gs[bj][1]); } }
        LDS_WAIT(); __builtin_amdgcn_s_barrier(); asm volatile("" ::: "memory");
    } };

struct SchedG2 { static constexpr bool PREFETCH = false; int c; const char* A; const char* B;
    __device__ __forceinline__ bool next(int i, Unit& u) const { if (i >= 4 || c >= 256) return false; u.pm = c; u.pn = i; u.aux = 0; u.rows = nullptr;
        u.A = A + (size_t)c * 256 * 1024 * 2; u.B = B + (size_t)i * 256 * 1024 * 2; return true; } };
struct EpiG2 { static constexpr int ID = 7; static constexpr bool PERM = true; const float* x; const float* mod; bf16_t* x1; LAS float* scr;
    __device__ __forceinline__ void operator()(const f32x4 (&acc)[2][2][4][2], const Unit& u_in, int wr, int wc, int fr_in, int fq_in) const {
        Unit u = u_in; asm volatile("" : "+s"(u.pm), "+s"(u.pn), "+s"(u.aux)); int fr = fr_in, fq = fq_in; asm volatile("" : "+v"(fr), "+v"(fq));
        const int b = u.pm >> 4;
        const char* xb = (const char*)(x + (size_t)u.pm * 256 * 1024 + u.pn * 256);
        char* ob = (char*)(x1 + (size_t)u.pm * 256 * 1024 + u.pn * 256);
        const char* gb = (const char*)(mod + b * 6144 + 2048 + u.pn * 256);
        const unsigned lcol = (unsigned)(wc * 32 + 8 * fq);
#pragma unroll
        for (int ai = 0; ai < 2; ++ai) {
            f32x4 xv[4][2][2], gt[2][2];
#pragma unroll
            for (int m = 0; m < 4; ++m)
#pragma unroll
                for (int bj = 0; bj < 2; ++bj) { const unsigned off = ((unsigned)EPI_ROWL * 1024u + bj * 128u + lcol) * 4u; xv[m][bj][0] = *(const f32x4*)(xb + off); xv[m][bj][1] = *(const f32x4*)(xb + off + 16); }
#pragma unroll
            for (int bj = 0; bj < 2; ++bj) { const unsigned off = (bj * 128u + lcol) * 4u; gt[bj][0] = *(const f32x4*)(gb + off); gt[bj][1] = *(const f32x4*)(gb + off + 16); }
#pragma unroll
            for (int m = 0; m < 4; ++m) { const int rl = EPI_ROWL; float ss = 0.f;
#pragma unroll
                for (int bj = 0; bj < 2; ++bj) { const unsigned off = ((unsigned)rl * 1024u + bj * 128u + lcol) * 2u;
                    const f32x4 o0 = xv[m][bj][0] + gt[bj][0] * acc[ai][bj][m][0], o1 = xv[m][bj][1] + gt[bj][1] * acc[ai][bj][m][1];
                    ss += (o0.x * o0.x + o0.y * o0.y) + (o0.z * o0.z + o0.w * o0.w) + (o1.x * o1.x + o1.y * o1.y) + (o1.z * o1.z + o1.w * o1.w);
                    *(u32x4*)(ob + off) = pack8(o0, o1); }
                ss += __shfl_xor(ss, 16); ss += __shfl_xor(ss, 32);
                if (fq == 0) scr[rl * 16 + u.pn * 4 + wc] = ss; }
            asm volatile("" ::: "memory"); }
    } };

struct SchedRS { static constexpr bool PREFETCH = false; TileOrder o; const char* A; const char* B;
    __device__ __forceinline__ bool next(int i, Unit& u) const { int pm, pn; if (!o.tile(i, pm, pn)) return false; u.pm = pm; u.pn = pn; u.aux = 0; u.rows = nullptr;
        u.A = A + (size_t)pm * 256 * 1024 * 2; u.B = B + (size_t)pn * 256 * 1024 * 2; return true; } };
struct EpiRS { static constexpr int ID = 8; static constexpr bool PERM = true; bf16_t* acts; float* logits;
    __device__ __forceinline__ void operator()(const f32x4 (&acc)[2][2][4][2], const Unit& u_in, int wr, int wc, int fr_in, int fq_in) const {
        Unit u = u_in; asm volatile("" : "+s"(u.pm), "+s"(u.pn), "+s"(u.aux)); int fr = fr_in, fq = fq_in; asm volatile("" : "+v"(fr), "+v"(fq));
        EPI_FOR_ROWS { const size_t row = (size_t)u.pm * 256 + EPI_ROWL;
            if (u.pn < 2) { f32x4 o0, o1;
#pragma unroll
                for (int j = 0; j < 4; ++j) { o0[j] = siluf_(acc[ai][0][m][0][j]) * acc[ai][1][m][0][j]; o1[j] = siluf_(acc[ai][0][m][1][j]) * acc[ai][1][m][1][j]; }
                *(u32x4*)(acts + row * 256 + u.pn * 128 + wc * 32 + 8 * fq) = pack8(o0, o1); }
            else if (wc < 2) { const int col = wc * 32 + 8 * fq; *(f32x4*)(logits + row * 64 + col) = acc[ai][0][m][0]; *(f32x4*)(logits + row * 64 + col + 4) = acc[ai][0][m][1]; } }
    } };

struct SchedUp { static constexpr bool PREFETCH = false; int G, c, nblk; const LAS int* blk_e; const int* tok; const char* H2; const char* W13;
    __device__ __forceinline__ bool next(int i, Unit& u) const { const int L = i * G + c; if (L >= 2 * nblk) return false; const int j = L >> 1, h = L & 1;
        const int e = __builtin_amdgcn_readfirstlane(blk_e[j]); u.pm = j; u.pn = h; u.aux = e; u.rows = tok + 2 * j * 256; u.A = H2; u.B = W13 + (size_t)(e * 2 + h) * 256 * 1024 * 2; return true; } };
struct EpiUp { static constexpr int ID = 11; static constexpr bool PERM = true; bf16_t* act; int sbx;
    __device__ __forceinline__ void operator()(const f32x4 (&acc)[2][2][4][2], const Unit& u_in, int wr, int wc, int fr_in, int fq_in) const {
        Unit u = u_in; asm volatile("" : "+s"(u.pm), "+s"(u.pn), "+s"(u.aux)); int fr = fr_in, fq = fq_in; asm volatile("" : "+v"(fr), "+v"(fq));
        EPI_FOR_ROWS { const size_t row = (size_t)u.pm * 256 + EPI_ROWL; f32x4 o0, o1;
            if (sbx & 8) { o0 = acc[ai][0][m][0] + acc[ai][1][m][0]; o1 = acc[ai][0][m][1] + acc[ai][1][m][1]; }
            else {
#pragma unroll
            for (int j = 0; j < 4; ++j) { o0[j] = siluf_(acc[ai][0][m][0][j]) * acc[ai][1][m][0][j]; o1[j] = siluf_(acc[ai][0][m][1][j]) * acc[ai][1][m][1][j]; } }
            const u32x4 w = pack8(o0, o1);
            if (sbx & 4) { asm volatile("" :: "v"(w)); } else *(u32x4*)(act + row * 256 + u.pn * 128 + wc * 32 + 8 * fq) = w; }
    } };

struct SchedDown { static constexpr bool PREFETCH = false; int G, c, nblk; const LAS int* blk_e; const char* act; const char* acts; const char* W2; const char* WS2;
    __device__ __forceinline__ bool next(int i, Unit& u) const { const int L = i * G + c; u.rows = nullptr; u.par = i % 3;
        if (L < 4 * nblk) { const int j = L >> 2, pn = L & 3; const int e = __builtin_amdgcn_readfirstlane(blk_e[j]); u.pm = j; u.pn = pn; u.aux = 0;
            u.A = act + (size_t)j * 256 * 256 * 2; u.B = W2 + (size_t)(e * 1024 + pn * 256) * 256 * 2; return true; }
        const int L2 = L - 4 * nblk; if (L2 >= 1024) return false; u.pm = L2 >> 2; u.pn = L2 & 3; u.aux = 1;
        u.A = acts + (size_t)u.pm * 256 * 256 * 2; u.B = WS2 + (size_t)u.pn * 256 * 256 * 2; return true; }
    const unsigned char* recb;
    __device__ __forceinline__ void prefetch(const Unit& u, int wid, int lane, LAS unsigned char* lds) const {
        if (u.aux == 0 && wid < 2) __builtin_amdgcn_global_load_lds((const unsigned*)(recb + ((size_t)u.pm * 256 + wid * 128 + lane * 2) * 8), (LAS unsigned*)(lds + RING_BYTES + 8192 + __builtin_amdgcn_readfirstlane(u.par) * 2048 + wid * 1024), 16, 0, 0); } };
struct EpiDown { static constexpr int ID = 12; static constexpr bool PERM = true; unsigned char* Yrb; unsigned char* Ys8;
    __device__ __forceinline__ void operator()(const f32x4 (&acc)[2][2][4][2], const Unit& u_in, int wr, int wc, int fr_in, int fq_in) const {
        Unit u = u_in; asm volatile("" : "+s"(u.pm), "+s"(u.pn), "+s"(u.aux)); int fr = fr_in, fq = fq_in; asm volatile("" : "+v"(fr), "+v"(fq));
        unsigned char* base = (u.aux == 0 ? Yrb : Ys8) + (size_t)u.pm * 256 * 1024 + u.pn * 256 + wc * 64 + fq * 16;
        EPI_FOR_ROWS { u32x4 w;
#pragma unroll
            for (int q = 0; q < 4; ++q) { const f32x4 v = acc[ai][q >> 1][m][q & 1] * 16.0f; int pk = 0;
                pk = __builtin_amdgcn_cvt_pk_fp8_f32(v.x, v.y, pk, false); pk = __builtin_amdgcn_cvt_pk_fp8_f32(v.z, v.w, pk, true); w[q] = (unsigned)pk; }
            *(u32x4*)(base + (size_t)EPI_ROWL * 1024) = w; }
    } };

__device__ __forceinline__ void p3_conv(Frame& F) {
    const bf16_t* P = WSP(bf16_t, WS_PROJC); bf16_t* Y = WSP(bf16_t, WS_YCAT);
    for (int chunk = F.blk * 8 + F.wave; chunk < NCHUNK; chunk += F.G * 8) {
        const int t0 = chunk * LCH;
        f32x4 w0[3], w1[3], w2[3], cb[3], gc[3], z1[3], z2[3];
#pragma unroll
        for (int j = 0; j < 3; ++j) { const int c0 = 4 * F.lane + 256 * j;
            w0[j] = *(const f32x4*)(F.conv_w + c0); w1[j] = *(const f32x4*)(F.conv_w + DCONV + c0); w2[j] = *(const f32x4*)(F.conv_w + 2 * DCONV + c0);
            cb[j] = *(const f32x4*)(F.conv_b + c0); gc[j] = *(const f32x4*)(F.g_conv + c0); z1[j] = (f32x4){0.f, 0.f, 0.f, 0.f}; z2[j] = z1[j]; }
        if ((t0 & (SEQ - 1)) != 0) {
#pragma unroll
            for (int j = 0; j < 3; ++j) { const int c0 = 4 * F.lane + 256 * j;
                const u32x2 za = *(const u32x2*)(P + (size_t)(t0 - 2) * 1536 + 768 + c0), zb = *(const u32x2*)(P + (size_t)(t0 - 1) * 1536 + 768 + c0);
                z2[j] = (f32x4){bflo(za.x), bfhi(za.x), bflo(za.y), bfhi(za.y)}; z1[j] = (f32x4){bflo(zb.x), bfhi(zb.x), bflo(zb.y), bfhi(zb.y)}; }
        }
        for (int tt = 0; tt < LCH; tt += 4) {
            u32x2 bw[4][3], zw[4][3];
#pragma unroll
            for (int q = 0; q < 4; ++q) { const size_t t = (size_t)t0 + tt + q;
#pragma unroll
                for (int j = 0; j < 3; ++j) { const int c0 = 4 * F.lane + 256 * j; bw[q][j] = *(const u32x2*)(P + t * 1536 + c0); zw[q][j] = *(const u32x2*)(P + t * 1536 + 768 + c0); } }
            f32x4 val[4][3]; float ss[4];
#pragma unroll
            for (int q = 0; q < 4; ++q) { float a = 0.f;
#pragma unroll
                for (int j = 0; j < 3; ++j) {
                    const f32x4 bg = (f32x4){bflo(bw[q][j].x), bfhi(bw[q][j].x), bflo(bw[q][j].y), bfhi(bw[q][j].y)};
                    const f32x4 z = (f32x4){bflo(zw[q][j].x), bfhi(zw[q][j].x), bflo(zw[q][j].y), bfhi(zw[q][j].y)};
                    val[q][j] = bg * (w0[j] * z2[j] + w1[j] * z1[j] + w2[j] * z + cb[j]); z2[j] = z1[j]; z1[j] = z;
                    a += (val[q][j].x * val[q][j].x + val[q][j].y * val[q][j].y) + (val[q][j].z * val[q][j].z + val[q][j].w * val[q][j].w); }
                ss[q] = a; }
#pragma unroll
            for (int o = 1; o < 64; o <<= 1) {
#pragma unroll
                for (int q = 0; q < 4; ++q) ss[q] += __shfl_xor(ss[q], o); }
#pragma unroll
            for (int q = 0; q < 4; ++q) { const size_t t = (size_t)t0 + tt + q; const float rstd = rsqrtf(ss[q] * (1.0f / DCONV) + RMS_EPS);
#pragma unroll
                for (int j = 0; j < 3; ++j) { const int c0 = 4 * F.lane + 256 * j; const f32x4 o = val[q][j] * rstd * gc[j];
                    *(u32x2*)(Y + t * 1024 + c0) = (u32x2){pk2(o.x, o.y), pk2(o.z, o.w)}; } }
        }
    }
}

__device__ __forceinline__ void p4_scan(Frame& F) {
    if (F.wave != 0) return;
    const float* S = WSP(float, WS_S); bf16_t* A2 = WSP(bf16_t, WS_A2);
    for (int bg = F.blk; bg < NB * NG; bg += F.G) { const int b = bg >> 4, g = bg & 15, p = F.lane;
        const f32x2 a = WSP(f32x2, WS_AB32)[g * 64 + p]; float xr = 0.f, xi = 0.f;
#pragma unroll 8
        for (int c = 0; c < 128; ++c) { const size_t chunk = (size_t)g * NCHUNK + b * 128 + c;
            *(unsigned*)(A2 + chunk * KA2 + KU + 2 * p) = pk2(xr, xi);
            const f32x2 s = *(const f32x2*)(S + chunk * 128 + 2 * p);
            const float nr = a.x * xr - a.y * xi + s.x, ni = a.x * xi + a.y * xr + s.y; xr = nr; xi = ni; }
    }
}

__device__ __forceinline__ void p7_post(Frame& F) {
    const float* mod = WSP(float, WS_MOD); const bf16_t* X1 = WSP(bf16_t, WS_X1); bf16_t* H2 = WSP(bf16_t, WS_H2);
    LAS float* scr = (LAS float*)(F.lds + EPI_OFF);
    VM_WAIT(); LDS_WAIT(); __syncthreads();
    if (F.blk >= 256) return;
    const int b = F.blk >> 4;
    f32x4 gf[4], sh[4], sc[4];
#pragma unroll
    for (int j = 0; j < 4; ++j) { const int c0 = 4 * F.lane + 256 * j; gf[j] = *(const f32x4*)(F.g_ffn + c0); sh[j] = *(const f32x4*)(mod + b * 6144 + 3072 + c0); sc[j] = *(const f32x4*)(mod + b * 6144 + 4096 + c0) + 1.0f; gf[j] = gf[j] * sc[j]; }
    for (int i = 0; i < 32; i += 4) {
        u32x2 xw[4][4]; float rstd[4];
#pragma unroll
        for (int q = 0; q < 4; ++q) { const int rl = F.wave * 32 + i + q; const size_t row = (size_t)F.blk * 256 + rl;
#pragma unroll
            for (int j = 0; j < 4; ++j) xw[q][j] = *(const u32x2*)(X1 + row * 1024 + 4 * F.lane + 256 * j);
            float tot = 0.f;
#pragma unroll
            for (int p = 0; p < 4; ++p) { const f32x4 pq = *(const LAS f32x4*)(scr + rl * 16 + 4 * p); tot += (pq.x + pq.y) + (pq.z + pq.w); }
            rstd[q] = rsqrtf(tot * (1.0f / D) + RMS_EPS); }
#pragma unroll
        for (int q = 0; q < 4; ++q) { const size_t row = (size_t)F.blk * 256 + F.wave * 32 + i + q;
#pragma unroll
            for (int j = 0; j < 4; ++j) { const int c0 = 4 * F.lane + 256 * j;
                const f32x4 xv = (f32x4){bflo(xw[q][j].x), bfhi(xw[q][j].x), bflo(xw[q][j].y), bfhi(xw[q][j].y)};
                const f32x4 h = xv * rstd[q] * gf[j] + sh[j];
                *(u32x2*)(H2 + row * 1024 + c0) = (u32x2){pk2(h.x, h.y), pk2(h.z, h.w)}; } }
    }
}

__device__ __forceinline__ void p9_topk(Frame& F) {
    const float* LG = WSP(float, WS_LOGITS); unsigned char* R = F.ws + WS_ROUTE;
    int* sele = (int*)(R + RT_SELE); float* selw = (float*)(R + RT_SELW); int* cntw = (int*)(R + RT_CNTW); int* cntb = (int*)(R + RT_CNTB);
    u32x2* rec = (u32x2*)(R + RT_REC);
    LAS int* lcnt = (LAS int*)F.lds;
    const float NEG = -INFINITY;
    for (int blk = F.blk; blk < 256; blk += F.G) {
        for (int i = F.tid; i < MAXBLK; i += 512) rec[blk * MAXBLK + i] = (u32x2){0xffffffffu, 0u};
        if (F.wave < 4) {
            const int tok = blk * 256 + F.tid;
            float s[64], bb[64];
#pragma unroll
            for (int q = 0; q < 16; ++q) { const f32x4 lg = *(const f32x4*)(LG + (size_t)tok * 64 + 4 * q);
#pragma unroll
                for (int j = 0; j < 4; ++j) { s[4 * q + j] = sigmoidf_(lg[j]); bb[4 * q + j] = s[4 * q + j] + F.router_bias[4 * q + j]; } }
            float gs[8];
#pragma unroll
            for (int g = 0; g < 8; ++g) { float m1 = NEG, m2 = NEG;
#pragma unroll
                for (int j = 0; j < 8; ++j) { const float v = bb[8 * g + j]; if (v > m1) { m2 = m1; m1 = v; } else if (v > m2) { m2 = v; } }
                gs[g] = m1 + m2; }
            unsigned gsel = 0u;
#pragma unroll
            for (int g = 0; g < 8; ++g) { int rk = 0;
#pragma unroll
                for (int g2 = 0; g2 < 8; ++g2) rk += (gs[g2] > gs[g] || (gs[g2] == gs[g] && g2 < g)) ? 1 : 0;
                gsel |= (rk < 4) ? (1u << g) : 0u; }
#pragma unroll
            for (int e = 0; e < 64; ++e) bb[e] = ((gsel >> (e >> 3)) & 1u) ? bb[e] : NEG;
            int ek[6]; float sk[6]; unsigned long long taken = 0ull; float ssum = 0.f;
#pragma unroll
            for (int k = 0; k < 6; ++k) { float best = NEG, bs = 0.f; int bi = 0;
#pragma unroll
                for (int e = 0; e < 64; ++e) { const bool c = (((taken >> e) & 1ull) == 0ull) && (bb[e] > best); best = c ? bb[e] : best; bs = c ? s[e] : bs; bi = c ? e : bi; }
                ek[k] = bi; sk[k] = bs; taken |= 1ull << bi; ssum += bs; }
            int rk[6] = {0, 0, 0, 0, 0, 0}; int mycnt = 0;
#pragma unroll
            for (int e = 0; e < 64; ++e) { const bool hit = ((taken >> e) & 1ull) != 0ull; const unsigned long long m = __ballot(hit);
                const int pre = __builtin_amdgcn_mbcnt_hi((unsigned)(m >> 32), __builtin_amdgcn_mbcnt_lo((unsigned)m, 0u));
#pragma unroll
                for (int k = 0; k < 6; ++k) rk[k] = (ek[k] == e) ? pre : rk[k];
                mycnt = (F.lane == e) ? __popcll(m) : mycnt; }
            const float inv = 2.5f / ssum;
#pragma unroll
            for (int k = 0; k < 6; ++k) { sele[(size_t)tok * 6 + k] = ek[k] | (rk[k] << 8); selw[(size_t)tok * 6 + k] = sk[k] * inv; }
            cntw[(blk * 4 + F.wave) * 64 + F.lane] = mycnt; lcnt[F.wave * 64 + F.lane] = mycnt;
        }
        else if (blk == F.blk) tr_w13(F, F.vcu * 4 + (F.wave - 4), F.G * 4);
        __syncthreads();
        if (F.tid < 64) cntb[blk * 64 + F.tid] = (lcnt[F.tid] + lcnt[64 + F.tid]) + (lcnt[128 + F.tid] + lcnt[192 + F.tid]);
        __syncthreads();
    }
}

__device__ __forceinline__ void p10_scatter(Frame& F) {
    unsigned char* R = F.ws + WS_ROUTE;
    const int* sele = (const int*)(R + RT_SELE); const float* selw = (const float*)(R + RT_SELW); const int* cntw = (const int*)(R + RT_CNTW); const int* cntb = (const int*)(R + RT_CNTB);
    u32x2* rec = (u32x2*)(R + RT_REC);
    LAS int* ptot = (LAS int*)F.lds; LAS int* ppre = ptot + 512; LAS int* pst = ppre + 512; LAS int* pad = pst + 64; LAS int* base = pad + 64;
    for (int blk = F.blk; blk < 256; blk += F.G) {
        { const int p8 = F.tid >> 6, e = F.tid & 63; int tot = 0, pre = 0;
          for (int b2 = 32 * p8; b2 < 32 * p8 + 32; ++b2) { const int c = cntb[b2 * 64 + e]; tot += c; pre += (b2 < blk) ? c : 0; }
          ptot[p8 * 64 + e] = tot; ppre[p8 * 64 + e] = pre; }
        __syncthreads();
        if (F.tid < 64) { const int e = F.tid; int total = 0, bb = 0;
#pragma unroll
            for (int q = 0; q < 8; ++q) { total += ptot[q * 64 + e]; bb += ppre[q * 64 + e]; }
            const int padded = (total + 255) & ~255; int v = padded;
#pragma unroll
            for (int o = 1; o < 64; o <<= 1) { const int tv = __shfl_up(v, o); if (e >= o) v += tv; }
            const int pstart = v - padded; pst[e] = pstart; pad[e] = padded;
            int run = pstart + bb;
#pragma unroll
            for (int w = 0; w < 4; ++w) { base[w * 64 + e] = run; run += cntw[(blk * 4 + w) * 64 + e]; }
            if (blk == 0 && e == 63) { const int nblk = (pstart + padded) >> 8; __hip_atomic_store(WSP(int, WS_CTL) + CW_NBLK, nblk, __ATOMIC_RELAXED, __HIP_MEMORY_SCOPE_AGENT); } }
        __syncthreads();
        for (int a = F.tid; a < 256 * TOPK; a += 512) { const int tl = a / 6, k = a - tl * 6, tok = blk * 256 + tl, w = tl >> 6;
            const int se = sele[(size_t)tok * 6 + k]; const int e = se & 255, r = se >> 8; const int dest = base[w * 64 + e] + r;
            rec[dest] = (u32x2){(unsigned)(tok | (k << 16)), 0u}; ((int*)(R + RT_TDEST))[(size_t)tok * 6 + k] = dest; }
        { const int nblk = (pst[63] + pad[63]) >> 8; int* blke = WSP(int, WS_BLKE);
            if (F.tid < 8) { const int j = blk * 8 + F.tid; if (j < nblk) { const int r0 = j * 256; int e = 0;
                for (int q = 0; q < 64; ++q) if (pad[q] > 0 && pst[q] <= r0 && r0 < pst[q] + pad[q]) e = q;
                blke[j] = e; } } }
        __syncthreads();
    }
}

__device__ __forceinline__ void p13_final(Frame& F) {
    const float* mod = WSP(float, WS_MOD); const bf16_t* X1 = WSP(bf16_t, WS_X1); const unsigned char* Yrb = F.ws + WS_Y4; const unsigned char* Ys8 = F.ws + WS_YS8;
    const int* tdest = (const int*)(F.ws + WS_ROUTE + RT_TDEST); const float* selw = (const float*)(F.ws + WS_ROUTE + RT_SELW);
    const int NGW = F.G * 8, c0 = 16 * F.lane;
    for (int t0 = F.blk * 8 + F.wave; t0 < T; t0 += 2 * NGW) {
        u32x4 yw[2][NSLOT], xw[2][2]; float wk[2][6];
#pragma unroll
        for (int q = 0; q < 2; ++q) { const size_t t = (size_t)t0 + (size_t)q * NGW;
            const int li = F.lane < 6 ? F.lane : 0; const int dv = tdest[t * 6 + li]; const float wv = selw[t * 6 + li];
#pragma unroll
            for (int k = 0; k < 6; ++k) { const int d = __builtin_amdgcn_readlane(dv, k); wk[q][k] = __builtin_bit_cast(float, __builtin_amdgcn_readlane(__builtin_bit_cast(int, wv), k));
                yw[q][k] = *(const u32x4*)(Yrb + (size_t)d * 1024 + c0); }
            yw[q][6] = *(const u32x4*)(Ys8 + t * 1024 + c0);
            xw[q][0] = *(const u32x4*)(X1 + t * 1024 + c0); xw[q][1] = *(const u32x4*)(X1 + t * 1024 + c0 + 8); }
        f32x4 v[2][4]; float ss[2];
#pragma unroll
        for (int q = 0; q < 2; ++q) { const int b = (t0 + q * NGW) >> 12; float a = 0.f;
#pragma unroll
            for (int j = 0; j < 4; ++j) { f32x4 ys = (f32x4){0.f, 0.f, 0.f, 0.f};
#pragma unroll
                for (int k = 0; k < NSLOT; ++k) { const f32x2 lo = __builtin_amdgcn_cvt_pk_f32_fp8((int)yw[q][k][j], false), hi = __builtin_amdgcn_cvt_pk_f32_fp8((int)yw[q][k][j], true);
                    const float w_ = k < 6 ? wk[q][k < 6 ? k : 0] : 1.0f; ys += (f32x4){lo.x, lo.y, hi.x, hi.y} * w_; }
                const f32x4 g2 = *(const f32x4*)(mod + b * 6144 + 5120 + c0 + 4 * j) * 0.0625f;
                const unsigned w0 = xw[q][j >> 1][(j & 1) * 2], w1 = xw[q][j >> 1][(j & 1) * 2 + 1];
                v[q][j] = (f32x4){bflo(w0), bfhi(w0), bflo(w1), bfhi(w1)} + g2 * ys;
                a += (v[q][j].x * v[q][j].x + v[q][j].y * v[q][j].y) + (v[q][j].z * v[q][j].z + v[q][j].w * v[q][j].w); }
            ss[q] = a; }
#pragma unroll
        for (int o = 1; o < 64; o <<= 1) { ss[0] += __shfl_xor(ss[0], o); ss[1] += __shfl_xor(ss[1], o); }
#pragma unroll
        for (int q = 0; q < 2; ++q) { const size_t t = (size_t)t0 + (size_t)q * NGW; const float rstd = rsqrtf(ss[q] * (1.0f / D) + RMS_EPS);
#pragma unroll
            for (int j = 0; j < 4; ++j) { const f32x4 gf = *(const f32x4*)(F.g_final + c0 + 4 * j);
                *(f32x4*)(F.out + t * 1024 + c0 + 4 * j) = v[q][j] * rstd * gf; } }
    }
}

#ifndef STAGGER
#define STAGGER 0
#endif
__device__ __forceinline__ void phase_stagger(Frame& F, int unit_ticks) {
#if STAGGER
    const unsigned long long t0 = __builtin_amdgcn_s_memrealtime(); const unsigned long long wait = (unsigned long long)(((F.blk >> 3) & 3) * unit_ticks / 4);
    while (__builtin_amdgcn_s_memrealtime() - t0 < wait) __builtin_amdgcn_s_sleep(16);
#endif
}
constexpr int N_PHASES = 14;
template <int K, int SBX = 0> __device__ __forceinline__ void run_phase(Frame& F) {
    LAS unsigned char* ring = F.lds; LAS float* escr = (LAS float*)(F.lds + EPI_OFF);
    if constexpr (K == 0) { if (F.blk < 192) p0_mod(F); }
    if constexpr (K == 1) { p0_prologue(F); p1_h(F); }
    if constexpr (K == 2) {
        SchedG1 S; S.o.init(256, 10, F.G, F.blk); S.A = (const char*)WSP(bf16_t, WS_H); S.B = (const char*)WSP(bf16_t, WS_WIN_T);
        EpiG1 E{WSP(bf16_t, WS_PROJC), WSP(bf16_t, WS_A2)};
        phase_stagger(F, 2800);
        pg8::gemm_phase<EpiG1, SchedG1, false, true>(ring, pg8::Desc{1024, 1024, 1024, SBX}, S, E);
    }
    if constexpr (K == 3) {
        p3_conv(F); __syncthreads();
        SchedS5a S{F.G, F.blk, (const char*)WSP(bf16_t, WS_A2), (const char*)WSP(bf16_t, WS_T1)}; EpiS5a E{WSP(float, WS_S)};
        pg8::gemm_phase<EpiS5a, SchedS5a, false, false>(ring, pg8::Desc{KA2, KU, KU, SBX}, S, E);
    }
    if constexpr (K == 4) { if (F.wave == 0) p4_scan(F); else tr_w2(F, F.vcu * 7 + (F.wave - 1), F.G * 7); }
    if constexpr (K == 5) {
        SchedS5b S{F.G, F.blk, (const char*)WSP(bf16_t, WS_A2), (const char*)WSP(bf16_t, WS_T2)}; EpiS5b E{WSP(bf16_t, WS_YS)};
        pg8::gemm_phase<EpiS5b, SchedS5b, false, false>(ring, pg8::Desc{KA2, KA2, KA2, SBX}, S, E);
    }
    if constexpr (K == 6) {
        SchedGlu S{F.G, F.blk, (const char*)WSP(bf16_t, WS_YS), (const char*)WSP(bf16_t, WS_WGLU_T)};
        EpiGlu E{WSP(bf16_t, WS_YS), F.b_glu, F.g_ssm, WSP(bf16_t, WS_YCAT), escr};
        pg8::gemm_phase<EpiGlu, SchedGlu, false, true>(ring, pg8::Desc{256, 256, 256, SBX}, S, E);
    }
    if constexpr (K == 7) {
        SchedG2 S{F.blk, (const char*)WSP(bf16_t, WS_YCAT), (const char*)WSP(bf16_t, WS_WOUT_T)};
        EpiG2 E{F.x, WSP(float, WS_MOD), WSP(bf16_t, WS_X1), escr};
        pg8::gemm_phase<EpiG2, SchedG2, false, true>(ring, pg8::Desc{1024, 1024, 1024, SBX}, S, E);
        p7_post(F);
    }
    if constexpr (K == 8) {
        SchedRS S; S.o.init(256, 3, F.G, F.blk); S.A = (const char*)WSP(bf16_t, WS_H2); S.B = (const char*)WSP(bf16_t, WS_WSR_T);
        EpiRS E{WSP(bf16_t, WS_ACTS), WSP(float, WS_LOGITS)};
        pg8::gemm_phase<EpiRS, SchedRS, false, true>(ring, pg8::Desc{1024, 1024, 1024, SBX}, S, E);
    }
    if constexpr (K == 9) { p9_topk(F); }
    if constexpr (K == 10) { p10_scatter(F); }
    if constexpr (K == 11) {
        const int nblk = __builtin_amdgcn_readfirstlane(ld_i32_agent(WSP(int, WS_CTL) + CW_NBLK));
        { LAS int* tb = (LAS int*)(F.lds + EPI_OFF); for (int j = F.tid; j < nblk; j += 512) tb[j] = ld_i32_agent(WSP(int, WS_BLKE) + j); __syncthreads(); }
        SchedUp S{F.G, F.vcu, nblk, (const LAS int*)(F.lds + EPI_OFF), (const int*)(F.ws + WS_ROUTE + RT_REC), (const char*)WSP(bf16_t, WS_H2), (const char*)WSP(bf16_t, WS_W13T)};
        EpiUp E{WSP(bf16_t, WS_ACT), SBX};
        phase_stagger(F, 2800);
        pg8::gemm_phase<EpiUp, SchedUp, true, true>(ring, pg8::Desc{1024, 1024, 1024, SBX}, S, E);
    }
    if constexpr (K == 12) {
        const int nblk = __builtin_amdgcn_readfirstlane(ld_i32_agent(WSP(int, WS_CTL) + CW_NBLK));
        { LAS int* tb = (LAS int*)(F.lds + EPI_OFF); for (int j = F.tid; j < nblk; j += 512) tb[j] = ld_i32_agent(WSP(int, WS_BLKE) + j); __syncthreads(); }
        SchedDown S{F.G, F.vcu, nblk, (const LAS int*)(F.lds + EPI_OFF), (const char*)WSP(bf16_t, WS_ACT), (const char*)WSP(bf16_t, WS_ACTS), (const char*)WSP(bf16_t, WS_W2T), (const char*)WSP(bf16_t, WS_WS2_T), F.ws + WS_ROUTE + RT_REC};
        EpiDown E{F.ws + WS_Y4, F.ws + WS_YS8};
        phase_stagger(F, 900);
        pg8::gemm_phase<EpiDown, SchedDown, false, true>(ring, pg8::Desc{256, 256, 256, SBX}, S, E);
    }
    if constexpr (K == 13) { p13_final(F); }
}
#ifndef REP_PHASE
#define REP_PHASE -1
#endif
#ifndef PH_MASK
#define PH_MASK 0xFFFF
#endif
#ifndef USE_CG_FIRST
#define USE_CG_FIRST 0
#endif
template <int K> __device__ __forceinline__ void grid_sync(Frame& F) {
#if MK_N_LAUNCHES == 1
    if constexpr (K == 0 && USE_CG_FIRST) cg::this_grid().sync(); else xcd_barrier(F.bar);
#endif
}
template <int K> __device__ __forceinline__ void phase_and_seam(Frame& F, int lo, int hi) {
    if (((PH_MASK >> K) & 1) && lo <= K && K < hi) {
        run_phase<K>(F);
        if constexpr (K == REP_PHASE) { grid_sync<K>(F); run_phase<K>(F); }
        if (K + 1 < hi) grid_sync<K>(F);
    }
}
__global__ void __launch_bounds__(512, 2) mk_fwd(Args args) {
    extern __shared__ __attribute__((aligned(16))) unsigned char lds_raw[];
    Frame F;
    F.lds = (LAS unsigned char*)lds_raw; F.tid = threadIdx.x; F.lane = F.tid & 63; F.wave = __builtin_amdgcn_readfirstlane(F.tid >> 6);
    F.blk = blockIdx.x; F.G = gridDim.x; F.vcu = (F.G % 8 == 0) ? (F.blk % 8) * (F.G / 8) + F.blk / 8 : F.blk;
    { const float* const* in = args.in;
      F.x = in[0]; F.c = in[1]; F.w_ada = in[2]; F.b_ada = in[3]; F.g_mix = in[4]; F.w_in = in[5]; F.conv_w = in[6]; F.conv_b = in[7]; F.g_conv = in[8];
      F.lam_re = in[9]; F.lam_im = in[10]; F.log_dt = in[11]; F.b_re = in[12]; F.b_im = in[13]; F.c_re = in[14]; F.c_im = in[15]; F.d_skip = in[16];
      F.w_glu = in[17]; F.b_glu = in[18]; F.g_ssm = in[19]; F.w_out = in[20]; F.g_ffn = in[21]; F.w_router = in[22]; F.router_bias = in[23];
      F.w1 = in[24]; F.w3 = in[25]; F.w2 = in[26]; F.ws1 = in[27]; F.ws3 = in[28]; F.ws2 = in[29]; F.g_final = in[30]; }
    F.out = args.out; F.ws = args.ws;
    const int lo = args.ph_lo, hi = args.ph_hi;
    if (F.tid < 64) ((LAS unsigned*)(F.lds + MISC_OFF))[F.tid] = 0u;
    __syncthreads();
    F.bar = xcd_barrier_post((unsigned*)(F.ws + WS_CTL) + CW_BAR, (volatile LAS unsigned*)(F.lds + MISC_OFF) + 8);
    phase_and_seam<0>(F, lo, hi); phase_and_seam<1>(F, lo, hi); phase_and_seam<2>(F, lo, hi); phase_and_seam<3>(F, lo, hi);
    phase_and_seam<4>(F, lo, hi); phase_and_seam<5>(F, lo, hi); phase_and_seam<6>(F, lo, hi); phase_and_seam<7>(F, lo, hi);
    phase_and_seam<8>(F, lo, hi); phase_and_seam<9>(F, lo, hi); phase_and_seam<10>(F, lo, hi); phase_and_seam<11>(F, lo, hi);
    phase_and_seam<12>(F, lo, hi); phase_and_seam<13>(F, lo, hi);
#ifdef SANDBOX_PHASE
    grid_sync<13>(F); run_phase<SANDBOX_PHASE, SANDBOX_FLAGS>(F);
#endif
}

extern "C" void kernel_launch(void* const* d_in, const int* in_sizes, int n_in, void* d_out, int out_size, void* d_ws, size_t ws_size, hipStream_t stream) {
    static int grid = 0;
    if (grid == 0) {
        if (n_in != 31 || in_sizes[0] != T * D || out_size != T * D || ws_size < WS_END) { fprintf(stderr, "kernel_launch: unexpected shapes (n_in %d, in0 %d, out %d, ws %zu)\n", n_in, n_in > 0 ? in_sizes[0] : -1, out_size, ws_size); grid = -1; return; }
        int dev = 0, cus = 0, per_cu = 0;
        if (hipGetDevice(&dev) != hipSuccess || hipDeviceGetAttribute(&cus, hipDeviceAttributeMultiprocessorCount, dev) != hipSuccess) { grid = -1; return; }
        if (hipFuncSetAttribute((const void*)mk_fwd, hipFuncAttributeMaxDynamicSharedMemorySize, LDS_BYTES) != hipSuccess) { fprintf(stderr, "kernel_launch: hipFuncSetAttribute failed\n"); grid = -1; return; }
        if (hipOccupancyMaxActiveBlocksPerMultiprocessor(&per_cu, (const void*)mk_fwd, 512, LDS_BYTES) != hipSuccess || per_cu < 1) { fprintf(stderr, "kernel_launch: occupancy query gives %d\n", per_cu); per_cu = 1; }
        (void)hipGetLastError();
        grid = cus;
        if (grid > 256) grid = 256;
    }
    if (grid < 0) return;
    (void)hipMemsetAsync((char*)d_ws + WS_CTL, 0, CTL_ZERO_BYTES, stream);
    Args a{};
    for (int i = 0; i < 31; ++i) a.in[i] = (const float*)d_in[i];
    a.out = (float*)d_out; a.ws = (unsigned char*)d_ws;
#if MK_N_LAUNCHES == 1
    a.ph_lo = 0; a.ph_hi = N_PHASES;
    void* kargs[] = {&a};
    hipError_t e = hipLaunchCooperativeKernel((const void*)mk_fwd, dim3(grid), dim3(512), kargs, LDS_BYTES, stream);
    if (e != hipSuccess) fprintf(stderr, "kernel_launch: cooperative launch failed: %s (grid %d)\n", hipGetErrorString(e), grid);
#else
    for (int p = 0; p < N_PHASES; ++p) { a.ph_lo = p; a.ph_hi = p + 1; hipLaunchKernelGGL(mk_fwd, dim3(grid), dim3(512), LDS_BYTES, stream, a); }
#endif
}
```

```cpp
#include <hip/hip_runtime.h>
#include <hip/hip_cooperative_groups.h>
#include <cstdio>
#include <cstdint>
namespace cg = cooperative_groups;

#ifndef MK_N_LAUNCHES
#define MK_N_LAUNCHES 1
#endif

#define LAS __attribute__((address_space(3)))
typedef unsigned short bf16_t;
typedef short bf16x8 __attribute__((ext_vector_type(8)));
typedef float f32x4 __attribute__((ext_vector_type(4)));
typedef float f32x2 __attribute__((ext_vector_type(2)));
typedef unsigned u32x4 __attribute__((ext_vector_type(4)));
typedef unsigned u32x2 __attribute__((ext_vector_type(2)));
typedef int i32x8 __attribute__((ext_vector_type(8)));

constexpr int NB = 16, SEQ = 4096, D = 1024, T = NB * SEQ;
constexpr int DCONV = 768, DSSM = 256, DIN = 2560, NG = 16, GC = 16, NP = 64;
constexpr int NE = 64, TOPK = 6, DE = 256, NSLOT = 7;
constexpr int LCH = 32;
constexpr int NCHUNK = T / LCH;
constexpr int KU = LCH * GC;
constexpr int KA2 = KU + 2 * NP;
constexpr int MAXBLK = 1600;
constexpr float RMS_EPS = 1e-6f;

constexpr size_t MiB = 1u << 20, KiB = 1u << 10;
constexpr size_t WS_CTL = 0;
constexpr size_t WS_MOD = 64 * KiB;
constexpr size_t WS_AB32 = 448 * KiB;
constexpr size_t WS_BLKE = 512 * KiB;
constexpr size_t WS_WIN_T = 1 * MiB;
constexpr size_t WS_WOUT_T = 6 * MiB;
constexpr size_t WS_WGLU_T = 8 * MiB;
constexpr size_t WS_WS2_T = 8 * MiB + 512 * KiB;
constexpr size_t WS_WSR_T = 9 * MiB;
constexpr size_t WS_T1 = 11 * MiB;
constexpr size_t WS_T2 = 15 * MiB;
constexpr size_t WS_W13T = 25 * MiB;
constexpr size_t WS_W2T = 89 * MiB;
constexpr size_t WS_WRB = 105 * MiB;
constexpr size_t WS_BIASR = 520 * KiB;
constexpr size_t WS_H = 128 * MiB;
constexpr size_t WS_X1 = 128 * MiB;
constexpr size_t WS_PROJC = 256 * MiB;
constexpr size_t WS_ACT = 256 * MiB;
constexpr size_t WS_ACTS = 456 * MiB;
constexpr size_t WS_ROUTE = 488 * MiB;
constexpr size_t WS_H2 = 512 * MiB;
constexpr size_t WS_Y4 = 512 * MiB;
constexpr size_t WS_YS8 = 912 * MiB;
constexpr size_t WS_YCAT = 640 * MiB;
constexpr size_t WS_LOGITS = 640 * MiB;
constexpr size_t WS_A2 = 768 * MiB;
constexpr size_t WS_S = 808 * MiB;
constexpr size_t WS_YS = 824 * MiB;
constexpr size_t WS_H2F8 = 768 * MiB;
constexpr size_t WS_END = 1024 * MiB;
constexpr size_t RT_SELE = 0;
constexpr size_t RT_SELW = 2 * MiB;
constexpr size_t RT_CNTW = 4 * MiB;
constexpr size_t RT_CNTB = 5 * MiB;
constexpr size_t RT_TDEST = 12 * MiB;
constexpr size_t RT_REC = 6 * MiB;
constexpr int CW_NBLK = 16;
constexpr int CW_BAR = 1024;
constexpr size_t CTL_ZERO_BYTES = 32 * KiB;

constexpr int RING_BYTES = 131072;
constexpr int EPI_OFF = RING_BYTES;
constexpr int MISC_OFF = EPI_OFF + 16384;
constexpr int LDS_BYTES = 148480;

__device__ __forceinline__ unsigned f2bf(float f) { unsigned u = __builtin_bit_cast(unsigned, f); return (u + 0x7fffu + ((u >> 16) & 1u)) >> 16; }
typedef __bf16 bf16x2_t __attribute__((ext_vector_type(2)));
__device__ __forceinline__ unsigned pk2(float lo, float hi) { const f32x2 v = {lo, hi}; const bf16x2_t b = __builtin_convertvector(v, bf16x2_t); return __builtin_bit_cast(unsigned, b); }
__device__ __forceinline__ unsigned pk4_fp8(float a, float b, float c, float d) { int pk = 0; pk = __builtin_amdgcn_cvt_pk_fp8_f32(a, b, pk, false); pk = __builtin_amdgcn_cvt_pk_fp8_f32(c, d, pk, true); return (unsigned)pk; }
__device__ __forceinline__ float bflo(unsigned w) { return __builtin_bit_cast(float, w << 16); }
__device__ __forceinline__ float bfhi(unsigned w) { return __builtin_bit_cast(float, w & 0xffff0000u); }
__device__ __forceinline__ float bf2f(bf16_t b) { return __builtin_bit_cast(float, (unsigned)b << 16); }
__device__ __forceinline__ float fexp_(float v) { return __builtin_amdgcn_exp2f(v * 1.4426950408889634f); }
__device__ __forceinline__ float sigmoidf_(float v) { return __builtin_amdgcn_rcpf(1.0f + fexp_(-v)); }
__device__ __forceinline__ float siluf_(float v) { return v * __builtin_amdgcn_rcpf(1.0f + fexp_(-v)); }
__device__ __forceinline__ float gelu_tanh(float v) {
    const float z = 0.7978845608028654f * (v + 0.044715f * v * v * v);
    const float e = fexp_(2.0f * z);
    const float th = 1.0f - 2.0f * __builtin_amdgcn_rcpf(e + 1.0f);
    return 0.5f * v * (1.0f + th);
}
__device__ __forceinline__ float wave_sum(float v) {
#pragma unroll
    for (int o = 1; o < 64; o <<= 1) v += __shfl_xor(v, o);
    return v;
}
__device__ __forceinline__ int ld_i32_agent(const int* p) { return __hip_atomic_load(p, __ATOMIC_RELAXED, __HIP_MEMORY_SCOPE_AGENT); }


#define XB_TMO      128
#define XB_XCNT(j)  (256  + 64 * (j))
#define XB_XSUB(j)  (1280 + 64 * (j))
#define XB_XGEN(j)  (2304 + 64 * (j))
#define XB_TOP      3328
#define XB_TOPGEN   3392
#define XCD_BAR_WORDS 3456
#define XB_SPIN_CAP (1u << 22)
__device__ __forceinline__ unsigned xb_ld(unsigned* p)              { return __hip_atomic_load(p, __ATOMIC_RELAXED, __HIP_MEMORY_SCOPE_AGENT); }
__device__ __forceinline__ unsigned xb_add(unsigned* p, unsigned v) { return __hip_atomic_fetch_add(p, v, __ATOMIC_RELAXED, __HIP_MEMORY_SCOPE_AGENT); }
__device__ __forceinline__ unsigned xb_xcc_id() { return (unsigned)__builtin_amdgcn_s_getreg((3 << 11) | 20) & 0xFu; }
#define XB_SPIN(cond, bar) do { unsigned _sp = 0; while (cond) { __builtin_amdgcn_s_sleep(1); \
    if ((++_sp & 255u) == 0u) { if (xb_ld(&(bar)[XB_TMO])) break; if (_sp > XB_SPIN_CAP) { atomicAdd(&(bar)[XB_TMO], 1u); break; } } } } while (0)
struct XcdBarrier { unsigned* bar; unsigned x; volatile LAS unsigned* st; };
__device__ __forceinline__ XcdBarrier xcd_barrier_post(unsigned* bar, volatile LAS unsigned* st) {
    XcdBarrier b; b.bar = bar; b.x = xb_xcc_id(); b.st = st;
    if (threadIdx.x == 0) (void)xb_add(&bar[XB_XCNT(b.x)], 1u);
    return b;
}
__device__ __forceinline__ void xcd_barrier_complete(unsigned* bar, unsigned x, unsigned& nloc, unsigned& nx) {
    const unsigned G = gridDim.x * gridDim.y * gridDim.z;
    unsigned sum, cnt, mine, sp = 0u;
    for (;;) {
        sum = 0u; cnt = 0u; mine = 0u;
#pragma unroll
        for (unsigned j = 0; j < 16; ++j) { const unsigned c = xb_ld(&bar[XB_XCNT(j)]); sum += c; cnt += (c > 0u) ? 1u : 0u; mine = (j == x) ? c : mine; }
        if (sum == G) break;
        __builtin_amdgcn_s_sleep(1);
        if ((++sp & 255u) == 0u) { if (xb_ld(&bar[XB_TMO])) break; if (sp > XB_SPIN_CAP) { atomicAdd(&bar[XB_TMO], 1u); break; } }
    }
    nloc = mine > 0u ? mine : 1u; nx = cnt > 0u ? cnt : 1u;
}
__device__ __forceinline__ void xcd_barrier(const XcdBarrier& b) {
    asm volatile("s_waitcnt vmcnt(0)" ::: "memory");
    __syncthreads();
    if (threadIdx.x == 0) {
        unsigned* bar = b.bar;
        __builtin_amdgcn_s_waitcnt(0);
        unsigned nloc = b.st[0], nx = b.st[1];
        if (nloc == 0u) { xcd_barrier_complete(bar, b.x, nloc, nx); b.st[0] = nloc; b.st[1] = nx; }
        const unsigned old = xb_add(&bar[XB_XSUB(b.x)], 1u);
        const unsigned gen = old / nloc;
        if (old + 1u == (gen + 1u) * nloc) {
            __builtin_amdgcn_fence(__ATOMIC_RELEASE, "agent");
            asm volatile("s_waitcnt vmcnt(0)" ::: "memory");
            const unsigned og = xb_add(&bar[XB_TOP], 1u);
            const unsigned tg = og / nx;
            if (og + 1u == (tg + 1u) * nx) xb_add(&bar[XB_TOPGEN], 1u);
            else XB_SPIN(xb_ld(&bar[XB_TOPGEN]) == tg, bar);
            __builtin_amdgcn_fence(__ATOMIC_ACQUIRE, "agent");
            xb_add(&bar[XB_XGEN(b.x)], 1u);
            asm volatile("s_waitcnt vmcnt(0)" ::: "memory");
        } else {
            XB_SPIN(xb_ld(&bar[XB_XGEN(b.x)]) == gen, bar);
            __builtin_amdgcn_fence(__ATOMIC_ACQUIRE, "agent");
            asm volatile("s_waitcnt vmcnt(0)" ::: "memory");
        }
    }
    __syncthreads();
}

namespace pg8 {
constexpr int BM = 256, BK = 64, HALF = 128, HTB = HALF * BK * 2, STAGE_BYTES = 8 * HTB;
__device__ __forceinline__ int lds_byte(int r, int c) { const int st = (r >> 4) * 2 + (c >> 5), rr = r & 15, cc = c & 31, ob = rr * 64 + cc * 2; return st * 1024 + (ob ^ (((ob >> 9) & 1) << 5)); }
__device__ __forceinline__ void stage_rc(int b, int& R, int& C) { const int st = b / 1024, sb = b % 1024, swz = sb ^ (((sb >> 9) & 1) << 5); R = (st >> 1) * 16 + swz / 64; C = (st & 1) * 32 + (swz % 64) / 2; }
__device__ __forceinline__ int perm32(int rho) { const int n = rho >> 4, i = rho & 15; return 8 * (i >> 2) + 4 * n + (i & 3); }

struct Unit { const char* A; const char* B; const int* rows; int pm, pn, aux, par; };
struct Desc { int lda, ldb, K; int sbx = 0; int sclB = 0x7f7f7f7f, sclA = 0x7f7f7f7f; };

template <class Epi, class Sched, bool GATHER, bool ALIGN_EPI, bool FP8 = false, bool NT2 = false, bool NARROW = false>
__device__ __forceinline__ void gemm_phase(LAS unsigned char* lds, const Desc g, const Sched& S, const Epi& E) {
    int tid = threadIdx.x; asm volatile("" : "+v"(tid));
    const int wid = __builtin_amdgcn_readfirstlane(tid >> 6), lane = tid & 63, wr = wid >> 2, wc = wid & 3, fr = lane & 15, fq = lane >> 4;
    const int K = g.K, nt = K / BK;
    int Rr[2], Cc[2]; unsigned voffB[2];
#pragma unroll
    for (int i = 0; i < 2; ++i) { int R, C; stage_rc(tid * 16 + i * 8192, R, C); const int Rb = Epi::PERM ? ((R & ~31) + perm32(R & 31)) : R;
        Rr[i] = R; Cc[i] = C; voffB[i] = (unsigned)(Rb * g.ldb + C) * 2u; }
    const size_t kstep = (size_t)(BK * 2);
    const size_t hstepB = (size_t)HALF * g.ldb * 2;
    const unsigned ldsw = (unsigned)wid * 1024u;
    const int aoff = lds_byte(wr * 64 + fr, fq * 8), boff = lds_byte(wc * 32 + fr, fq * 8);
    const int aoff0 = aoff, boff0 = boff;
    int sclBv = g.sclB, sclAv = g.sclA; asm volatile("" : "+v"(sclBv), "+v"(sclAv));
#define PG8_SA(b, h) (((b) * 2 + (h)) * HTB)
#define PG8_SB(b, h) ((4 + (b) * 2 + (h)) * HTB)
#define PG8_STAGE(bufoff, gbase, v0, v1) do { \
        __builtin_amdgcn_global_load_lds((const unsigned*)((const char*)(gbase) + (v0)), (LAS unsigned*)(lds + (bufoff) + ldsw), 16, 0, 0); \
        __builtin_amdgcn_global_load_lds((const unsigned*)((const char*)(gbase) + (v1)), (LAS unsigned*)(lds + (bufoff) + ldsw + 8192), 16, 0, 0); } while (0)
#define PG8_STAGEB(bufoff, gbase) PG8_STAGE(bufoff, gbase, voffB[0], voffB[1])
#define PG8_RD32(off) __builtin_bit_cast(i32x8, __builtin_shufflevector(*(const LAS u32x4*)(lds + (off)), *(const LAS u32x4*)(lds + (off) + 1024), 0, 1, 2, 3, 4, 5, 6, 7))
#define PG8_LDA(dst, b, h) do { if constexpr (FP8) { _Pragma("unroll") for (int m = 0; m < 4; ++m) dst##8[m] = PG8_RD32(PG8_SA(b, h) + aoff0 + m * 2048); } \
        else { _Pragma("unroll") for (int m = 0; m < 4; ++m) _Pragma("unroll") for (int k = 0; k < 2; ++k) dst[m][k] = *(const LAS bf16x8*)(lds + PG8_SA(b, h) + aoff + m * 2048 + k * 1024); } } while (0)
#define PG8_LDB(dst, b, h) do { if constexpr (FP8) { _Pragma("unroll") for (int n = 0; n < 2; ++n) dst##8[n] = PG8_RD32(PG8_SB(b, h) + boff0 + n * 2048); } \
        else { _Pragma("unroll") for (int n = 0; n < 2; ++n) _Pragma("unroll") for (int k = 0; k < 2; ++k) dst[n][k] = *(const LAS bf16x8*)(lds + PG8_SB(b, h) + boff + n * 2048 + k * 1024); } } while (0)
#define PG8_MMA(ai, bj, At, Bt) do { __builtin_amdgcn_s_setprio(1); if constexpr (FP8) { _Pragma("unroll") for (int m = 0; m < 4; ++m) _Pragma("unroll") for (int n = 0; n < 2; ++n) \
        asm volatile("v_mfma_scale_f32_16x16x128_f8f6f4 %0, %1, %2, %0, %3, %4 op_sel_hi:[0,0,0]" : "+v"(acc[ai][bj][m][n]) : "v"(Bt##8[n]), "v"(At##8[m]), "v"(sclBv), "v"(sclAv)); } \
        else { _Pragma("unroll") for (int m = 0; m < 4; ++m) _Pragma("unroll") for (int n = 0; n < 2; ++n) _Pragma("unroll") for (int k = 0; k < 2; ++k) \
        acc[ai][bj][m][n] = __builtin_amdgcn_mfma_f32_16x16x32_bf16(Bt[n][k], At[m][k], acc[ai][bj][m][n], 0, 0, 0); } __builtin_amdgcn_s_setprio(0); } while (0)
#define PG8_MMA0(ai, bj, At, Bt) do { __builtin_amdgcn_s_setprio(1); _Pragma("unroll") for (int m = 0; m < 4; ++m) _Pragma("unroll") for (int n = 0; n < 2; ++n) \
        asm volatile("v_mfma_scale_f32_16x16x128_f8f6f4 %0, %1, %2, 0, %3, %4 op_sel_hi:[0,0,0]" : "=&v"(acc[ai][bj][m][n]) : "v"(Bt##8[n]), "v"(At##8[m]), "v"(sclBv), "v"(sclAv)); __builtin_amdgcn_s_setprio(0); } while (0)
#define PG8_WAIT_V(n) asm volatile("s_waitcnt vmcnt(" #n ")" ::: "memory")
#define PG8_WAIT_L(n) asm volatile("s_waitcnt lgkmcnt(" #n ")" ::: "memory")
#define PG8_BAR __builtin_amdgcn_s_barrier()
#define PG8_SCHED __builtin_amdgcn_sched_barrier(0)
    const unsigned hoffA = GATHER ? 0u : (unsigned)(HALF * g.lda) * 2u;
#define PG8_AOFFS(dst, u) do { if constexpr (GATHER) { _Pragma("unroll") for (int h = 0; h < 2; ++h) _Pragma("unroll") for (int i = 0; i < 2; ++i) { \
        const int rec_ = (u).rows[2 * (h * HALF + Rr[i])]; const int row_ = rec_ < 0 ? 0 : (rec_ & 0xffff); dst[h][i] = (unsigned)(row_ * g.lda + Cc[i]) * 2u; } \
        asm volatile("" : "+v"(dst[0][0]), "+v"(dst[0][1]), "+v"(dst[1][0]), "+v"(dst[1][1])); } } while (0)
    const bool nact = !NARROW || wc < 2;
    Unit cur, nxt; int ui = 0;
    if (!S.next(0, cur)) return;
    unsigned cvo[2][2], nvo[2][2];
    if constexpr (Sched::PREFETCH) S.prefetch(cur, wid, lane, lds);
    if constexpr (GATHER) { PG8_AOFFS(cvo, cur); }
    else {
#pragma unroll
        for (int i = 0; i < 2; ++i) { cvo[0][i] = (unsigned)(Rr[i] * g.lda + Cc[i]) * 2u; cvo[1][i] = cvo[0][i] + hoffA; nvo[0][i] = cvo[0][i]; nvo[1][i] = cvo[1][i]; } }
    f32x4 acc[2][2][4][2];
    if constexpr (!NT2)
#pragma unroll
    for (int a = 0; a < 2; ++a)
#pragma unroll
        for (int b = 0; b < 2; ++b)
#pragma unroll
            for (int m = 0; m < 4; ++m)
#pragma unroll
                for (int n = 0; n < 2; ++n) acc[a][b][m][n] = (f32x4){0.f, 0.f, 0.f, 0.f};
    bf16x8 At[4][2], B0[2][2], B1[2][2]; i32x8 At8[4], B08[2], B18[2];
    const char* cA = cur.A; const char* cB = cur.B;
    PG8_STAGEB(PG8_SB(0, 0), cB); PG8_STAGEB(PG8_SB(0, 1), cB + hstepB); PG8_STAGE(PG8_SA(0, 0), cA, cvo[0][0], cvo[0][1]); PG8_STAGE(PG8_SA(0, 1), cA, cvo[1][0], cvo[1][1]);
    if (wr == 1) PG8_BAR;
    PG8_WAIT_V(2); PG8_BAR;
    PG8_STAGEB(PG8_SB(1, 0), cB + kstep); PG8_STAGE(PG8_SA(1, 0), cA + kstep, cvo[0][0], cvo[0][1]); PG8_STAGEB(PG8_SB(1, 1), cB + hstepB + kstep);
    PG8_WAIT_V(6); PG8_BAR;
    for (;;) {
        const bool has_next = S.next(ui + 1, nxt);
        if constexpr (Sched::PREFETCH) { if (has_next) S.prefetch(nxt, wid, lane, lds); }
        if (g.sbx & 1) { nxt.A = cur.A; nxt.B = cur.B; nxt.rows = cur.rows; }
        const char* nA = has_next ? nxt.A : cA; const char* nB = has_next ? nxt.B : cB;
        if constexpr (GATHER) { if (has_next) { PG8_AOFFS(nvo, nxt); } else {
#pragma unroll
            for (int h = 0; h < 2; ++h)
#pragma unroll
                for (int i = 0; i < 2; ++i) nvo[h][i] = cvo[h][i]; } }
#pragma nounroll
        for (int t = 0; t < nt; t += 2) {
            const bool last = (t == nt - 2);
            const char* a1 = cA + (size_t)(t + 1) * kstep;
            const char* a2 = last ? nA : cA + (size_t)(t + 2) * kstep; const char* b2 = last ? nB : cB + (size_t)(t + 2) * kstep;
            const char* a3 = a2 + kstep; const char* b3 = b2 + kstep;
            const unsigned o00 = (GATHER && last) ? nvo[0][0] : cvo[0][0], o01 = (GATHER && last) ? nvo[0][1] : cvo[0][1], o10 = (GATHER && last) ? nvo[1][0] : cvo[1][0], o11 = (GATHER && last) ? nvo[1][1] : cvo[1][1];
            if (nact) { PG8_LDB(B0, 0, 0); if constexpr (!NARROW) { PG8_LDB(B1, 0, 1); } PG8_SCHED; PG8_LDA(At, 0, 0); } PG8_STAGE(PG8_SA(1, 1), a1, cvo[1][0], cvo[1][1]);
            PG8_WAIT_V(8); PG8_WAIT_L(0); PG8_BAR; if constexpr (NT2) { PG8_MMA0(0, 0, At, B0); PG8_MMA0(0, 1, At, B1); } else if (nact) { PG8_MMA(0, 0, At, B0); if constexpr (!NARROW) { PG8_MMA(0, 1, At, B1); } } PG8_BAR; PG8_SCHED;
            if (nact) { PG8_LDA(At, 0, 1); } PG8_STAGEB(PG8_SB(0, 0), b2); PG8_STAGEB(PG8_SB(0, 1), b2 + hstepB); PG8_STAGE(PG8_SA(0, 0), a2, o00, o01);
            PG8_WAIT_V(8); PG8_WAIT_L(0); PG8_BAR; if constexpr (NT2) { PG8_MMA0(1, 0, At, B0); PG8_MMA0(1, 1, At, B1); } else if (nact) { PG8_MMA(1, 0, At, B0); if constexpr (!NARROW) { PG8_MMA(1, 1, At, B1); } } PG8_BAR; PG8_SCHED;
            if (nact) { PG8_LDB(B0, 1, 0); if constexpr (!NARROW) { PG8_LDB(B1, 1, 1); } PG8_SCHED; PG8_LDA(At, 1, 0); } PG8_STAGE(PG8_SA(0, 1), a2, o10, o11);
            PG8_WAIT_V(8); PG8_WAIT_L(0); PG8_BAR; if (nact) { PG8_MMA(0, 0, At, B0); if constexpr (!NARROW) { PG8_MMA(0, 1, At, B1); } } PG8_BAR; PG8_SCHED;
            if (nact) { PG8_LDA(At, 1, 1); } PG8_STAGEB(PG8_SB(1, 0), b3); PG8_STAGEB(PG8_SB(1, 1), b3 + hstepB); PG8_STAGE(PG8_SA(1, 0), a3, o00, o01);
            PG8_WAIT_V(8); PG8_WAIT_L(0); PG8_BAR; if (nact) { PG8_MMA(1, 0, At, B0); if constexpr (!NARROW) { PG8_MMA(1, 1, At, B1); } } PG8_BAR; PG8_SCHED;
        }
        if constexpr (FP8) { asm volatile("s_nop 7\n\ts_nop 7\n\ts_nop 7" ::: "memory"); }
        if constexpr (ALIGN_EPI) { if (wr == 0) PG8_BAR; }
        if (g.sbx & 2) {
#pragma unroll
            for (int a = 0; a < 2; ++a)
#pragma unroll
                for (int b = 0; b < 2; ++b)
#pragma unroll
                    for (int m = 0; m < 4; ++m) asm volatile("" :: "v"(acc[a][b][m][0]), "v"(acc[a][b][m][1])); } else
        E(acc, cur, wr, wc, fr, fq);
#ifdef EPI_TWICE
        if constexpr (Epi::ID == EPI_TWICE) { asm volatile("" ::: "memory"); E(acc, cur, wr, wc, fr, fq); }
#endif
        if (!has_next) break;
        if constexpr (!NT2)
#pragma unroll
        for (int a = 0; a < 2; ++a)
#pragma unroll
            for (int b = 0; b < 2; ++b)
#pragma unroll
                for (int m = 0; m < 4; ++m)
#pragma unroll
                    for (int n = 0; n < 2; ++n) acc[a][b][m][n] = (f32x4){0.f, 0.f, 0.f, 0.f};
        cur = nxt; cA = nA; cB = nB; ++ui;
        if constexpr (GATHER) {
#pragma unroll
        for (int h = 0; h < 2; ++h)
#pragma unroll
            for (int i = 0; i < 2; ++i) cvo[h][i] = nvo[h][i]; }
        if constexpr (ALIGN_EPI) { if (wr == 1) PG8_BAR; }
    }
    PG8_WAIT_V(0);
    if constexpr (!ALIGN_EPI) { if (wr == 0) PG8_BAR; }
    PG8_BAR;
#undef PG8_SA
#undef PG8_SB
#undef PG8_STAGE
#undef PG8_STAGEB
#undef PG8_LDA
#undef PG8_LDB
#undef PG8_MMA
#undef PG8_MMA0
#undef PG8_RD32
#undef PG8_WAIT_V
#undef PG8_WAIT_L
#undef PG8_BAR
#undef PG8_SCHED
#undef PG8_AOFFS
}
}
using pg8::Unit;

struct Args { const float* in[31]; float* out; unsigned char* ws; int ph_lo, ph_hi; };
struct Frame {
    LAS unsigned char* lds; int tid, lane, wave, blk, G, vcu;
    const float *x, *c, *w_ada, *b_ada, *g_mix, *w_in, *conv_w, *conv_b, *g_conv, *lam_re, *lam_im, *log_dt, *b_re, *b_im, *c_re, *c_im,
        *d_skip, *w_glu, *b_glu, *g_ssm, *w_out, *g_ffn, *w_router, *router_bias, *w1, *w3, *w2, *ws1, *ws3, *ws2, *g_final;
    float* out; unsigned char* ws; XcdBarrier bar;
};
#define WSP(T_, off) ((T_*)(F.ws + (off)))
#define LDS_WAIT() asm volatile("s_waitcnt lgkmcnt(0)" ::: "memory")
#define VM_WAIT() asm volatile("s_waitcnt vmcnt(0)" ::: "memory")

struct TileOrder {
    int nM, nN, nwg, G, c;
    __device__ __forceinline__ void init(int nM_, int nN_, int G_, int c_) { nM = nM_; nN = nN_; nwg = nM * nN; G = G_; c = c_; }
    __device__ __forceinline__ bool tile(int i, int& pm, int& pn) const {
        const long L = (long)i * G + c; if (L >= nwg) return false;
        int wgid = (int)L; { const int q = nwg / 8, r = nwg % 8, xcd = wgid % 8, off = wgid / 8; wgid = (xcd < r ? xcd * (q + 1) : r * (q + 1) + (xcd - r) * q) + off; }
        const int nig = 8 * nN, gid = wgid / nig, fm = gid * 8, gsz = (nM - fm) < 8 ? (nM - fm) : 8;
        pm = fm + ((wgid % nig) % gsz); pn = (wgid % nig) / gsz; return true;
    }
};

__device__ __forceinline__ int down_perm_row(int c0) { const int c = 16 * ((c0 & 255) >> 2) + 4 * (c0 >> 8) + (c0 & 3); const int cl = c & 255; return (c & ~255) + ((cl >> 3) & 1) * 128 + (cl >> 6) * 32 + ((cl >> 4) & 3) * 8 + (cl & 7); }
__device__ __forceinline__ void tr_item_load(const float* W, int ldw, int k0, int n0, int lane, float (&tv)[32]) {
#pragma unroll
    for (int i = 0; i < 32; ++i) { const int kk = 2 * i + (lane >> 5); tv[i] = W[(size_t)(k0 + kk) * ldw + n0 + (lane & 31)]; }
}
template <int PMODE = 0>
__device__ __forceinline__ void tr_item_finish_f8(const float (&tv)[32], int k0, unsigned char* WT8, int ldt, int drow0, float scale, LAS float* scr, int lane) {
#pragma unroll
    for (int i = 0; i < 32; ++i) { const int kk = 2 * i + (lane >> 5); scr[kk * 33 + (lane & 31)] = tv[i] * scale; }
    LDS_WAIT(); asm volatile("" ::: "memory");
    const int c = lane & 7;
#pragma unroll
    for (int j = 0; j < 4; ++j) { const int n = (lane >> 3) + 8 * j; const LAS float* s = scr + (8 * c) * 33 + n;
        const u32x2 o = {pk4_fp8(s[0 * 33], s[1 * 33], s[2 * 33], s[3 * 33]), pk4_fp8(s[4 * 33], s[5 * 33], s[6 * 33], s[7 * 33])};
        const int drow = PMODE ? down_perm_row(drow0 + n) : (drow0 + n);
        *(u32x2*)(WT8 + (size_t)drow * ldt + k0 + 8 * c) = o; }
    LDS_WAIT(); asm volatile("" ::: "memory");
}
template <int PMODE = 0>
__device__ __forceinline__ void transpose_item_f8(const float* W, int ldw, int k0, int n0, unsigned char* WT8, int ldt, int drow0, float scale, LAS float* scr, int lane) {
    float tv[32]; tr_item_load(W, ldw, k0, n0, lane, tv); tr_item_finish_f8<PMODE>(tv, k0, WT8, ldt, drow0, scale, scr, lane);
}
template <int PMODE = 0>
__device__ __forceinline__ void transpose_item(const float* W, int ldw, int k0, int n0, bf16_t* WT, int ldt, int drow0, LAS float* scr, int lane) {
    float tv[32];
#pragma unroll
    for (int i = 0; i < 32; ++i) { const int kk = 2 * i + (lane >> 5); tv[i] = W[(size_t)(k0 + kk) * ldw + n0 + (lane & 31)]; }
#pragma unroll
    for (int i = 0; i < 32; ++i) { const int kk = 2 * i + (lane >> 5); scr[kk * 33 + (lane & 31)] = tv[i]; }
    LDS_WAIT(); asm volatile("" ::: "memory");
    const int c = lane & 7;
#pragma unroll
    for (int j = 0; j < 4; ++j) { const int n = (lane >> 3) + 8 * j; const LAS float* s = scr + (8 * c) * 33 + n;
        u32x4 o; o.x = pk2(s[0 * 33], s[1 * 33]); o.y = pk2(s[2 * 33], s[3 * 33]); o.z = pk2(s[4 * 33], s[5 * 33]); o.w = pk2(s[6 * 33], s[7 * 33]);
        const int drow = PMODE ? down_perm_row(drow0 + n) : (drow0 + n);
        *(u32x4*)(WT + (size_t)drow * ldt + k0 + 8 * c) = o; }
    LDS_WAIT(); asm volatile("" ::: "memory");
}

__device__ __forceinline__ void p0_mod(Frame& F) {
    LAS float* sil = (LAS float*)F.lds;
    LAS float* red = (LAS float*)(F.lds + 65536);
    const int c4 = F.tid & 7, ks = F.tid >> 3, n0 = F.blk * 32;
    f32x4 wv[16];
#pragma unroll
    for (int kk = 0; kk < 16; ++kk) wv[kk] = *(const f32x4*)(F.w_ada + (size_t)(ks * 16 + kk) * 6144 + n0 + 4 * c4);
    { f32x4 cv[8];
#pragma unroll
      for (int i = 0; i < 8; ++i) cv[i] = ((const f32x4*)F.c)[F.tid + 512 * i];
#pragma unroll
      for (int i = 0; i < 8; ++i) { f32x4 o; o.x = siluf_(cv[i].x); o.y = siluf_(cv[i].y); o.z = siluf_(cv[i].z); o.w = siluf_(cv[i].w); ((LAS f32x4*)sil)[F.tid + 512 * i] = o; } }
    __syncthreads();
    f32x4 acc[16];
#pragma unroll
    for (int b = 0; b < 16; ++b) acc[b] = (f32x4){0.f, 0.f, 0.f, 0.f};
#pragma unroll
    for (int kq = 0; kq < 4; ++kq) {
#pragma unroll
        for (int b = 0; b < 16; ++b) { const f32x4 sv = *(const LAS f32x4*)(sil + b * 1024 + ks * 16 + 4 * kq);
            acc[b] += wv[4 * kq] * sv.x + wv[4 * kq + 1] * sv.y + wv[4 * kq + 2] * sv.z + wv[4 * kq + 3] * sv.w; } }
#pragma unroll
    for (int o = 8; o < 64; o <<= 1) {
#pragma unroll
        for (int b = 0; b < 16; ++b) { acc[b].x += __shfl_xor(acc[b].x, o); acc[b].y += __shfl_xor(acc[b].y, o); acc[b].z += __shfl_xor(acc[b].z, o); acc[b].w += __shfl_xor(acc[b].w, o); } }
    if (F.lane < 8) {
#pragma unroll
        for (int b = 0; b < 16; ++b) *(LAS f32x4*)(red + (F.wave * 16 + b) * 32 + 4 * c4) = acc[b]; }
    __syncthreads();
    { const int b = F.tid >> 5, col = F.tid & 31; float s = 0.f;
#pragma unroll
      for (int w = 0; w < 8; ++w) s += red[(w * 16 + b) * 32 + col];
      WSP(float, WS_MOD)[b * 6144 + n0 + col] = s + F.b_ada[n0 + col]; }
    __syncthreads();
}

__device__ __forceinline__ void p0_s5_tables(Frame& F, int g, int part) {
    LAS f32x2* pw = (LAS f32x2*)F.lds;
    LAS f32x2* Bb = (LAS f32x2*)(F.lds + 20480);
    LAS f32x2* Cc = (LAS f32x2*)(F.lds + 28672);
    LAS float* Kn = (LAS float*)(F.lds + 40960);
    const float dt = expf(F.log_dt[g]);
    { int tau = -1, p = 0;
      if (F.tid < 320) { tau = 4 * part + (F.tid >> 6); p = F.tid & 63; }
      if (tau >= 0) { const float lr = F.lam_re[g * 64 + p], li = F.lam_im[g * 64 + p];
        const float mag = expf(lr * dt * (float)tau), ang = li * dt * (float)tau; const float sn = sinf(ang), cs = cosf(ang); pw[tau * 64 + p] = (f32x2){mag * cs, mag * sn}; } }
    if (F.tid < 256) { const int tau = F.tid >> 3, p = 8 * part + (F.tid & 7);
        if (tau < 4 * part || tau > 4 * part + 4) { const float lr = F.lam_re[g * 64 + p], li = F.lam_im[g * 64 + p];
            const float mag = expf(lr * dt * (float)tau), ang = li * dt * (float)tau; const float sn = sinf(ang), cs = cosf(ang); pw[tau * 64 + p] = (f32x2){mag * cs, mag * sn}; } }
    for (int i = F.tid; i < 1024; i += 512) { const int p = i >> 4, hi = i & 15; const float lr = F.lam_re[g * 64 + p], li = F.lam_im[g * 64 + p];
        const float mag = expf(lr * dt), ang = li * dt; const float sn = sinf(ang), cs = cosf(ang);
        const float nr = mag * cs - 1.0f, ni = mag * sn, den = lr * lr + li * li, qr = (nr * lr + ni * li) / den, qi = (ni * lr - nr * li) / den;
        const float br = F.b_re[(g * 64 + p) * 16 + hi], bi = F.b_im[(g * 64 + p) * 16 + hi];
        Bb[i] = (f32x2){qr * br - qi * bi, qr * bi + qi * br};
        Cc[(i >> 6) * 65 + (i & 63)] = (f32x2){F.c_re[g * 1024 + i], F.c_im[g * 1024 + i]}; }
    __syncthreads();
    { const int j = F.tid >> 7, ho = (F.tid >> 3) & 15, hp = F.tid & 7; float k0 = 0.f, k1 = 0.f;
      for (int p = 0; p < 64; ++p) { const f32x2 c = Cc[ho * 65 + p], a = pw[(4 * part + j) * 64 + p];
          const float wr_ = c.x * a.x - c.y * a.y, wi_ = c.x * a.y + c.y * a.x;
          const f32x4 b = *(const LAS f32x4*)(Bb + p * 16 + 2 * hp); k0 += wr_ * b.x - wi_ * b.y; k1 += wr_ * b.z - wi_ * b.w; }
      if (part == 0 && j == 0) { const float dsk = F.d_skip[g * 16 + ho]; if (2 * hp == ho) k0 += dsk; if (2 * hp + 1 == ho) k1 += dsk; }
      *(LAS f32x2*)(Kn + F.tid * 2) = (f32x2){k0, k1}; }
    __syncthreads();
    bf16_t* T2 = WSP(bf16_t, WS_T2); bf16_t* T1 = WSP(bf16_t, WS_T1);
    for (int i = F.tid; i < 4 * 32 * 128; i += 512) { const int hp = i & 7, ho = (i >> 3) & 15, tl = (i >> 7) & 31, j = i >> 12, sl = tl - (4 * part + j);
        if (sl >= 0) { const f32x2 v = *(const LAS f32x2*)(Kn + ((j * 16 + ho) * 16 + 2 * hp));
            *(unsigned*)(T2 + ((size_t)(g * 512 + tl * 16 + ho) * KA2 + sl * 16 + 2 * hp)) = pk2(v.x, v.y); } }
    for (int i = F.tid; i < 64 * 320; i += 512) { const int n = 64 * part + i / 320, k = 2 * (i % 320), tl = n >> 4, ho = n & 15;
        if (k < KU) { if ((k >> 4) > tl) *(unsigned*)(T2 + ((size_t)(g * 512 + n) * KA2 + k)) = 0u; }
        else { const int p = (k - KU) >> 1; const f32x2 c = Cc[ho * 65 + p], a = pw[(tl + 1) * 64 + p];
            *(unsigned*)(T2 + ((size_t)(g * 512 + n) * KA2 + k)) = pk2(c.x * a.x - c.y * a.y, -(c.x * a.y + c.y * a.x)); } }
    for (int i = F.tid; i < 16 * 256; i += 512) { const int n1 = 16 * part + (i >> 8), k = 2 * (i & 255), p = n1 >> 1, ri = n1 & 1, sl = k >> 4, hi = k & 15;
        const f32x2 a = pw[(31 - sl) * 64 + p], b0 = Bb[p * 16 + hi], b1 = Bb[p * 16 + hi + 1];
        const float v0 = ri ? (a.x * b0.y + a.y * b0.x) : (a.x * b0.x - a.y * b0.y), v1 = ri ? (a.x * b1.y + a.y * b1.x) : (a.x * b1.x - a.y * b1.y);
        *(unsigned*)(T1 + ((size_t)(g * 256 + n1) * KU + k)) = pk2(v0, v1);
        *(unsigned*)(T1 + ((size_t)(g * 256 + 128 + n1) * KU + k)) = 0u; }
    if (part == 7 && F.tid < 64) { const f32x2 a = pw[32 * 64 + F.tid]; WSP(f32x2, WS_AB32)[g * 64 + F.tid] = a; }
    __syncthreads();
}

__device__ __forceinline__ void p0_router_tables(Frame& F) {
    const int b = F.blk >> 4, kq = F.blk & 15; const float* mod = WSP(float, WS_MOD); bf16_t* WrB = WSP(bf16_t, WS_WRB) + (size_t)b * 256 * 1024;
    LAS float* wt = (LAS float*)F.lds;
    LAS float* red = (LAS float*)(F.lds + 32768);
    { const int e = F.tid & 63, kk = F.tid >> 6; float bs = 0.f;
#pragma unroll
      for (int q = 0; q < 8; ++q) { const int kl = 8 * q + kk, k = 64 * kq + kl; const float w = F.w_router[k * 64 + e]; const float gs = F.g_ffn[k] * (1.0f + mod[b * 6144 + 4096 + k]);
          wt[kl * 65 + e] = w * gs; bs += mod[b * 6144 + 3072 + k] * w; }
      red[kk * 64 + e] = bs; }
    __syncthreads();
    { const int k2 = F.tid & 31, e0 = F.tid >> 5;
#pragma unroll
      for (int j = 0; j < 4; ++j) { const int e = e0 + 16 * j; *(unsigned*)(WrB + (size_t)e * 1024 + 64 * kq + 2 * k2) = pk2(wt[(2 * k2) * 65 + e], wt[(2 * k2 + 1) * 65 + e]); } }
    if (F.tid < 64) { float t = 0.f;
#pragma unroll
        for (int q = 0; q < 8; ++q) t += red[q * 64 + F.tid];
        WSP(float, WS_BIASR)[(b * 16 + kq) * 64 + F.tid] = t; }
    __syncthreads();
}
__device__ __forceinline__ void p0_prologue(Frame& F) {
    if (F.G == 256) p0_router_tables(F);
    { const int it = 255 - F.blk; if (it < 128) p0_s5_tables(F, it >> 3, 7 - (it & 7)); }
    __syncthreads();
    { u32x4* z = (u32x4*)(WSP(bf16_t, WS_WSR_T) + (size_t)576 * 1024); const int nz = 192 * 1024 * 2 / 16;
      for (int i = F.blk * 512 + F.tid; i < nz; i += F.G * 512) z[i] = (u32x4){0u, 0u, 0u, 0u}; }
    LAS float* scr = (LAS float*)(F.lds + F.wave * 16384);
    const int gw = F.wave * F.G + F.vcu, NGW = F.G * 8;
    constexpr int I0 = 1280, I1 = 512, I2 = 32, I3 = 128, I4 = 128, I5 = 32, I6 = 128;
    constexpr int NITEMS = I0 + I1 + I2 + I3 + I4 + I5 + I6;
    for (int it = gw; it < NITEMS; it += NGW) {
        int r = it;
        if (r < I0) { const int kb = r / 80, nb = r % 80, n0 = 32 * nb;
            const int drow = (n0 < 768 || n0 >= 2304) ? n0 : (n0 < 1536 ? 768 + ((n0 - 768) >> 7) * 256 + ((n0 - 768) & 127) : 768 + ((n0 - 1536) >> 7) * 256 + 128 + ((n0 - 1536) & 127));
            transpose_item(F.w_in, DIN, 64 * kb, n0, WSP(bf16_t, WS_WIN_T), 1024, drow, scr, F.lane); continue; } r -= I0;
        if (r < I1) { const int kb = r / 32, nb = r % 32; transpose_item(F.w_out, 1024, 64 * kb, 32 * nb, WSP(bf16_t, WS_WOUT_T), 1024, 32 * nb, scr, F.lane); continue; } r -= I1;
        if (r < I2) { const int kb = r / 8, nb = r % 8; transpose_item(F.w_glu, 256, 64 * kb, 32 * nb, WSP(bf16_t, WS_WGLU_T), 256, 32 * nb, scr, F.lane); continue; } r -= I2;
        if (r < I3) { const int kb = r / 8, nb = r % 8, n0 = 32 * nb; transpose_item_f8(F.ws1, 256, 64 * kb, n0, F.ws + WS_WSR_T, 1024, (n0 >> 7) * 256 + (n0 & 127), 64.0f, scr, F.lane); continue; } r -= I3;
        if (r < I4) { const int kb = r / 8, nb = r % 8, n0 = 32 * nb; transpose_item_f8(F.ws3, 256, 64 * kb, n0, F.ws + WS_WSR_T, 1024, (n0 >> 7) * 256 + 128 + (n0 & 127), 64.0f, scr, F.lane); continue; } r -= I4;
        if (r < I5) { const int kb = r / 2, nb = r % 2; transpose_item(F.w_router, 64, 64 * kb, 32 * nb, WSP(bf16_t, WS_WSR_T), 1024, 512 + 32 * nb, scr, F.lane); continue; } r -= I5;
        { const int kb = r / 32, nb = r % 32; transpose_item_f8<1>(F.ws2, 1024, 64 * kb, 32 * nb, F.ws + WS_WS2_T, 256, 32 * nb, 32.0f, scr, F.lane); }
    }
}
__device__ __forceinline__ void tr_w2_load(Frame& F, int r, float (&tv)[32]) { const int e = r >> 7, q = r & 127, kb = q / 32, nb = q % 32;
    tr_item_load(F.w2 + (size_t)e * 256 * 1024, 1024, 64 * kb, 32 * nb, F.lane, tv); }
__device__ __forceinline__ void tr_w2_fin(Frame& F, int r, const float (&tv)[32], LAS float* scr) { const int e = r >> 7, q = r & 127, kb = q / 32, nb = q % 32;
    tr_item_finish_f8<1>(tv, 64 * kb, F.ws + WS_W2T + (size_t)e * 1024 * 256, 256, 32 * nb, 32.0f, scr, F.lane); }
__device__ __forceinline__ void tr_w2(Frame& F, int ws, int nws) {
    LAS float* scr = (LAS float*)(F.lds + F.wave * 16384); constexpr int N = 8192;
    if (ws >= N) return;
    float ta[32], tb[32]; tr_w2_load(F, ws, ta);
    for (int r = ws; r < N; r += 2 * nws) {
        const int r1 = r + nws, r2 = r + 2 * nws;
        tr_w2_load(F, r1 < N ? r1 : r, tb); tr_w2_fin(F, r, ta, scr);
        tr_w2_load(F, r2 < N ? r2 : r, ta); if (r1 < N) tr_w2_fin(F, r1, tb, scr); }
}
__device__ __forceinline__ void tr_w13_load(Frame& F, int r, float (&tv)[32]) { const int which = r >> 13, rr = r & 8191, e = rr >> 7, q = rr & 127, kb = q / 8, nb = q % 8;
    tr_item_load((which ? F.w3 : F.w1) + (size_t)e * 1024 * 256, 256, 64 * kb, 32 * nb, F.lane, tv); }
__device__ __forceinline__ void tr_w13_fin(Frame& F, int r, const float (&tv)[32], LAS float* scr) { const int which = r >> 13, rr = r & 8191, e = rr >> 7, q = rr & 127, kb = q / 8, nb = q % 8, n0 = 32 * nb;
    tr_item_finish_f8(tv, 64 * kb, F.ws + WS_W13T + (size_t)e * 512 * 1024, 1024, (n0 >> 7) * 256 + which * 128 + (n0 & 127), 64.0f, scr, F.lane); }
__device__ __forceinline__ void tr_w13(Frame& F, int ws, int nws) {
    LAS float* scr = (LAS float*)(F.lds + F.wave * 16384); constexpr int N = 16384;
    if (ws >= N) return;
    float ta[32], tb[32]; tr_w13_load(F, ws, ta);
    for (int r = ws; r < N; r += 2 * nws) {
        const int r1 = r + nws, r2 = r + 2 * nws;
        tr_w13_load(F, r1 < N ? r1 : r, tb); tr_w13_fin(F, r, ta, scr);
        tr_w13_load(F, r2 < N ? r2 : r, ta); if (r1 < N) tr_w13_fin(F, r1, tb, scr); }
}

__device__ __forceinline__ void p1_h_load(const float* x, int t, int lane, f32x4 (&v)[4]) { const f32x4* xr = (const f32x4*)(x + (size_t)t * D) + lane;
#pragma unroll
    for (int j = 0; j < 4; ++j) v[j] = xr[64 * j]; }
__device__ __forceinline__ void p1_h(Frame& F) {
    const float* mod = WSP(float, WS_MOD); bf16_t* H = WSP(bf16_t, WS_H);
    const int NGW = F.G * 8;
    if (F.G == 256) {
        const int gw = F.blk * 8 + F.wave, b = gw >> 7, tb = b * SEQ + (((gw & 7) << 4) | ((gw >> 3) & 15));
        f32x4 gs[4], sh[4];
#pragma unroll
        for (int j = 0; j < 4; ++j) { const int c0 = 4 * F.lane + 256 * j;
            gs[j] = *(const f32x4*)(F.g_mix + c0) * (*(const f32x4*)(mod + b * 6144 + 1024 + c0) + 1.0f); sh[j] = *(const f32x4*)(mod + b * 6144 + c0); }
        f32x4 v[2][4][4];
#pragma unroll
        for (int q = 0; q < 4; ++q) p1_h_load(F.x, tb + 1024 * q, F.lane, v[0][q]);
#pragma unroll
        for (int it = 0; it < 8; ++it) { const int cb = it & 1;
            if (it + 1 < 8) {
#pragma unroll
                for (int q = 0; q < 4; ++q) p1_h_load(F.x, tb + 128 * ((it + 1) + 8 * q), F.lane, v[cb ^ 1][q]); }
            float ss[4];
#pragma unroll
            for (int q = 0; q < 4; ++q) { float a = 0.f;
#pragma unroll
                for (int j = 0; j < 4; ++j) { const f32x4 w = v[cb][q][j]; a += (w.x * w.x + w.y * w.y) + (w.z * w.z + w.w * w.w); }
                ss[q] = a; }
#pragma unroll
            for (int o = 1; o < 64; o <<= 1) {
#pragma unroll
                for (int q = 0; q < 4; ++q) ss[q] += __shfl_xor(ss[q], o); }
#pragma unroll
            for (int q = 0; q < 4; ++q) { const int t = tb + 128 * (it + 8 * q); const float rstd = rsqrtf(ss[q] * (1.0f / D) + RMS_EPS);
#pragma unroll
                for (int j = 0; j < 4; ++j) { const int c0 = 4 * F.lane + 256 * j; const f32x4 h = v[cb][q][j] * rstd * gs[j] + sh[j];
                    *(u32x2*)(H + (size_t)t * D + c0) = (u32x2){pk2(h.x, h.y), pk2(h.z, h.w)}; } }
        }
        return;
    }
    for (int t0 = F.blk * 8 + F.wave; t0 < T; t0 += 4 * NGW) {
        f32x4 v[4][4]; float ss[4];
#pragma unroll
        for (int q = 0; q < 4; ++q) { const int t = t0 + q * NGW; const f32x4* xr = (const f32x4*)(F.x + (size_t)t * D) + F.lane;
#pragma unroll
            for (int j = 0; j < 4; ++j) v[q][j] = xr[64 * j]; }
#pragma unroll
        for (int q = 0; q < 4; ++q) { float a = 0.f;
#pragma unroll
            for (int j = 0; j < 4; ++j) a += (v[q][j].x * v[q][j].x + v[q][j].y * v[q][j].y) + (v[q][j].z * v[q][j].z + v[q][j].w * v[q][j].w);
            ss[q] = a; }
#pragma unroll
        for (int o = 1; o < 64; o <<= 1) {
#pragma unroll
            for (int q = 0; q < 4; ++q) ss[q] += __shfl_xor(ss[q], o); }
#pragma unroll
        for (int q = 0; q < 4; ++q) { const int t = t0 + q * NGW; const int b = t >> 12; const float rstd = rsqrtf(ss[q] * (1.0f / D) + RMS_EPS);
#pragma unroll
            for (int j = 0; j < 4; ++j) { const int c0 = 4 * F.lane + 256 * j;
                const f32x4 gm = *(const f32x4*)(F.g_mix + c0), sh = *(const f32x4*)(mod + b * 6144 + c0), sc = *(const f32x4*)(mod + b * 6144 + 1024 + c0);
                const f32x4 h = v[q][j] * rstd * gm * (sc + 1.0f) + sh;
                *(u32x2*)(H + (size_t)t * D + c0) = (u32x2){pk2(h.x, h.y), pk2(h.z, h.w)}; } }
    }
}

__device__ __forceinline__ u32x4 pack8(const f32x4 a, const f32x4 b) { return (u32x4){pk2(a.x, a.y), pk2(a.z, a.w), pk2(b.x, b.y), pk2(b.z, b.w)}; }
#define EPI_FOR_ROWS _Pragma("unroll") for (int ai = 0; ai < 2; ++ai) _Pragma("unroll") for (int m = 0; m < 4; ++m)
#define EPI_ROWL (ai * 128 + wr * 64 + m * 16 + fr)

struct SchedG1 { static constexpr bool PREFETCH = false; TileOrder o; const char* A; const char* B;
    __device__ __forceinline__ bool next(int i, Unit& u) const { int pm, pn; if (!o.tile(i, pm, pn)) return false; u.pm = pm; u.pn = pn; u.aux = 0; u.rows = nullptr;
        u.A = A + (size_t)pm * 256 * 1024 * 2; u.B = B + (size_t)pn * 256 * 1024 * 2; return true; } };
struct EpiG1 { static constexpr int ID = 2; static constexpr bool PERM = true; bf16_t* projc; bf16_t* A2;
    __device__ __forceinline__ void operator()(const f32x4 (&acc)[2][2][4][2], const Unit& u_in, int wr, int wc, int fr_in, int fq_in) const {
        Unit u = u_in; asm volatile("" : "+s"(u.pm), "+s"(u.pn), "+s"(u.aux)); int fr = fr_in, fq = fq_in; asm volatile("" : "+v"(fr), "+v"(fq));
        EPI_FOR_ROWS { const int row = u.pm * 256 + EPI_ROWL;
            if (u.pn >= 3 && u.pn < 9) { *(u32x4*)(projc + (size_t)row * 1536 + 768 + (u.pn - 3) * 128 + wc * 32 + 8 * fq) = pack8(acc[ai][0][m][0] * acc[ai][1][m][0], acc[ai][0][m][1] * acc[ai][1][m][1]); }
            else {
#pragma unroll
                for (int bj = 0; bj < 2; ++bj) { const int col = bj * 128 + wc * 32 + 8 * fq; const u32x4 w = pack8(acc[ai][bj][m][0], acc[ai][bj][m][1]);
                    if (u.pn < 3) *(u32x4*)(projc + (size_t)row * 1536 + u.pn * 256 + col) = w;
                    else { const int g = col >> 4, hi0 = col & 15, chunk = row >> 5, sl = row & 31; *(u32x4*)(A2 + ((size_t)(g * NCHUNK + chunk) * KA2 + sl * 16 + hi0)) = w; } } } }
    } };

struct SchedS5a { static constexpr bool PREFETCH = false; int G, c; const char* A2; const char* T1;
    __device__ __forceinline__ bool next(int i, Unit& u) const { const int L = i * G + c; if (L >= 128) return false; const int g = L >> 3, pm = L & 7; u.pm = pm; u.pn = 0; u.aux = g; u.rows = nullptr;
        u.A = A2 + (size_t)(g * NCHUNK + pm * 256) * KA2 * 2; u.B = T1 + (size_t)g * 256 * KU * 2; return true; } };
struct EpiS5a { static constexpr int ID = 3; static constexpr bool PERM = false; float* S;
    __device__ __forceinline__ void operator()(const f32x4 (&acc)[2][2][4][2], const Unit& u_in, int wr, int wc, int fr_in, int fq_in) const {
        Unit u = u_in; asm volatile("" : "+s"(u.pm), "+s"(u.pn), "+s"(u.aux)); int fr = fr_in, fq = fq_in; asm volatile("" : "+v"(fr), "+v"(fq));
        EPI_FOR_ROWS { const int row = u.pm * 256 + EPI_ROWL;
#pragma unroll
            for (int n = 0; n < 2; ++n) { const int col = wc * 32 + 16 * n + 4 * fq; *(f32x4*)(S + ((size_t)(u.aux * NCHUNK + row) * 128 + col)) = acc[ai][0][m][n]; } }
    } };

struct SchedS5b { static constexpr bool PREFETCH = false; int G, c; const char* A2; const char* T2;
    __device__ __forceinline__ bool next(int i, Unit& u) const { const int L = i * G + c; if (L >= 256) return false; const int g = L >> 4, pm = (L >> 1) & 7, pn = L & 1; u.pm = pm; u.pn = pn; u.aux = g; u.rows = nullptr;
        u.A = A2 + (size_t)(g * NCHUNK + pm * 256) * KA2 * 2; u.B = T2 + (size_t)(g * 512 + pn * 256) * KA2 * 2; return true; } };
struct EpiS5b { static constexpr int ID = 5; static constexpr bool PERM = true; bf16_t* ys;
    __device__ __forceinline__ void operator()(const f32x4 (&acc)[2][2][4][2], const Unit& u_in, int wr, int wc, int fr_in, int fq_in) const {
        Unit u = u_in; asm volatile("" : "+s"(u.pm), "+s"(u.pn), "+s"(u.aux)); int fr = fr_in, fq = fq_in; asm volatile("" : "+v"(fr), "+v"(fq));
        EPI_FOR_ROWS { const int chunk = u.pm * 256 + EPI_ROWL;
#pragma unroll
            for (int bj = 0; bj < 2; ++bj) { const int n = u.pn * 256 + bj * 128 + wc * 32 + 8 * fq, tl = n >> 4, ho0 = n & 15; const size_t t = (size_t)chunk * LCH + tl;
                f32x4 a = acc[ai][bj][m][0], b = acc[ai][bj][m][1];
#pragma unroll
                for (int j = 0; j < 4; ++j) { a[j] = gelu_tanh(a[j]); b[j] = gelu_tanh(b[j]); }
                *(u32x4*)(ys + t * 256 + u.aux * 16 + ho0) = pack8(a, b); } }
    } };

struct SchedGlu { static constexpr bool PREFETCH = false; int G, c; const char* ys; const char* W;
    __device__ __forceinline__ bool next(int i, Unit& u) const { const int L = i * G + c; if (L >= 256) return false; u.pm = L; u.pn = 0; u.aux = 0; u.rows = nullptr;
        u.A = ys + (size_t)L * 256 * 256 * 2; u.B = W; return true; } };
struct EpiGlu { static constexpr int ID = 6; static constexpr bool PERM = true; const bf16_t* ys; const float* b_glu; const float* g_ssm; bf16_t* ycat; LAS float* scr;
    __device__ __forceinline__ void operator()(f32x4 (&acc)[2][2][4][2], const Unit& u_in, int wr, int wc, int fr_in, int fq_in) const {
        Unit u = u_in; asm volatile("" : "+s"(u.pm), "+s"(u.pn), "+s"(u.aux)); int fr = fr_in, fq = fq_in; asm volatile("" : "+v"(fr), "+v"(fq));
        f32x4 bg[2][2];
#pragma unroll
        for (int bj = 0; bj < 2; ++bj) { const int col = bj * 128 + wc * 32 + 8 * fq; bg[bj][0] = *(const f32x4*)(b_glu + col); bg[bj][1] = *(const f32x4*)(b_glu + col + 4); }
#pragma unroll
        for (int ai = 0; ai < 2; ++ai) {
            u32x4 yw[4][2];
#pragma unroll
            for (int m = 0; m < 4; ++m)
#pragma unroll
                for (int bj = 0; bj < 2; ++bj) yw[m][bj] = *(const u32x4*)(ys + ((size_t)u.pm * 256 + EPI_ROWL) * 256 + bj * 128 + wc * 32 + 8 * fq);
#pragma unroll
            for (int m = 0; m < 4; ++m) { const int rl = EPI_ROWL; float ss = 0.f;
#pragma unroll
                for (int bj = 0; bj < 2; ++bj) { const u32x4 w = yw[m][bj];
                    const f32x4 y0 = (f32x4){bflo(w.x), bfhi(w.x), bflo(w.y), bfhi(w.y)}, y1 = (f32x4){bflo(w.z), bfhi(w.z), bflo(w.w), bfhi(w.w)};
#pragma unroll
                    for (int j = 0; j < 4; ++j) { const float o0 = y0[j] * sigmoidf_(acc[ai][bj][m][0][j] + bg[bj][0][j]), o1 = y1[j] * sigmoidf_(acc[ai][bj][m][1][j] + bg[bj][1][j]);
                        acc[ai][bj][m][0][j] = o0; acc[ai][bj][m][1][j] = o1; ss += o0 * o0 + o1 * o1; } }
                ss += __shfl_xor(ss, 16); ss += __shfl_xor(ss, 32);
                if (fq == 0) scr[rl * 4 + wc] = ss; }
            asm volatile("" ::: "memory"); }
        LDS_WAIT(); __builtin_amdgcn_s_barrier(); asm volatile("" ::: "memory");
        f32x4 gs[2][2];
#pragma unroll
        for (int bj = 0; bj < 2; ++bj) { const int col = bj * 128 + wc * 32 + 8 * fq; gs[bj][0] = *(const f32x4*)(g_ssm + col); gs[bj][1] = *(const f32x4*)(g_ssm + col + 4); }
        EPI_FOR_ROWS { const int rl = EPI_ROWL; const size_t row = (size_t)u.pm * 256 + rl; const f32x4 p = *(const LAS f32x4*)(scr + rl * 4);
            const float rstd = rsqrtf(((p.x + p.y) + (p.z + p.w)) * (1.0f / 256.0f) + RMS_EPS);
#pragma unroll
            for (int bj = 0; bj < 2; ++bj) { const int col = bj * 128 + wc * 32 + 8 * fq;
                *(u32x4*)(ycat + row * 1024 + 768 + col) = pack8(acc[ai][bj][m][0] * rstd * gs[bj][0], acc[ai][bj][m][1] * rstd * gs[bj][1]); } }
        LDS_WAIT(); __builtin_amdgcn_s_barrier(); asm volatile("" ::: "memory");
    } };

struct SchedG2 { static constexpr bool PREFETCH = false; int c; const char* A; const char* B;
    __device__ __forceinline__ bool next(int i, Unit& u) const { if (i >= 4 || c >= 256) return false; u.pm = c; u.pn = i; u.aux = 0; u.rows = nullptr;
        u.A = A + (size_t)c * 256 * 1024 * 2; u.B = B + (size_t)i * 256 * 1024 * 2; return true; } };
struct EpiG2 { static constexpr int ID = 7; static constexpr bool PERM = true; const float* x; const float* mod; bf16_t* x1; LAS float* scr;
    __device__ __forceinline__ void operator()(const f32x4 (&acc)[2][2][4][2], const Unit& u_in, int wr, int wc, int fr_in, int fq_in) const {
        Unit u = u_in; asm volatile("" : "+s"(u.pm), "+s"(u.pn), "+s"(u.aux)); int fr = fr_in, fq = fq_in; asm volatile("" : "+v"(fr), "+v"(fq));
        const int b = u.pm >> 4;
        const char* xb = (const char*)(x + (size_t)u.pm * 256 * 1024 + u.pn * 256);
        char* ob = (char*)(x1 + (size_t)u.pm * 256 * 1024 + u.pn * 256);
        const char* gb = (const char*)(mod + b * 6144 + 2048 + u.pn * 256);
        const unsigned lcol = (unsigned)(wc * 32 + 8 * fq);
#pragma unroll
        for (int ai = 0; ai < 2; ++ai) {
            f32x4 xv[4][2][2], gt[2][2];
#pragma unroll
            for (int m = 0; m < 4; ++m)
#pragma unroll
                for (int bj = 0; bj < 2; ++bj) { const unsigned off = ((unsigned)EPI_ROWL * 1024u + bj * 128u + lcol) * 4u; xv[m][bj][0] = *(const f32x4*)(xb + off); xv[m][bj][1] = *(const f32x4*)(xb + off + 16); }
#pragma unroll
            for (int bj = 0; bj < 2; ++bj) { const unsigned off = (bj * 128u + lcol) * 4u; gt[bj][0] = *(const f32x4*)(gb + off); gt[bj][1] = *(const f32x4*)(gb + off + 16); }
#pragma unroll
            for (int m = 0; m < 4; ++m) { const int rl = EPI_ROWL; float ss = 0.f;
#pragma unroll
                for (int bj = 0; bj < 2; ++bj) { const unsigned off = ((unsigned)rl * 1024u + bj * 128u + lcol) * 2u;
                    const f32x4 o0 = xv[m][bj][0] + gt[bj][0] * acc[ai][bj][m][0], o1 = xv[m][bj][1] + gt[bj][1] * acc[ai][bj][m][1];
                    ss += (o0.x * o0.x + o0.y * o0.y) + (o0.z * o0.z + o0.w * o0.w) + (o1.x * o1.x + o1.y * o1.y) + (o1.z * o1.z + o1.w * o1.w);
                    *(u32x4*)(ob + off) = pack8(o0, o1); }
                ss += __shfl_xor(ss, 16); ss += __shfl_xor(ss, 32);
                if (fq == 0) scr[rl * 16 + u.pn * 4 + wc] = ss; }
            asm volatile("" ::: "memory"); }
    } };

struct SchedRS { static constexpr bool PREFETCH = false; __device__ __forceinline__ const char* zero_row() const { return nullptr; }
    int c, tile0, ntiles; const char* A; const char* B; int rowbytes;
    __device__ __forceinline__ bool next(int i, Unit& u) const { if (i >= ntiles || c >= 256) return false; u.pm = c; u.pn = tile0 + i; u.aux = 0; u.rows = nullptr;
        u.A = A + (size_t)c * 256 * rowbytes; u.B = B + (size_t)(tile0 + i) * 256 * rowbytes; return true; } };
struct EpiRS { static constexpr int ID = 8; static constexpr bool PERM = true; bf16_t* acts; float* logits; const LAS float* biasr; const LAS float* ssq;
    __device__ __forceinline__ void operator()(const f32x4 (&acc)[2][2][4][2], const Unit& u_in, int wr, int wc, int fr_in, int fq_in) const {
        Unit u = u_in; asm volatile("" : "+s"(u.pm), "+s"(u.pn), "+s"(u.aux)); int fr = fr_in, fq = fq_in; asm volatile("" : "+v"(fr), "+v"(fq));
        EPI_FOR_ROWS { const size_t row = (size_t)u.pm * 256 + EPI_ROWL;
            if (u.pn < 2) { f32x4 o0, o1;
#pragma unroll
                for (int j = 0; j < 4; ++j) { o0[j] = siluf_(acc[ai][0][m][0][j]) * acc[ai][1][m][0][j]; o1[j] = siluf_(acc[ai][0][m][1][j]) * acc[ai][1][m][1][j]; }
                o0 = o0 * 4.0f; o1 = o1 * 4.0f; *(u32x2*)((unsigned char*)acts + row * 256 + u.pn * 128 + wc * 32 + 8 * fq) = (u32x2){pk4_fp8(o0.x, o0.y, o0.z, o0.w), pk4_fp8(o1.x, o1.y, o1.z, o1.w)}; }
            else if (wc < 2) { const int col = wc * 32 + 8 * fq, rl = EPI_ROWL; float tot = 0.f;
#pragma unroll
                for (int p = 0; p < 4; ++p) { const f32x4 pq = *(const LAS f32x4*)(ssq + rl * 16 + 4 * p); tot += (pq.x + pq.y) + (pq.z + pq.w); }
                const float rstd = rsqrtf(tot * (1.0f / D) + RMS_EPS); const LAS float* bp = biasr + col;
                *(f32x4*)(logits + row * 64 + col) = acc[ai][0][m][0] * rstd + *(const LAS f32x4*)bp; *(f32x4*)(logits + row * 64 + col + 4) = acc[ai][0][m][1] * rstd + *(const LAS f32x4*)(bp + 4); } }
    } };

struct SchedUp { static constexpr bool PREFETCH = false; int G, c, nblk; const LAS int* blk_e; const int* tok; const char* H2; const char* W13;
    __device__ __forceinline__ bool next(int i, Unit& u) const { const int L = i * G + c; if (L >= 2 * nblk) return false; const int j = L >> 1, h = L & 1;
        const int e = __builtin_amdgcn_readfirstlane(blk_e[j]); u.pm = j; u.pn = h; u.aux = e; u.rows = tok + 2 * j * 256; u.A = H2; u.B = W13 + (size_t)(e * 2 + h) * 256 * 1024; return true; } };
struct EpiUp { static constexpr int ID = 11; static constexpr bool PERM = true; unsigned char* act;
    __device__ __forceinline__ void operator()(const f32x4 (&acc)[2][2][4][2], const Unit& u_in, int wr, int wc, int fr_in, int fq_in) const {
        Unit u = u_in; asm volatile("" : "+s"(u.pm), "+s"(u.pn), "+s"(u.aux)); int fr = fr_in, fq = fq_in; asm volatile("" : "+v"(fr), "+v"(fq));
        EPI_FOR_ROWS { const size_t row = (size_t)u.pm * 256 + EPI_ROWL; f32x4 o0, o1;
#pragma unroll
            for (int j = 0; j < 4; ++j) { o0[j] = siluf_(acc[ai][0][m][0][j]) * acc[ai][1][m][0][j] * 4.0f; o1[j] = siluf_(acc[ai][0][m][1][j]) * acc[ai][1][m][1][j] * 4.0f; }
            *(u32x2*)(act + row * 256 + u.pn * 128 + wc * 32 + 8 * fq) = (u32x2){pk4_fp8(o0.x, o0.y, o0.z, o0.w), pk4_fp8(o1.x, o1.y, o1.z, o1.w)}; }
    } };

struct SchedDown { static constexpr bool PREFETCH = false; int G, c, nblk; const LAS int* blk_e; const char* act; const char* acts; const char* W2; const char* WS2;
    __device__ __forceinline__ bool next(int i, Unit& u) const { const int L = i * G + c; u.rows = nullptr; u.par = i % 3;
        if (L < 4 * nblk) { const int j = L >> 2, pn = L & 3; const int e = __builtin_amdgcn_readfirstlane(blk_e[j]); u.pm = j; u.pn = pn; u.aux = 0;
            u.A = act + (size_t)j * 256 * 256; u.B = W2 + (size_t)(e * 1024 + pn * 256) * 256; return true; }
        const int L2 = L - 4 * nblk; if (L2 >= 1024) return false; u.pm = L2 >> 2; u.pn = L2 & 3; u.aux = 1;
        u.A = acts + (size_t)u.pm * 256 * 256; u.B = WS2 + (size_t)u.pn * 256 * 256; return true; }
    const unsigned char* recb;
    __device__ __forceinline__ void prefetch(const Unit& u, int wid, int lane, LAS unsigned char* lds) const {
        if (u.aux == 0 && wid < 2) __builtin_amdgcn_global_load_lds((const unsigned*)(recb + ((size_t)u.pm * 256 + wid * 128 + lane * 2) * 8), (LAS unsigned*)(lds + RING_BYTES + 8192 + __builtin_amdgcn_readfirstlane(u.par) * 2048 + wid * 1024), 16, 0, 0); } };
struct EpiDown { static constexpr int ID = 12; static constexpr bool PERM = true; unsigned char* Yrb; unsigned char* Ys8;
    __device__ __forceinline__ void operator()(const f32x4 (&acc)[2][2][4][2], const Unit& u_in, int wr, int wc, int fr_in, int fq_in) const {
        Unit u = u_in; asm volatile("" : "+s"(u.pm), "+s"(u.pn), "+s"(u.aux)); int fr = fr_in, fq = fq_in; asm volatile("" : "+v"(fr), "+v"(fq));
        unsigned char* base = (u.aux == 0 ? Yrb : Ys8) + (size_t)u.pm * 256 * 1024 + u.pn * 256 + wc * 64 + fq * 16;
        EPI_FOR_ROWS { u32x4 w;
#pragma unroll
            for (int q = 0; q < 4; ++q) { const f32x4 v = acc[ai][q >> 1][m][q & 1]; int pk = 0;
                pk = __builtin_amdgcn_cvt_pk_fp8_f32(v.x, v.y, pk, false); pk = __builtin_amdgcn_cvt_pk_fp8_f32(v.z, v.w, pk, true); w[q] = (unsigned)pk; }
            *(u32x4*)(base + (size_t)EPI_ROWL * 1024) = w; }
    } };

__device__ __forceinline__ void p3_conv(Frame& F) {
    const bf16_t* P = WSP(bf16_t, WS_PROJC); bf16_t* Y = WSP(bf16_t, WS_YCAT);
    f32x4 w0[3], w1[3], w2[3], cb[3], gc[3];
#pragma unroll
    for (int j = 0; j < 3; ++j) { const int c0 = 4 * F.lane + 256 * j;
        w0[j] = *(const f32x4*)(F.conv_w + c0); w1[j] = *(const f32x4*)(F.conv_w + DCONV + c0); w2[j] = *(const f32x4*)(F.conv_w + 2 * DCONV + c0);
        cb[j] = *(const f32x4*)(F.conv_b + c0); gc[j] = *(const f32x4*)(F.g_conv + c0); }
    constexpr int NT = 8;
    for (int run = F.G == 256 ? ((F.wave << 8) | F.blk) : F.blk * 8 + F.wave; run < T / NT; run += F.G * 8) {
        const int t0 = run * NT; const bool first = (t0 & (SEQ - 1)) == 0;
        u32x2 bw[NT][3], zw[NT + 2][3];
#pragma unroll
        for (int q = 0; q < NT + 2; ++q) { const size_t t = (size_t)((first && q < 2) ? t0 : t0 - 2 + q);
#pragma unroll
            for (int j = 0; j < 3; ++j) { const int c0 = 4 * F.lane + 256 * j; zw[q][j] = *(const u32x2*)(P + t * 1536 + 768 + c0); if (q >= 2) bw[q - 2][j] = *(const u32x2*)(P + t * 1536 + c0); } }
        if (first) {
#pragma unroll
            for (int j = 0; j < 3; ++j) { zw[0][j] = (u32x2){0u, 0u}; zw[1][j] = (u32x2){0u, 0u}; } }
        f32x4 val[NT][3]; float ss[NT];
#pragma unroll
        for (int q = 0; q < NT; ++q) { float a = 0.f;
#pragma unroll
            for (int j = 0; j < 3; ++j) {
                const f32x4 bg = (f32x4){bflo(bw[q][j].x), bfhi(bw[q][j].x), bflo(bw[q][j].y), bfhi(bw[q][j].y)};
                const f32x4 z2 = (f32x4){bflo(zw[q][j].x), bfhi(zw[q][j].x), bflo(zw[q][j].y), bfhi(zw[q][j].y)};
                const f32x4 z1 = (f32x4){bflo(zw[q + 1][j].x), bfhi(zw[q + 1][j].x), bflo(zw[q + 1][j].y), bfhi(zw[q + 1][j].y)};
                const f32x4 z = (f32x4){bflo(zw[q + 2][j].x), bfhi(zw[q + 2][j].x), bflo(zw[q + 2][j].y), bfhi(zw[q + 2][j].y)};
                val[q][j] = bg * (w0[j] * z2 + w1[j] * z1 + w2[j] * z + cb[j]);
                a += (val[q][j].x * val[q][j].x + val[q][j].y * val[q][j].y) + (val[q][j].z * val[q][j].z + val[q][j].w * val[q][j].w); }
            ss[q] = a; }
#pragma unroll
        for (int o = 1; o < 64; o <<= 1) {
#pragma unroll
            for (int q = 0; q < NT; ++q) ss[q] += __shfl_xor(ss[q], o); }
#pragma unroll
        for (int q = 0; q < NT; ++q) { const size_t t = (size_t)t0 + q; const float rstd = rsqrtf(ss[q] * (1.0f / DCONV) + RMS_EPS);
#pragma unroll
            for (int j = 0; j < 3; ++j) { const int c0 = 4 * F.lane + 256 * j; const f32x4 o = val[q][j] * rstd * gc[j];
                *(u32x2*)(Y + t * 1024 + c0) = (u32x2){pk2(o.x, o.y), pk2(o.z, o.w)}; } }
    }
}

__device__ __forceinline__ void p4_scan(Frame& F) {
    if (F.wave != 0) return;
    const float* S = WSP(float, WS_S); bf16_t* A2 = WSP(bf16_t, WS_A2);
    for (int bg = F.blk; bg < NB * NG; bg += F.G) { const int g = bg >> 4, b = bg & 15, p = F.lane;
        const f32x2 a = WSP(f32x2, WS_AB32)[g * 64 + p]; float xr = 0.f, xi = 0.f;
        for (int c0 = 0; c0 < 128; c0 += 32) { f32x2 sv[32];
#pragma unroll
            for (int c = 0; c < 32; ++c) sv[c] = *(const f32x2*)(S + ((size_t)g * NCHUNK + b * 128 + c0 + c) * 128 + 2 * p);
#pragma unroll
            for (int c = 0; c < 32; ++c) { const size_t chunk = (size_t)g * NCHUNK + b * 128 + c0 + c;
                *(unsigned*)(A2 + chunk * KA2 + KU + 2 * p) = pk2(xr, xi);
                const float nr = a.x * xr - a.y * xi + sv[c].x, ni = a.x * xi + a.y * xr + sv[c].y; xr = nr; xi = ni; } }
    }
}

__device__ __forceinline__ void p7_post(Frame& F) {
    const float* mod = WSP(float, WS_MOD); const bf16_t* X1 = WSP(bf16_t, WS_X1); bf16_t* H2 = WSP(bf16_t, WS_H2);
    LAS float* scr = (LAS float*)(F.lds + EPI_OFF);
    VM_WAIT(); LDS_WAIT(); __syncthreads();
    if (F.blk >= 256) return;
    const int b = F.blk >> 4;
    if (F.tid < 64) { float t = 0.f;
#pragma unroll
        for (int q = 0; q < 16; ++q) t += WSP(float, WS_BIASR)[(b * 16 + q) * 64 + F.tid];
        ((LAS float*)(F.lds + MISC_OFF + 512))[F.tid] = t; }
    f32x4 gf[4], sh[4], sc[4];
#pragma unroll
    for (int j = 0; j < 4; ++j) { const int c0 = 4 * F.lane + 256 * j; gf[j] = *(const f32x4*)(F.g_ffn + c0); sh[j] = *(const f32x4*)(mod + b * 6144 + 3072 + c0); sc[j] = *(const f32x4*)(mod + b * 6144 + 4096 + c0) + 1.0f; gf[j] = gf[j] * sc[j]; }
    u32x2 xw[2][4][4];
    const size_t row0 = (size_t)F.blk * 256 + F.wave * 32;
#pragma unroll
    for (int q = 0; q < 4; ++q)
#pragma unroll
        for (int j = 0; j < 4; ++j) xw[0][q][j] = *(const u32x2*)(X1 + (row0 + q) * 1024 + 4 * F.lane + 256 * j);
#pragma unroll
    for (int it = 0; it < 8; ++it) { const int cb = it & 1, i = 4 * it;
        if (it + 1 < 8) {
#pragma unroll
            for (int q = 0; q < 4; ++q)
#pragma unroll
                for (int j = 0; j < 4; ++j) xw[cb ^ 1][q][j] = *(const u32x2*)(X1 + (row0 + i + 4 + q) * 1024 + 4 * F.lane + 256 * j); }
        float rstd[4];
#pragma unroll
        for (int q = 0; q < 4; ++q) { const int rl = F.wave * 32 + i + q; float tot = 0.f;
#pragma unroll
            for (int p = 0; p < 4; ++p) { const f32x4 pq = *(const LAS f32x4*)(scr + rl * 16 + 4 * p); tot += (pq.x + pq.y) + (pq.z + pq.w); }
            rstd[q] = rsqrtf(tot * (1.0f / D) + RMS_EPS); }
#pragma unroll
        for (int q = 0; q < 4; ++q) { const size_t row = row0 + i + q;
#pragma unroll
            for (int j = 0; j < 4; ++j) { const int c0 = 4 * F.lane + 256 * j;
                const f32x4 xv = (f32x4){bflo(xw[cb][q][j].x), bfhi(xw[cb][q][j].x), bflo(xw[cb][q][j].y), bfhi(xw[cb][q][j].y)};
                const f32x4 h = xv * rstd[q] * gf[j] + sh[j];
                *(unsigned*)(F.ws + WS_H2F8 + row * 1024 + c0) = pk4_fp8(h.x, h.y, h.z, h.w); } }
    }
}

__device__ __forceinline__ void p9_topk(Frame& F) {
    const float* LG = WSP(float, WS_LOGITS); unsigned char* R = F.ws + WS_ROUTE;
    int* sele = (int*)(R + RT_SELE); float* selw = (float*)(R + RT_SELW); int* cntw = (int*)(R + RT_CNTW); int* cntb = (int*)(R + RT_CNTB);
    u32x2* rec = (u32x2*)(R + RT_REC);
    LAS int* lcnt = (LAS int*)F.lds;
    const float NEG = -INFINITY;
    for (int blk = F.blk; blk < 256; blk += F.G) {
        for (int i = F.tid; i < MAXBLK; i += 512) rec[blk * MAXBLK + i] = (u32x2){0xffffffffu, 0u};
        if (F.wave < 4) {
            const int tok = blk * 256 + F.tid;
            float s[64], bb[64];
#pragma unroll
            for (int q = 0; q < 16; ++q) { const f32x4 lg = *(const f32x4*)(LG + (size_t)tok * 64 + 4 * q);
#pragma unroll
                for (int j = 0; j < 4; ++j) { s[4 * q + j] = sigmoidf_(lg[j]); bb[4 * q + j] = s[4 * q + j] + F.router_bias[4 * q + j]; } }
            float gs[8];
#pragma unroll
            for (int g = 0; g < 8; ++g) { float m1 = NEG, m2 = NEG;
#pragma unroll
                for (int j = 0; j < 8; ++j) { const float v = bb[8 * g + j]; if (v > m1) { m2 = m1; m1 = v; } else if (v > m2) { m2 = v; } }
                gs[g] = m1 + m2; }
            unsigned gsel = 0u;
#pragma unroll
            for (int g = 0; g < 8; ++g) { int rk = 0;
#pragma unroll
                for (int g2 = 0; g2 < 8; ++g2) rk += (gs[g2] > gs[g] || (gs[g2] == gs[g] && g2 < g)) ? 1 : 0;
                gsel |= (rk < 4) ? (1u << g) : 0u; }
#pragma unroll
            for (int e = 0; e < 64; ++e) bb[e] = ((gsel >> (e >> 3)) & 1u) ? bb[e] : NEG;
            int ek[6]; float sk[6]; unsigned long long taken = 0ull; float ssum = 0.f;
#pragma unroll
            for (int k = 0; k < 6; ++k) { float best = NEG, bs = 0.f; int bi = 0;
#pragma unroll
                for (int e = 0; e < 64; ++e) { const bool c = (((taken >> e) & 1ull) == 0ull) && (bb[e] > best); best = c ? bb[e] : best; bs = c ? s[e] : bs; bi = c ? e : bi; }
                ek[k] = bi; sk[k] = bs; taken |= 1ull << bi; ssum += bs; }
            int rk[6] = {0, 0, 0, 0, 0, 0}; int mycnt = 0;
#pragma unroll
            for (int e = 0; e < 64; ++e) { const bool hit = ((taken >> e) & 1ull) != 0ull; const unsigned long long m = __ballot(hit);
                const int pre = __builtin_amdgcn_mbcnt_hi((unsigned)(m >> 32), __builtin_amdgcn_mbcnt_lo((unsigned)m, 0u));
#pragma unroll
                for (int k = 0; k < 6; ++k) rk[k] = (ek[k] == e) ? pre : rk[k];
                mycnt = (F.lane == e) ? __popcll(m) : mycnt; }
            const float inv = 2.5f / ssum;
#pragma unroll
            for (int k = 0; k < 6; ++k) { sele[(size_t)tok * 6 + k] = ek[k] | (rk[k] << 8); selw[(size_t)tok * 6 + k] = sk[k] * inv; }
            cntw[(blk * 4 + F.wave) * 64 + F.lane] = mycnt; lcnt[F.wave * 64 + F.lane] = mycnt;
        }
        else if (blk == F.blk) tr_w13(F, F.vcu * 4 + (F.wave - 4), F.G * 4);
        __syncthreads();
        if (F.tid < 64) cntb[blk * 64 + F.tid] = (lcnt[F.tid] + lcnt[64 + F.tid]) + (lcnt[128 + F.tid] + lcnt[192 + F.tid]);
        __syncthreads();
    }
}

__device__ __forceinline__ void p10_scatter(Frame& F) {
    unsigned char* R = F.ws + WS_ROUTE;
    const int* sele = (const int*)(R + RT_SELE); const float* selw = (const float*)(R + RT_SELW); const int* cntw = (const int*)(R + RT_CNTW); const int* cntb = (const int*)(R + RT_CNTB);
    u32x2* rec = (u32x2*)(R + RT_REC);
    LAS int* ptot = (LAS int*)F.lds; LAS int* ppre = ptot + 512; LAS int* pst = ppre + 512; LAS int* pad = pst + 64; LAS int* base = pad + 64;
    for (int blk = F.blk; blk < 256; blk += F.G) {
        int sev[3], cw[4];
#pragma unroll
        for (int i = 0; i < 3; ++i) sev[i] = sele[(size_t)blk * (256 * TOPK) + F.tid + 512 * i];
#pragma unroll
        for (int w = 0; w < 4; ++w) cw[w] = cntw[(blk * 4 + w) * 64 + (F.tid & 63)];
        { const int p8 = F.tid >> 6, e = F.tid & 63; int tot = 0, pre = 0;
          for (int b2 = 32 * p8; b2 < 32 * p8 + 32; ++b2) { const int c = cntb[b2 * 64 + e]; tot += c; pre += (b2 < blk) ? c : 0; }
          ptot[p8 * 64 + e] = tot; ppre[p8 * 64 + e] = pre; }
        __syncthreads();
        if (F.tid < 64) { const int e = F.tid; int total = 0, bb = 0;
#pragma unroll
            for (int q = 0; q < 8; ++q) { total += ptot[q * 64 + e]; bb += ppre[q * 64 + e]; }
            const int padded = (total + 255) & ~255; int v = padded;
#pragma unroll
            for (int o = 1; o < 64; o <<= 1) { const int tv = __shfl_up(v, o); if (e >= o) v += tv; }
            const int pstart = v - padded; pst[e] = pstart; pad[e] = padded;
            int run = pstart + bb;
#pragma unroll
            for (int w = 0; w < 4; ++w) { base[w * 64 + e] = run; run += cw[w]; }
            if (blk == 0 && e == 63) { const int nblk = (pstart + padded) >> 8; __hip_atomic_store(WSP(int, WS_CTL) + CW_NBLK, nblk, __ATOMIC_RELAXED, __HIP_MEMORY_SCOPE_AGENT); } }
        __syncthreads();
#pragma unroll
        for (int i = 0; i < 3; ++i) { const int a = F.tid + 512 * i; const int tl = a / 6, k = a - tl * 6, tok = blk * 256 + tl, w = tl >> 6;
            const int se = sev[i]; const int e = se & 255, r = se >> 8; const int dest = base[w * 64 + e] + r;
            rec[dest] = (u32x2){(unsigned)(tok | (k << 16)), 0u}; ((int*)(R + RT_TDEST))[(size_t)tok * 6 + k] = dest; }
        { const int nblk = (pst[63] + pad[63]) >> 8; int* blke = WSP(int, WS_BLKE);
            if (F.tid < 8) { const int j = blk * 8 + F.tid; if (j < nblk) { const int r0 = j * 256; int e = 0;
                for (int q = 0; q < 64; ++q) if (pad[q] > 0 && pst[q] <= r0 && r0 < pst[q] + pad[q]) e = q;
                blke[j] = e; } } }
        __syncthreads();
    }
}

__device__ __forceinline__ void p13_final(Frame& F) {
    const float* mod = WSP(float, WS_MOD); const bf16_t* X1 = WSP(bf16_t, WS_X1); const unsigned char* Yrb = F.ws + WS_Y4; const unsigned char* Ys8 = F.ws + WS_YS8;
    const int* tdest = (const int*)(F.ws + WS_ROUTE + RT_TDEST); const float* selw = (const float*)(F.ws + WS_ROUTE + RT_SELW);
    const int NGW = F.G * 8, c0 = 16 * F.lane, cl = 4 * F.lane, li = F.lane < 6 ? F.lane : 0;
    f32x4 gf[4];
#pragma unroll
    for (int j = 0; j < 4; ++j) gf[j] = *(const f32x4*)(F.g_final + cl + 256 * j);
    int t0 = F.blk * 8 + F.wave;
    int ds[2][6]; float wk[2][6];
#pragma unroll
    for (int q = 0; q < 2; ++q) { const size_t t = (size_t)t0 + (size_t)q * NGW; const int dv = tdest[t * 6 + li]; const float wv = selw[t * 6 + li];
#pragma unroll
        for (int k = 0; k < 6; ++k) { ds[q][k] = __builtin_amdgcn_readlane(dv, k); wk[q][k] = __builtin_bit_cast(float, __builtin_amdgcn_readlane(__builtin_bit_cast(int, wv), k)); } }
    for (; t0 < T; t0 += 2 * NGW) {
        int dn[2] = {0, 0}; float wn[2] = {0.f, 0.f};
        if (t0 + 2 * NGW < T) {
#pragma unroll
            for (int q = 0; q < 2; ++q) { const size_t t = (size_t)t0 + (size_t)(q + 2) * NGW; dn[q] = tdest[t * 6 + li]; wn[q] = selw[t * 6 + li]; } }
        asm volatile("" ::: "memory");
        u32x4 yw[2][NSLOT]; u32x2 xw[2][4]; f32x4 g2[2][4];
#pragma unroll
        for (int q = 0; q < 2; ++q) { const size_t t = (size_t)t0 + (size_t)q * NGW; const int b = (t0 + q * NGW) >> 12;
#pragma unroll
            for (int k = 0; k < 6; ++k) yw[q][k] = *(const u32x4*)(Yrb + (size_t)ds[q][k] * 1024 + c0);
            yw[q][6] = *(const u32x4*)(Ys8 + t * 1024 + c0);
#pragma unroll
            for (int j = 0; j < 4; ++j) { xw[q][j] = *(const u32x2*)(X1 + t * 1024 + cl + 256 * j); g2[q][j] = *(const f32x4*)(mod + b * 6144 + 5120 + cl + 256 * j); } }
        asm volatile("" ::: "memory");
        f32x4 v[2][4]; float ss[2];
#pragma unroll
        for (int q = 0; q < 2; ++q) { float a = 0.f;
#pragma unroll
            for (int j = 0; j < 4; ++j) { f32x4 ys = (f32x4){0.f, 0.f, 0.f, 0.f};
#pragma unroll
                for (int k = 0; k < NSLOT; ++k) { const f32x2 lo = __builtin_amdgcn_cvt_pk_f32_fp8((int)yw[q][k][j], false), hi = __builtin_amdgcn_cvt_pk_f32_fp8((int)yw[q][k][j], true);
                    const float w_ = k < 6 ? wk[q][k < 6 ? k : 0] : 1.0f; ys += (f32x4){lo.x, lo.y, hi.x, hi.y} * w_; }
                const f32x4 g2s = g2[q][j] * 0.0625f;
                const unsigned w0 = xw[q][j].x, w1 = xw[q][j].y;
                v[q][j] = (f32x4){bflo(w0), bfhi(w0), bflo(w1), bfhi(w1)} + g2s * ys;
                a += (v[q][j].x * v[q][j].x + v[q][j].y * v[q][j].y) + (v[q][j].z * v[q][j].z + v[q][j].w * v[q][j].w); }
            ss[q] = a; }
#pragma unroll
        for (int o = 1; o < 64; o <<= 1) { ss[0] += __shfl_xor(ss[0], o); ss[1] += __shfl_xor(ss[1], o); }
#pragma unroll
        for (int q = 0; q < 2; ++q) {
#pragma unroll
            for (int k = 0; k < 6; ++k) { ds[q][k] = __builtin_amdgcn_readlane(dn[q], k); wk[q][k] = __builtin_bit_cast(float, __builtin_amdgcn_readlane(__builtin_bit_cast(int, wn[q]), k)); } }
#pragma unroll
        for (int q = 0; q < 2; ++q) { const size_t t = (size_t)t0 + (size_t)q * NGW; const float rstd = rsqrtf(ss[q] * (1.0f / D) + RMS_EPS);
#pragma unroll
            for (int j = 0; j < 4; ++j) *(f32x4*)(F.out + t * 1024 + cl + 256 * j) = v[q][j] * rstd * gf[j]; }
    }
}

#ifndef STAGGER
#define STAGGER 0
#endif
__device__ __forceinline__ void phase_stagger(Frame& F, int unit_ticks) {
#if STAGGER
    const unsigned long long t0 = __builtin_amdgcn_s_memrealtime(); const unsigned long long wait = (unsigned long long)(((F.blk >> 3) & 3) * unit_ticks / 4);
    while (__builtin_amdgcn_s_memrealtime() - t0 < wait) __builtin_amdgcn_s_sleep(16);
#endif
}
constexpr int N_PHASES = 14;
template <int K, int SBX = 0> __device__ __forceinline__ void run_phase(Frame& F) {
    LAS unsigned char* ring = F.lds; LAS float* escr = (LAS float*)(F.lds + EPI_OFF);
    if constexpr (K == 0) { if (F.blk < 192) p0_mod(F); }
    if constexpr (K == 1) { p0_prologue(F); p1_h(F); }
    if constexpr (K == 2) {
        SchedG1 S; S.o.init(256, 10, F.G, F.blk); S.A = (const char*)WSP(bf16_t, WS_H); S.B = (const char*)WSP(bf16_t, WS_WIN_T);
        EpiG1 E{WSP(bf16_t, WS_PROJC), WSP(bf16_t, WS_A2)};
        phase_stagger(F, 2800);
        pg8::gemm_phase<EpiG1, SchedG1, false, true>(ring, pg8::Desc{1024, 1024, 1024, SBX}, S, E);
    }
    if constexpr (K == 3) {
        p3_conv(F); __syncthreads();
        SchedS5a S{F.G, F.blk, (const char*)WSP(bf16_t, WS_A2), (const char*)WSP(bf16_t, WS_T1)}; EpiS5a E{WSP(float, WS_S)};
        pg8::gemm_phase<EpiS5a, SchedS5a, false, false>(ring, pg8::Desc{KA2, KU, KU, SBX}, S, E);
    }
    if constexpr (K == 4) { if (F.wave == 0) p4_scan(F); else tr_w2(F, F.vcu * 7 + (F.wave - 1), F.G * 7); }
    if constexpr (K == 5) {
        SchedS5b S{F.G, F.blk, (const char*)WSP(bf16_t, WS_A2), (const char*)WSP(bf16_t, WS_T2)}; EpiS5b E{WSP(bf16_t, WS_YS)};
        pg8::gemm_phase<EpiS5b, SchedS5b, false, false>(ring, pg8::Desc{KA2, KA2, KA2, SBX}, S, E);
    }
    if constexpr (K == 6) {
        SchedGlu S{F.G, F.blk, (const char*)WSP(bf16_t, WS_YS), (const char*)WSP(bf16_t, WS_WGLU_T)};
        EpiGlu E{WSP(bf16_t, WS_YS), F.b_glu, F.g_ssm, WSP(bf16_t, WS_YCAT), escr};
        pg8::gemm_phase<EpiGlu, SchedGlu, false, true>(ring, pg8::Desc{256, 256, 256, SBX}, S, E);
    }
    if constexpr (K == 7) {
        SchedG2 S{F.blk, (const char*)WSP(bf16_t, WS_YCAT), (const char*)WSP(bf16_t, WS_WOUT_T)};
        EpiG2 E{F.x, WSP(float, WS_MOD), WSP(bf16_t, WS_X1), escr};
        pg8::gemm_phase<EpiG2, SchedG2, false, true>(ring, pg8::Desc{1024, 1024, 1024, SBX}, S, E);
        p7_post(F);
    }
    if constexpr (K == 8) {
        EpiRS E{WSP(bf16_t, WS_ACTS), WSP(float, WS_LOGITS), (const LAS float*)(F.lds + MISC_OFF + 512), (const LAS float*)escr};
        { SchedRS S{F.blk, 0, 2, (const char*)(F.ws + WS_H2F8), (const char*)(F.ws + WS_WSR_T), 1024};
          pg8::gemm_phase<EpiRS, SchedRS, false, true, true>(ring, pg8::Desc{512, 512, 512, SBX, 0x79797979, 0x7f7f7f7f}, S, E); }
        { SchedRS S{F.blk, 2, 1, (const char*)WSP(bf16_t, WS_X1), (const char*)(WSP(bf16_t, WS_WRB) + (size_t)(F.blk >> 4) * 256 * 1024) - (size_t)2 * 256 * 2048, 2048};
          pg8::gemm_phase<EpiRS, SchedRS, false, true, false, false, true>(ring, pg8::Desc{1024, 1024, 1024, SBX}, S, E); }
    }
    if constexpr (K == 9) { p9_topk(F); }
    if constexpr (K == 10) { p10_scatter(F); }
    if constexpr (K == 11) {
        const int nblk = __builtin_amdgcn_readfirstlane(ld_i32_agent(WSP(int, WS_CTL) + CW_NBLK));
        { LAS int* tb = (LAS int*)(F.lds + EPI_OFF); for (int j = F.tid; j < nblk; j += 512) tb[j] = ld_i32_agent(WSP(int, WS_BLKE) + j); __syncthreads(); }
        SchedUp S{F.G, F.vcu, nblk, (const LAS int*)(F.lds + EPI_OFF), (const int*)(F.ws + WS_ROUTE + RT_REC), (const char*)(F.ws + WS_H2F8), (const char*)(F.ws + WS_W13T)};
        EpiUp E{F.ws + WS_ACT};
        phase_stagger(F, 2800);
        pg8::gemm_phase<EpiUp, SchedUp, true, true, true>(ring, pg8::Desc{512, 512, 512, SBX, 0x79797979, 0x7f7f7f7f}, S, E);
    }
    if constexpr (K == 12) {
        const int nblk = __builtin_amdgcn_readfirstlane(ld_i32_agent(WSP(int, WS_CTL) + CW_NBLK));
        { LAS int* tb = (LAS int*)(F.lds + EPI_OFF); for (int j = F.tid; j < nblk; j += 512) tb[j] = ld_i32_agent(WSP(int, WS_BLKE) + j); __syncthreads(); }
        SchedDown S{F.G, F.vcu, nblk, (const LAS int*)(F.lds + EPI_OFF), (const char*)WSP(bf16_t, WS_ACT), (const char*)WSP(bf16_t, WS_ACTS), (const char*)WSP(bf16_t, WS_W2T), (const char*)WSP(bf16_t, WS_WS2_T), F.ws + WS_ROUTE + RT_REC};
        EpiDown E{F.ws + WS_Y4, F.ws + WS_YS8};
        phase_stagger(F, 900);
        pg8::gemm_phase<EpiDown, SchedDown, false, false, true, true>(ring, pg8::Desc{128, 128, 128, SBX, 0x7e7e7e7e, 0x7d7d7d7d}, S, E);
    }
    if constexpr (K == 13) { p13_final(F); }
}
#ifndef REP_PHASE
#define REP_PHASE -1
#endif
#ifndef PH_MASK
#define PH_MASK 0xFFFF
#endif
#ifndef USE_CG_FIRST
#define USE_CG_FIRST 0
#endif
template <int K> __device__ __forceinline__ void grid_sync(Frame& F) {
#if MK_N_LAUNCHES == 1
    if constexpr (K == 0 && USE_CG_FIRST) cg::this_grid().sync(); else xcd_barrier(F.bar);
#endif
}
template <int K> __device__ __forceinline__ void phase_and_seam(Frame& F, int lo, int hi) {
    if (((PH_MASK >> K) & 1) && lo <= K && K < hi) {
        run_phase<K>(F);
        if constexpr (K == REP_PHASE) { grid_sync<K>(F); run_phase<K>(F); }
        if (K + 1 < hi) { if constexpr (K == 7 || K == 8) { VM_WAIT(); __syncthreads(); } else grid_sync<K>(F); }
    }
}
__global__ void __launch_bounds__(512, 2) mk_fwd(Args args) {
    extern __shared__ __attribute__((aligned(16))) unsigned char lds_raw[];
    Frame F;
    F.lds = (LAS unsigned char*)lds_raw; F.tid = threadIdx.x; F.lane = F.tid & 63; F.wave = __builtin_amdgcn_readfirstlane(F.tid >> 6);
    F.blk = blockIdx.x; F.G = gridDim.x; F.vcu = (F.G % 8 == 0) ? (F.blk % 8) * (F.G / 8) + F.blk / 8 : F.blk;
    { const float* const* in = args.in;
      F.x = in[0]; F.c = in[1]; F.w_ada = in[2]; F.b_ada = in[3]; F.g_mix = in[4]; F.w_in = in[5]; F.conv_w = in[6]; F.conv_b = in[7]; F.g_conv = in[8];
      F.lam_re = in[9]; F.lam_im = in[10]; F.log_dt = in[11]; F.b_re = in[12]; F.b_im = in[13]; F.c_re = in[14]; F.c_im = in[15]; F.d_skip = in[16];
      F.w_glu = in[17]; F.b_glu = in[18]; F.g_ssm = in[19]; F.w_out = in[20]; F.g_ffn = in[21]; F.w_router = in[22]; F.router_bias = in[23];
      F.w1 = in[24]; F.w3 = in[25]; F.w2 = in[26]; F.ws1 = in[27]; F.ws3 = in[28]; F.ws2 = in[29]; F.g_final = in[30]; }
    F.out = args.out; F.ws = args.ws;
    const int lo = args.ph_lo, hi = args.ph_hi;
    if (F.tid < 64) ((LAS unsigned*)(F.lds + MISC_OFF))[F.tid] = 0u;
    __syncthreads();
    F.bar = xcd_barrier_post((unsigned*)(F.ws + WS_CTL) + CW_BAR, (volatile LAS unsigned*)(F.lds + MISC_OFF) + 8);
    phase_and_seam<0>(F, lo, hi); phase_and_seam<1>(F, lo, hi); phase_and_seam<2>(F, lo, hi); phase_and_seam<3>(F, lo, hi);
    phase_and_seam<4>(F, lo, hi); phase_and_seam<5>(F, lo, hi); phase_and_seam<6>(F, lo, hi); phase_and_seam<7>(F, lo, hi);
    phase_and_seam<8>(F, lo, hi); phase_and_seam<9>(F, lo, hi); phase_and_seam<10>(F, lo, hi); phase_and_seam<11>(F, lo, hi);
    phase_and_seam<12>(F, lo, hi); phase_and_seam<13>(F, lo, hi);
#ifdef SANDBOX_PHASE
    grid_sync<13>(F); run_phase<SANDBOX_PHASE, SANDBOX_FLAGS>(F);
#endif
}

extern "C" void kernel_launch(void* const* d_in, const int* in_sizes, int n_in, void* d_out, int out_size, void* d_ws, size_t ws_size, hipStream_t stream) {
    static int grid = 0;
    if (grid == 0) {
        if (n_in != 31 || in_sizes[0] != T * D || out_size != T * D || ws_size < WS_END) { fprintf(stderr, "kernel_launch: unexpected shapes (n_in %d, in0 %d, out %d, ws %zu)\n", n_in, n_in > 0 ? in_sizes[0] : -1, out_size, ws_size); grid = -1; return; }
        int dev = 0, cus = 0, per_cu = 0;
        if (hipGetDevice(&dev) != hipSuccess || hipDeviceGetAttribute(&cus, hipDeviceAttributeMultiprocessorCount, dev) != hipSuccess) { grid = -1; return; }
        if (hipFuncSetAttribute((const void*)mk_fwd, hipFuncAttributeMaxDynamicSharedMemorySize, LDS_BYTES) != hipSuccess) { fprintf(stderr, "kernel_launch: hipFuncSetAttribute failed\n"); grid = -1; return; }
        if (hipOccupancyMaxActiveBlocksPerMultiprocessor(&per_cu, (const void*)mk_fwd, 512, LDS_BYTES) != hipSuccess || per_cu < 1) { fprintf(stderr, "kernel_launch: occupancy query gives %d\n", per_cu); per_cu = 1; }
        (void)hipGetLastError();
        grid = cus;
        if (grid > 256) grid = 256;
    }
    if (grid < 0) return;
    (void)hipMemsetAsync((char*)d_ws + WS_CTL, 0, CTL_ZERO_BYTES, stream);
    Args a{};
    for (int i = 0; i < 31; ++i) a.in[i] = (const float*)d_in[i];
    a.out = (float*)d_out; a.ws = (unsigned char*)d_ws;
#if MK_N_LAUNCHES == 1
    a.ph_lo = 0; a.ph_hi = N_PHASES;
    void* kargs[] = {&a};
    hipError_t e = hipLaunchCooperativeKernel((const void*)mk_fwd, dim3(grid), dim3(512), kargs, LDS_BYTES, stream);
    if (e != hipSuccess) fprintf(stderr, "kernel_launch: cooperative launch failed: %s (grid %d)\n", hipGetErrorString(e), grid);
#else
    for (int p = 0; p < N_PHASES; ++p) { a.ph_lo = p; a.ph_hi = p + 1; hipLaunchKernelGGL(mk_fwd, dim3(grid), dim3(512), LDS_BYTES, stream, a); }
#endif
}
```
